# Optimizing an MI355X kernel written in HIP

```python
import jax, jax.numpy as jnp
from jax import lax
import numpy as np

D_MODEL = 1024
BATCH = 8
SEQ = 8192
DEPTH = 1

HEAD_DIM = 64
A_Q_HEADS = 8
A_KV_HEADS = 2
A_GROUP = A_Q_HEADS // A_KV_HEADS
B_GROUPS = ((128, 1), (512, 4), (2048, 16))
B_HEADS_PER_GROUP = 4
B_HEADS = B_HEADS_PER_GROUP * len(B_GROUPS)
GRID_W = 64
ROPE_THETA = 10000.0
Q_BLOCK = 128
N_EXPERTS = 16
EXPERT_FF = 1024
EC_CAPACITY_FACTOR = 2
NORM_EPS = 1e-6
NEG_INF = -1e30

A_Q_W = A_Q_HEADS * HEAD_DIM
A_KV_W = A_KV_HEADS * HEAD_DIM
B_W = B_HEADS * HEAD_DIM
B_OUT_W = B_HEADS_PER_GROUP * HEAD_DIM
N_IN = A_Q_W + 2 * A_KV_W + 3 * B_W + 2 * D_MODEL

kernel_name = "hybrid_gqa2drope_dilated_alibi_ecmoe"


def rms_norm(x, g):
    xf = x.astype(jnp.float32)
    y = xf * lax.rsqrt(jnp.mean(xf * xf, axis=-1, keepdims=True) + NORM_EPS)
    return (y * g.astype(jnp.float32)).astype(x.dtype)


def axial_rope_tables(seq):
    rows = seq // GRID_W
    row_id = jnp.repeat(jnp.arange(rows, dtype=jnp.float32), GRID_W)
    col_id = jnp.tile(jnp.arange(GRID_W, dtype=jnp.float32), rows)
    half = HEAD_DIM // 2
    inv_freq = 1.0 / (ROPE_THETA ** (jnp.arange(0, half, 2, dtype=jnp.float32) / half))
    ang_r = row_id[:, None] * inv_freq[None, :]
    ang_c = col_id[:, None] * inv_freq[None, :]
    return (jnp.cos(ang_r)[:, None, :], jnp.sin(ang_r)[:, None, :],
            jnp.cos(ang_c)[:, None, :], jnp.sin(ang_c)[:, None, :])


def _rotate(x, cos, sin):
    n = x.shape[-1] // 2
    x1, x2 = x[..., :n], x[..., n:]
    return jnp.concatenate([x1 * cos - x2 * sin, x2 * cos + x1 * sin], axis=-1)


def apply_axial_rope(x, tables):
    cos_r, sin_r, cos_c, sin_c = tables
    xf = x.astype(jnp.float32)
    half = HEAD_DIM // 2
    out = jnp.concatenate([_rotate(xf[..., :half], cos_r, sin_r),
                           _rotate(xf[..., half:], cos_c, sin_c)], axis=-1)
    return out.astype(x.dtype)


def axial_gqa_attention(q, k, v, q_g, k_g):
    bsz, seq, _ = q.shape
    q = rms_norm(q.reshape(bsz, seq, A_Q_HEADS, HEAD_DIM), q_g)
    k = rms_norm(k.reshape(bsz, seq, A_KV_HEADS, HEAD_DIM), k_g)
    v = v.reshape(bsz, seq, A_KV_HEADS, HEAD_DIM)
    tables = axial_rope_tables(seq)
    q = apply_axial_rope(q, tables) * (HEAD_DIM ** -0.5)
    k = apply_axial_rope(k, tables)
    q = q.reshape(bsz, seq, A_KV_HEADS, A_GROUP, HEAD_DIM)

    def block(s0):
        qb = lax.dynamic_slice_in_dim(q, s0, Q_BLOCK, axis=1)
        s = jnp.einsum('bqkgd,bskd->bkgqs', qb, k).astype(jnp.float32)
        p = jax.nn.softmax(s, axis=-1).astype(v.dtype)
        return jnp.einsum('bkgqs,bskd->bqkgd', p, v)

    starts = jnp.arange(seq // Q_BLOCK, dtype=jnp.int32) * Q_BLOCK
    o = lax.map(block, starts)
    return jnp.moveaxis(o, 0, 1).reshape(bsz, seq, A_Q_W)


def dilated_window_attention(q, k, v):
    bsz, seq, _ = q.shape
    n_g = len(B_GROUPS)
    q = q.reshape(bsz, seq, n_g, B_HEADS_PER_GROUP, HEAD_DIM) * (HEAD_DIM ** -0.5)
    k = k.reshape(bsz, seq, n_g, B_HEADS_PER_GROUP, HEAD_DIM)
    v = v.reshape(bsz, seq, n_g, B_HEADS_PER_GROUP, HEAD_DIM)
    qs = [q[:, :, gi] for gi in range(n_g)]
    ks = [k[:, :, gi] for gi in range(n_g)]
    vs = [v[:, :, gi] for gi in range(n_g)]
    slopes = jnp.exp2(-8.0 * jnp.arange(1, B_HEADS + 1, dtype=jnp.float32) / B_HEADS)
    slopes = slopes.reshape(n_g, B_HEADS_PER_GROUP)

    def block(s0):
        t = s0 + jnp.arange(Q_BLOCK, dtype=jnp.int32)
        outs, lses = [], []
        for gi, (window, dil) in enumerate(B_GROUPS):
            n_side = window // (2 * dil)
            off = np.arange(-n_side, n_side + 1, dtype=np.int32) * dil
            idx = t[:, None] + jnp.asarray(off)[None, :]
            valid = (idx >= 0) & (idx < seq)
            idxc = jnp.clip(idx, 0, seq - 1)
            qb = lax.dynamic_slice_in_dim(qs[gi], s0, Q_BLOCK, axis=1)
            kg = ks[gi][:, idxc]
            vg = vs[gi][:, idxc]
            s = jnp.einsum('bqhd,bqkhd->bhqk', qb, kg).astype(jnp.float32)
            s = s - slopes[gi][:, None, None] * jnp.abs(jnp.asarray(off, jnp.float32))[None, None, :]
            s = jnp.where(valid[None, None], s, NEG_INF)
            lse = jax.nn.logsumexp(s, axis=-1)
            p = jnp.exp(s - lse[..., None]).astype(vg.dtype)
            outs.append(jnp.einsum('bhqk,bqkhd->bqhd', p, vg))
            lses.append(lse)
        w = jax.nn.softmax(jnp.stack(lses, axis=0), axis=0)
        w = jnp.swapaxes(w, 2, 3)[..., None]
        o = jnp.sum(jnp.stack(outs, axis=0).astype(jnp.float32) * w, axis=0)
        return o.astype(v.dtype)

    starts = jnp.arange(seq // Q_BLOCK, dtype=jnp.int32) * Q_BLOCK
    o = lax.map(block, starts)
    return jnp.moveaxis(o, 0, 1).reshape(bsz, seq, B_OUT_W)


def expert_choice_swiglu(h, w_router, w_gate, w_up, w_down):
    bsz, seq, dm = h.shape
    cap = EC_CAPACITY_FACTOR * seq // N_EXPERTS
    aff = jax.nn.softmax(jnp.einsum('bsd,de->bse', h, w_router).astype(jnp.float32), axis=-1)
    g, idx = lax.top_k(jnp.swapaxes(aff, 1, 2), cap)
    xin = jax.vmap(lambda hb, ib: hb[ib])(h, idx)
    a = jnp.einsum('becd,edf->becf', xin, w_gate)
    u = jnp.einsum('becd,edf->becf', xin, w_up)
    y = jnp.einsum('becf,efd->becd', jax.nn.silu(a) * u, w_down) * g[..., None].astype(h.dtype)
    return jax.vmap(lambda ib, yb: jnp.zeros((seq, dm), yb.dtype).at[ib.reshape(-1)].add(yb.reshape(-1, dm)))(idx, y)


def setup_inputs(seed: int = 0) -> dict:
    key = jax.random.key(seed)
    ks = jax.random.split(key, 16)
    f32 = jnp.float32
    nrm = lambda k, shape, fan_in: jax.random.normal(k, shape, f32) * (fan_in ** -0.5)
    gain = lambda k, shape: 1.0 + 0.02 * jax.random.normal(k, shape, f32)
    return {
        "x": jax.random.normal(ks[0], (BATCH, SEQ, D_MODEL), f32),
        "norm1_g": gain(ks[1], (DEPTH, D_MODEL)),
        "w_in": nrm(ks[2], (DEPTH, D_MODEL, N_IN), D_MODEL),
        "b_gates": 0.1 * jax.random.normal(ks[3], (DEPTH, 2 * D_MODEL), f32),
        "q_norm_g": gain(ks[4], (DEPTH, HEAD_DIM)),
        "k_norm_g": gain(ks[5], (DEPTH, HEAD_DIM)),
        "w_o_a": nrm(ks[6], (DEPTH, A_Q_W, D_MODEL), A_Q_W),
        "w_o_b": nrm(ks[7], (DEPTH, B_OUT_W, D_MODEL), B_OUT_W),
        "w_out": nrm(ks[8], (DEPTH, D_MODEL, D_MODEL), D_MODEL),
        "norm2_g": gain(ks[9], (DEPTH, D_MODEL)),
        "w_router": nrm(ks[10], (DEPTH, D_MODEL, N_EXPERTS), D_MODEL),
        "w_gate": nrm(ks[11], (DEPTH, N_EXPERTS, D_MODEL, EXPERT_FF), D_MODEL),
        "w_up": nrm(ks[12], (DEPTH, N_EXPERTS, D_MODEL, EXPERT_FF), D_MODEL),
        "w_down": nrm(ks[13], (DEPTH, N_EXPERTS, EXPERT_FF, D_MODEL), EXPERT_FF),
        "normf_g": gain(ks[14], (D_MODEL,)),
    }


def reference(x, norm1_g, w_in, b_gates, q_norm_g, k_norm_g, w_o_a, w_o_b, w_out,
              norm2_g, w_router, w_gate, w_up, w_down, normf_g):
    splits = np.cumsum([A_Q_W, A_KV_W, A_KV_W, B_W, B_W, B_W, D_MODEL])
    for l in range(DEPTH):
        h = rms_norm(x, norm1_g[l])
        z = jnp.einsum('bsd,dn->bsn', h, w_in[l])
        qa, ka, va, qb, kb, vb, ga, gb = jnp.split(z, splits, axis=-1)
        gate_a = jax.nn.sigmoid(ga + b_gates[l, :D_MODEL])
        gate_b = jax.nn.sigmoid(gb + b_gates[l, D_MODEL:])
        ya = jnp.einsum('bsc,cd->bsd', axial_gqa_attention(qa, ka, va, q_norm_g[l], k_norm_g[l]), w_o_a[l])
        yb = jnp.einsum('bsc,cd->bsd', dilated_window_attention(qb, kb, vb), w_o_b[l])
        x = x + jnp.einsum('bsc,cd->bsd', gate_a * ya + gate_b * yb, w_out[l])
        x = x + expert_choice_swiglu(rms_norm(x, norm2_g[l]), w_router[l], w_gate[l], w_up[l], w_down[l])
    return rms_norm(x, normf_g)
```

```cpp
#include <hip/hip_runtime.h>
#include <cstdio>
#include <cstdint>
namespace pg8 {
#define PG8_LAS __attribute__((address_space(3)))
typedef unsigned short bf16_t;
typedef short bf16x8 __attribute__((ext_vector_type(8)));
typedef float f32x4 __attribute__((ext_vector_type(4)));
typedef unsigned u32x4 __attribute__((ext_vector_type(4)));
constexpr int BM = 256, BK = 64, HALF = 128, HTB = HALF * BK * 2  , STAGE_BYTES = 8 * HTB, NXCD = 8, WGM = 8;

__host__ __device__ __forceinline__ int lds_byte(int r, int c) { const int st = (r >> 4) * 2 + (c >> 5), rr = r & 15, cc = c & 31, ob = rr * 64 + cc * 2; return st * 1024 + (ob ^ (((ob >> 9) & 1) << 5)); }
__host__ __device__ __forceinline__ void stage_rc(int b, int& R, int& C) { const int st = b / 1024, sb = b % 1024, swz = sb ^ (((sb >> 9) & 1) << 5); R = (st >> 1) * 16 + swz / 64; C = (st & 1) * 32 + (swz % 64) / 2; }
__host__ __device__ __forceinline__ int perm32(int rho) { const int n = rho >> 4, i = rho & 15; return 8 * (i >> 2) + 4 * n + (i & 3); }

struct Unit { int pm, pn, pb; };
struct Gemm { const bf16_t* A; const bf16_t* Bt; int K, lda, ldb; };

struct StaticOrder {
    int nM, nN, nwg, G, c;
    __host__ __device__ void init(int M, int N, int G_, int c_) { nM = M / BM; nN = N / BM; nwg = nM * nN; G = G_; c = c_; }
    __host__ __device__ bool next(int i, Unit& u) const {
        const long L = (long)i * G + c; if (L >= nwg) return false;
        int wgid = (int)L; { const int q = nwg / NXCD, r = nwg % NXCD, xcd = wgid % NXCD, off = wgid / NXCD; wgid = (xcd < r ? xcd * (q + 1) : r * (q + 1) + (xcd - r) * q) + off; }
        const int nig = WGM * nN, gid = wgid / nig, fm = gid * WGM, gsz = (nM - fm) < WGM ? (nM - fm) : WGM;
        u.pm = fm + ((wgid % nig) % gsz); u.pn = (wgid % nig) / gsz; u.pb = u.pn; return true;
    }
    __device__ __forceinline__ void a_ready(const Unit&) const {}
    __device__ __forceinline__ void done(const Unit&) const {}
};
struct MoeOrderGU {
    int G, vcu;
    __device__ __forceinline__ bool next(int i, Unit& u) const {
        const int L = i * G + vcu; if (L >= 4096) return false;
        const int rnd = L >> 8, x = (L >> 5) & 7, w = L & 31; const int e = 2 * x + (rnd >> 3), b = rnd & 7, g = b * 16 + e;
        u.pm = g * 4 + (w & 3); u.pn = w >> 2; u.pb = e * 8 + u.pn; return true; }
    __device__ __forceinline__ void a_ready(const Unit&) const {}
    __device__ __forceinline__ void done(const Unit&) const {}
};
struct MoeOrderDown {
    int G, vcu;
    __device__ __forceinline__ bool next(int i, Unit& u) const {
        const int L = i * G + vcu; if (L >= 2048) return false;
        const int rnd = L >> 8, x = (L >> 5) & 7, w = L & 31; const int jj = 2 * rnd + (w >> 4), w16 = w & 15; const int e = 2 * x + (jj >> 3), b = jj & 7, g = b * 16 + e;
        u.pm = g * 4 + (w16 & 3); u.pn = w16 >> 2; u.pb = e * 4 + u.pn; return true; }
    __device__ __forceinline__ void a_ready(const Unit&) const {}
    __device__ __forceinline__ void done(const Unit&) const {}
};

__device__ __forceinline__ unsigned cvt_pk_bf16(float lo, float hi) { unsigned r; asm volatile("v_cvt_pk_bf16_f32 %0, %1, %2" : "=v"(r) : "v"(lo), "v"(hi)); return r; }
__device__ __forceinline__ float bf_lo(unsigned w) { return __uint_as_float(w << 16); }
__device__ __forceinline__ float bf_hi(unsigned w) { return __uint_as_float(w & 0xffff0000u); }
__device__ __forceinline__ float sigmoidf_fast(float v) { return __builtin_amdgcn_rcpf(1.0f + __builtin_amdgcn_exp2f(-1.4426950408889634f * v)); }
constexpr float QSCALE = 0.125f * 1.4426950408889634f;

struct EpiZ {
    static constexpr bool PERM = true, AFTER_DRAIN = false;
    bf16_t *QA, *KVA, *QB, *KB, *VB, *G; const float* bg;
    __device__ __forceinline__ void operator()(const f32x4 (&acc)[2][2][4][2], const Unit& u, int wr, int wc, int fr, int fq) const {
        const int pn = u.pn; bf16_t* base; int ldc, colt; float sc = 1.f; bool gate = false;
        if (pn < 2) { base = QA; ldc = 512; colt = pn * 256; }
        else if (pn == 2) { base = KVA; ldc = 256; colt = 0; }
        else if (pn < 6) { base = QB; ldc = 768; colt = (pn - 3) * 256; sc = QSCALE; }
        else if (pn < 9) { base = KB; ldc = 768; colt = (pn - 6) * 256; }
        else if (pn < 12) { base = VB; ldc = 768; colt = (pn - 9) * 256; }
        else { base = G; ldc = 2048; colt = (pn - 12) * 256; gate = true; }
        const int row0 = u.pm * BM + wr * 64 + fr, col0 = colt + wc * 32 + 8 * fq;
        f32x4 bv[2][2];
#pragma unroll
        for (int bj = 0; bj < 2; ++bj)
#pragma unroll
            for (int n = 0; n < 2; ++n) bv[bj][n] = gate ? *(const f32x4*)(bg + col0 + bj * HALF + 4 * n) : (f32x4){0.f, 0.f, 0.f, 0.f};
#pragma unroll
        for (int ai = 0; ai < 2; ++ai)
#pragma unroll
            for (int m = 0; m < 4; ++m) { bf16_t* rowp = base + (size_t)(row0 + ai * HALF + m * 16) * ldc + col0;
#pragma unroll
                for (int bj = 0; bj < 2; ++bj) { f32x4 v0 = acc[ai][bj][m][0], v1 = acc[ai][bj][m][1];
                    if (gate) { v0 = v0 + bv[bj][0]; v1 = v1 + bv[bj][1];
#pragma unroll
                        for (int q = 0; q < 4; ++q) { v0[q] = sigmoidf_fast(v0[q]); v1[q] = sigmoidf_fast(v1[q]); } }
                    else { v0 = v0 * sc; v1 = v1 * sc; }
                    u32x4 w; w.x = cvt_pk_bf16(v0[0], v0[1]); w.y = cvt_pk_bf16(v0[2], v0[3]); w.z = cvt_pk_bf16(v1[0], v1[1]); w.w = cvt_pk_bf16(v1[2], v1[3]);
                    *(u32x4*)(rowp + bj * HALF) = w; } }
    }
};
template <bool ADD> struct EpiGate {
    static constexpr bool PERM = true, AFTER_DRAIN = false;
    const bf16_t* Gt; bf16_t* O;
    __device__ __forceinline__ void operator()(const f32x4 (&acc)[2][2][4][2], const Unit& u, int wr, int wc, int fr, int fq) const {
        const int row0 = u.pm * BM + wr * 64 + fr, col0 = u.pn * BM + wc * 32 + 8 * fq;
#pragma unroll
        for (int ai = 0; ai < 2; ++ai)
#pragma unroll
            for (int m = 0; m < 4; ++m) { const size_t row = (size_t)(row0 + ai * HALF + m * 16);
#pragma unroll
                for (int bj = 0; bj < 2; ++bj) { const u32x4 gw = *(const u32x4*)(Gt + row * 2048 + col0 + bj * HALF); bf16_t* op = O + row * 1024 + col0 + bj * HALF;
                    f32x4 v0 = acc[ai][bj][m][0], v1 = acc[ai][bj][m][1];
                    v0[0] *= bf_lo(gw.x); v0[1] *= bf_hi(gw.x); v0[2] *= bf_lo(gw.y); v0[3] *= bf_hi(gw.y); v1[0] *= bf_lo(gw.z); v1[1] *= bf_hi(gw.z); v1[2] *= bf_lo(gw.w); v1[3] *= bf_hi(gw.w);
                    if (ADD) { const u32x4 t = *(const u32x4*)op; v0[0] += bf_lo(t.x); v0[1] += bf_hi(t.x); v0[2] += bf_lo(t.y); v0[3] += bf_hi(t.y); v1[0] += bf_lo(t.z); v1[1] += bf_hi(t.z); v1[2] += bf_lo(t.w); v1[3] += bf_hi(t.w); }
                    u32x4 w; w.x = cvt_pk_bf16(v0[0], v0[1]); w.y = cvt_pk_bf16(v0[2], v0[3]); w.z = cvt_pk_bf16(v1[0], v1[1]); w.w = cvt_pk_bf16(v1[2], v1[3]);
                    *(u32x4*)op = w; } }
    }
};
struct EpiResF32 {
    static constexpr bool PERM = false, AFTER_DRAIN = false;
    const float* base; float* out;
    __device__ __forceinline__ void operator()(const f32x4 (&acc)[2][2][4][2], const Unit& u, int wr, int wc, int fr, int fq) const {
        const int row0 = u.pm * BM + wr * 64 + fr, col0 = u.pn * BM + wc * 32 + 4 * fq;
#pragma unroll
        for (int ai = 0; ai < 2; ++ai)
#pragma unroll
            for (int m = 0; m < 4; ++m) { const size_t off = (size_t)(row0 + ai * HALF + m * 16) * 1024 + col0;
#pragma unroll
                for (int bj = 0; bj < 2; ++bj)
#pragma unroll
                    for (int n = 0; n < 2; ++n) { const f32x4 bs = *(const f32x4*)(base + off + bj * HALF + n * 16); *(f32x4*)(out + off + bj * HALF + n * 16) = bs + acc[ai][bj][m][n]; }
                if (m & 1) asm volatile("" ::: "memory"); }
    }
};
struct EpiSwiglu {
    static constexpr bool PERM = true, AFTER_DRAIN = false;
    bf16_t* O;
    __device__ __forceinline__ void operator()(const f32x4 (&acc)[2][2][4][2], const Unit& u, int wr, int wc, int fr, int fq) const {
        const int row0 = u.pm * BM + wr * 64 + fr, col0 = u.pn * HALF + wc * 32 + 8 * fq;
#pragma unroll
        for (int ai = 0; ai < 2; ++ai)
#pragma unroll
            for (int m = 0; m < 4; ++m) { bf16_t* op = O + (size_t)(row0 + ai * HALF + m * 16) * 1024 + col0;
                f32x4 h0, h1;
#pragma unroll
                for (int q = 0; q < 4; ++q) { const float a0 = acc[ai][0][m][0][q], a1 = acc[ai][0][m][1][q]; h0[q] = a0 * sigmoidf_fast(a0) * acc[ai][1][m][0][q]; h1[q] = a1 * sigmoidf_fast(a1) * acc[ai][1][m][1][q]; }
                u32x4 w; w.x = cvt_pk_bf16(h0[0], h0[1]); w.y = cvt_pk_bf16(h0[2], h0[3]); w.z = cvt_pk_bf16(h1[0], h1[1]); w.w = cvt_pk_bf16(h1[2], h1[3]);
                *(u32x4*)op = w; }
    }
};
struct EpiDown {
    static constexpr bool PERM = true, AFTER_DRAIN = false;
    bf16_t* O; const float* gv;
    __device__ __forceinline__ void operator()(const f32x4 (&acc)[2][2][4][2], const Unit& u, int wr, int wc, int fr, int fq) const {
        const int row0 = u.pm * BM + wr * 64 + fr, col0 = u.pn * BM + wc * 32 + 8 * fq;
#pragma unroll
        for (int ai = 0; ai < 2; ++ai)
#pragma unroll
            for (int m = 0; m < 4; ++m) { const int row = row0 + ai * HALF + m * 16; const float gsc = gv[row]; bf16_t* op = O + (size_t)row * 1024 + col0;
#pragma unroll
                for (int bj = 0; bj < 2; ++bj) { const f32x4 v0 = acc[ai][bj][m][0] * gsc, v1 = acc[ai][bj][m][1] * gsc;
                    u32x4 w; w.x = cvt_pk_bf16(v0[0], v0[1]); w.y = cvt_pk_bf16(v0[2], v0[3]); w.z = cvt_pk_bf16(v1[0], v1[1]); w.w = cvt_pk_bf16(v1[2], v1[3]);
                    *(u32x4*)(op + bj * HALF) = w; } }
    }
};

template <class Epi, class Sched, bool ALIGN_EPI = false, bool SP2 = false>
__device__ __forceinline__ void gemm_phase(PG8_LAS unsigned char* lds, const Gemm g, const Sched& S, const Epi& E) {
    const int tid = threadIdx.x, wid = __builtin_amdgcn_readfirstlane(tid >> 6), lane = tid & 63, wr = wid >> 2, wc = wid & 3, fr = lane & 15, fq = lane >> 4;
    const int K = g.K, nt = K / BK;
    unsigned voffA[2], voffB[2];
#pragma unroll
    for (int i = 0; i < 2; ++i) { int R, C; stage_rc(tid * 16 + i * 8192, R, C); const int Rb = Epi::PERM ? ((R & ~31) + perm32(R & 31)) : R;
        voffA[i] = (unsigned)(R * g.lda + C) * 2u; voffB[i] = (unsigned)(Rb * g.ldb + C) * 2u; }
    const size_t kstep = (size_t)(BK * 2);
    const size_t hstepA = (size_t)HALF * g.lda * 2, hstepB = (size_t)HALF * g.ldb * 2;
    const size_t tstepA = 2 * hstepA, tstepB = 2 * hstepB;
    const unsigned ldsw = (unsigned)wid * 1024u;
    const int aoff = lds_byte(wr * 64 + fr, fq * 8), boff = lds_byte(wc * 32 + fr, fq * 8);
#define PG8_SA(b, h) (((b) * 2 + (h)) * HTB)
#define PG8_SB(b, h) ((4 + (b) * 2 + (h)) * HTB)
#define PG8_STAGE(bufoff, gbase, voff) do { _Pragma("unroll") for (int _i = 0; _i < 2; ++_i) \
        __builtin_amdgcn_global_load_lds((const unsigned*)((const char*)(gbase) + (voff)[_i]), (PG8_LAS unsigned*)(lds + (bufoff) + ldsw + _i * 8192), 16, 0, 0); } while (0)
#define PG8_LDA(dst, b, h) do { _Pragma("unroll") for (int m = 0; m < 4; ++m) _Pragma("unroll") for (int k = 0; k < 2; ++k) dst[m][k] = *(const PG8_LAS bf16x8*)(lds + PG8_SA(b, h) + aoff + m * 2048 + k * 1024); } while (0)
#define PG8_LDB(dst, b, h) do { _Pragma("unroll") for (int n = 0; n < 2; ++n) _Pragma("unroll") for (int k = 0; k < 2; ++k) dst[n][k] = *(const PG8_LAS bf16x8*)(lds + PG8_SB(b, h) + boff + n * 2048 + k * 1024); } while (0)
#define PG8_MMA(ai, bj, At, Bt) do { __builtin_amdgcn_s_setprio(1); _Pragma("unroll") for (int m = 0; m < 4; ++m) _Pragma("unroll") for (int n = 0; n < 2; ++n) _Pragma("unroll") for (int k = 0; k < 2; ++k) \
        acc[ai][bj][m][n] = __builtin_amdgcn_mfma_f32_16x16x32_bf16(Bt[n][k], At[m][k], acc[ai][bj][m][n], 0, 0, 0); __builtin_amdgcn_s_setprio(0); } while (0)
#define PG8_WAIT_V(n) asm volatile("s_waitcnt vmcnt(" #n ")" ::: "memory")
#define PG8_WAIT_L(n) asm volatile("s_waitcnt lgkmcnt(" #n ")" ::: "memory")
#define PG8_BAR __builtin_amdgcn_s_barrier()
#define PG8_SCHED __builtin_amdgcn_sched_barrier(0)
    Unit cur, nxt; int ui = 0;
    if (!S.next(0, cur)) return;
    f32x4 acc[2][2][4][2];
#pragma unroll
    for (int a = 0; a < 2; ++a)
#pragma unroll
        for (int b = 0; b < 2; ++b)
#pragma unroll
            for (int m = 0; m < 4; ++m)
#pragma unroll
                for (int n = 0; n < 2; ++n) acc[a][b][m][n] = (f32x4){0.f, 0.f, 0.f, 0.f};
    bf16x8 At[4][2], B0[2][2], B1[2][2];
    const char* cA = (const char*)g.A + (size_t)cur.pm * tstepA; const char* cB = (const char*)g.Bt + (size_t)cur.pb * tstepB;
    S.a_ready(cur);
    if constexpr (SP2) {
        PG8_STAGE(PG8_SB(0, 0), cB, voffB); PG8_STAGE(PG8_SB(0, 1), cB + hstepB, voffB); PG8_STAGE(PG8_SA(0, 0), cA, voffA); PG8_STAGE(PG8_SA(0, 1), cA + hstepA, voffA);
        if (wr == 1) PG8_BAR;
        PG8_WAIT_V(2); PG8_BAR;
        PG8_STAGE(PG8_SB(1, 0), cB + kstep, voffB); PG8_STAGE(PG8_SA(1, 0), cA + kstep, voffA); PG8_STAGE(PG8_SB(1, 1), cB + hstepB + kstep, voffB);
        PG8_WAIT_V(6); PG8_BAR;
    } else {
        PG8_STAGE(PG8_SB(0, 0), cB, voffB); PG8_STAGE(PG8_SA(0, 0), cA, voffA); PG8_STAGE(PG8_SB(0, 1), cB + hstepB, voffB); PG8_STAGE(PG8_SA(0, 1), cA + hstepA, voffA);
        if (wr == 1) PG8_BAR;
        PG8_WAIT_V(4); PG8_BAR;
        PG8_STAGE(PG8_SB(1, 0), cB + kstep, voffB); PG8_STAGE(PG8_SA(1, 0), cA + kstep, voffA); PG8_STAGE(PG8_SB(1, 1), cB + hstepB + kstep, voffB);
        PG8_WAIT_V(6); PG8_BAR;
    }
    for (;;) {
        const bool has_next = S.next(ui + 1, nxt);
        const char* nA = has_next ? (const char*)g.A + (size_t)nxt.pm * tstepA : cA; const char* nB = has_next ? (const char*)g.Bt + (size_t)nxt.pb * tstepB : cB;
        for (int t = 0; t < nt; t += 2) {
            const bool last = (t == nt - 2);
            const char* a1 = cA + (size_t)(t + 1) * kstep;
            const char* a2 = last ? nA : cA + (size_t)(t + 2) * kstep; const char* b2 = last ? nB : cB + (size_t)(t + 2) * kstep;
            const char* a3 = a2 + kstep; const char* b3 = b2 + kstep;
            if (last && has_next) S.a_ready(nxt);
            if constexpr (SP2) {
            PG8_LDB(B0, 0, 0); PG8_LDB(B1, 0, 1); PG8_SCHED; PG8_LDA(At, 0, 0); PG8_STAGE(PG8_SA(1, 1), a1 + hstepA, voffA);
            PG8_WAIT_V(8); PG8_WAIT_L(0); PG8_BAR; PG8_MMA(0, 0, At, B0); PG8_MMA(0, 1, At, B1); PG8_BAR; PG8_SCHED;
            PG8_LDA(At, 0, 1); PG8_STAGE(PG8_SB(0, 0), b2, voffB); PG8_STAGE(PG8_SB(0, 1), b2 + hstepB, voffB); PG8_STAGE(PG8_SA(0, 0), a2, voffA);
            PG8_WAIT_V(8); PG8_WAIT_L(0); PG8_BAR; PG8_MMA(1, 0, At, B0); PG8_MMA(1, 1, At, B1); PG8_BAR; PG8_SCHED;
            PG8_LDB(B0, 1, 0); PG8_LDB(B1, 1, 1); PG8_SCHED; PG8_LDA(At, 1, 0); PG8_STAGE(PG8_SA(0, 1), a2 + hstepA, voffA);
            PG8_WAIT_V(8); PG8_WAIT_L(0); PG8_BAR; PG8_MMA(0, 0, At, B0); PG8_MMA(0, 1, At, B1); PG8_BAR; PG8_SCHED;
            PG8_LDA(At, 1, 1); PG8_STAGE(PG8_SB(1, 0), b3, voffB); PG8_STAGE(PG8_SB(1, 1), b3 + hstepB, voffB); PG8_STAGE(PG8_SA(1, 0), a3, voffA);
            PG8_WAIT_V(8); PG8_WAIT_L(0); PG8_BAR; PG8_MMA(1, 0, At, B0); PG8_MMA(1, 1, At, B1); PG8_BAR; PG8_SCHED;
            } else {
            PG8_LDB(B0, 0, 0); PG8_SCHED; PG8_LDA(At, 0, 0); PG8_STAGE(PG8_SA(1, 1), a1 + hstepA, voffA);
            PG8_WAIT_L(8); PG8_BAR; PG8_WAIT_L(0); PG8_MMA(0, 0, At, B0); PG8_BAR; PG8_SCHED;
            PG8_LDB(B1, 0, 1); PG8_STAGE(PG8_SB(0, 0), b2, voffB);
            PG8_BAR; PG8_WAIT_L(0); PG8_MMA(0, 1, At, B1); PG8_BAR;
            PG8_LDA(At, 0, 1); PG8_STAGE(PG8_SA(0, 0), a2, voffA);
            PG8_BAR; PG8_WAIT_L(0); PG8_MMA(1, 0, At, B0); PG8_BAR; PG8_SCHED;
            PG8_STAGE(PG8_SB(0, 1), b2 + hstepB, voffB);
            PG8_WAIT_V(6); PG8_BAR; PG8_MMA(1, 1, At, B1); PG8_BAR;
            PG8_LDB(B0, 1, 0); PG8_SCHED; PG8_LDA(At, 1, 0); PG8_STAGE(PG8_SA(0, 1), a2 + hstepA, voffA);
            PG8_WAIT_L(8); PG8_BAR; PG8_WAIT_L(0); PG8_MMA(0, 0, At, B0); PG8_BAR; PG8_SCHED;
            PG8_LDB(B1, 1, 1); PG8_STAGE(PG8_SB(1, 0), b3, voffB);
            PG8_BAR; PG8_WAIT_L(0); PG8_MMA(0, 1, At, B1); PG8_BAR;
            PG8_LDA(At, 1, 1); PG8_STAGE(PG8_SA(1, 0), a3, voffA);
            PG8_BAR; PG8_WAIT_L(0); PG8_MMA(1, 0, At, B0); PG8_BAR; PG8_SCHED;
            PG8_STAGE(PG8_SB(1, 1), b3 + hstepB, voffB);
            PG8_WAIT_V(6); PG8_BAR; PG8_MMA(1, 1, At, B1); PG8_BAR;
            }
        }
        if constexpr (ALIGN_EPI) { if (wr == 0) PG8_BAR; }
        if constexpr (!Epi::AFTER_DRAIN) { E(acc, cur, wr, wc, fr, fq); S.done(cur); }
        if (!has_next) break;
#pragma unroll
        for (int a = 0; a < 2; ++a)
#pragma unroll
            for (int b = 0; b < 2; ++b)
#pragma unroll
                for (int m = 0; m < 4; ++m)
#pragma unroll
                    for (int n = 0; n < 2; ++n) acc[a][b][m][n] = (f32x4){0.f, 0.f, 0.f, 0.f};
        cur = nxt; cA = nA; cB = nB; ++ui;
        if constexpr (ALIGN_EPI) { if (wr == 1) PG8_BAR; }
    }
    PG8_WAIT_V(0);
    if constexpr (!ALIGN_EPI) { if (wr == 0) PG8_BAR; }
    PG8_BAR;
    if constexpr (Epi::AFTER_DRAIN) { E.fused(acc, cur, wr, wc, fr, fq, lds, wid, lane); S.done(cur); }
#undef PG8_SA
#undef PG8_SB
#undef PG8_STAGE
#undef PG8_LDA
#undef PG8_LDB
#undef PG8_MMA
#undef PG8_WAIT_V
#undef PG8_WAIT_L
#undef PG8_BAR
#undef PG8_SCHED
}
}
#include <hip/hip_bf16.h>
#include <cmath>
namespace attn_body {
using bf16=__hip_bfloat16;
using bf16x8=__attribute__((ext_vector_type(8)))short;
using s16x4=__attribute__((ext_vector_type(4)))short;
using f32x16=__attribute__((ext_vector_type(16)))float;
using u32x4=__attribute__((ext_vector_type(4)))unsigned;
constexpr int BATCH=8,NHEAD=8,NKVH=2,SEQ=8192,D=64,QP=512,KVP=256,OP=768;
constexpr int NW=8,QBLK=32,QB=QBLK*NW,KVBLK=64,NQB=SEQ/QB;
constexpr int ATTN_UNIT_ROWS=QB;
__device__ __forceinline__ int crow(int r,int hi){return (r&3)+8*(r>>2)+4*hi;}
#define SBAR() __builtin_amdgcn_sched_barrier(0)
__device__ __forceinline__ void cmask(f32x16&p0,f32x16&p1,int jb,int qrel,int hi){
  const float NEG=-INFINITY; int kb=64*jb+4*hi;
  #pragma unroll
  for(int r=0;r<16;++r){int kv=kb+(r&3)+8*(r>>2); if(kv>qrel)p0[r]=NEG; if(kv+32>qrel)p1[r]=NEG;}
}

constexpr int NSLOT=3, SLOTB=8192;
constexpr int LDS_K=0, LDS_V=NSLOT*SLOTB, LDS_WS=2*NSLOT*SLOTB, LDS_OST=LDS_WS+NW*64*4, LDS_BYTES=LDS_OST+NW*4096;
constexpr float C2=0.125f*1.4426950408889634f;
__device__ __forceinline__ void glds16(const void*gsrc,unsigned lds_dst){unsigned keep;
  asm volatile("s_mov_b32 %0, m0\n\ts_mov_b32 m0, %2\n\ts_nop 0\n\tglobal_load_lds_dwordx4 %1, off\n\ts_mov_b32 m0, %0":"=&s"(keep):"v"(gsrc),"s"(lds_dst):"memory");}
__device__ __forceinline__ float max3f(float a,float b,float c){float r;asm("v_max3_f32 %0, %1, %2, %3":"=v"(r):"v"(a),"v"(b),"v"(c));return r;}
__device__ __forceinline__ float max2f(float a,float b){float r;asm("v_max_f32_e32 %0, %1, %2":"=v"(r):"v"(a),"v"(b));return r;}
__device__ __forceinline__ float fadd_s(float a,float b){float r;asm("v_add_f32_e32 %0, %1, %2":"=v"(r):"v"(a),"v"(b));return r;}
__device__ __forceinline__ float fsub_s(float a,float b){float r;asm("v_sub_f32_e32 %0, %1, %2":"=v"(r):"v"(a),"v"(b));return r;}
typedef float f32x2_t __attribute__((ext_vector_type(2))); typedef __bf16 bf16x2_t __attribute__((ext_vector_type(2)));
__device__ __forceinline__ unsigned cvtpk_s(float lo,float hi){f32x2_t v={lo,hi};bf16x2_t b=__builtin_convertvector(v,bf16x2_t);return __builtin_bit_cast(unsigned,b);}
#define WAIT_BAR(N) asm volatile("s_waitcnt vmcnt(" #N ") lgkmcnt(0)\n\ts_barrier":::"memory")

__device__ __forceinline__ void qkt(f32x16&p0,f32x16&p1,const char*Kslot,const bf16x8*qr,const f32x16&negm,int r32,int hi){
  const char*kb=Kslot+hi*1024+r32*16;
  #pragma unroll
  for(int d0=0;d0<4;++d0){
    const bf16x8 b0=*reinterpret_cast<const bf16x8*>(kb+d0*2048);
    const bf16x8 b1=*reinterpret_cast<const bf16x8*>(kb+d0*2048+512);
    if(d0==0){p0=__builtin_amdgcn_mfma_f32_32x32x16_bf16(b0,qr[0],negm,0,0,0);p1=__builtin_amdgcn_mfma_f32_32x32x16_bf16(b1,qr[0],negm,0,0,0);}
    else{p0=__builtin_amdgcn_mfma_f32_32x32x16_bf16(b0,qr[d0],p0,0,0,0);p1=__builtin_amdgcn_mfma_f32_32x32x16_bf16(b1,qr[d0],p1,0,0,0);}}
}
typedef __attribute__((address_space(3))) const char* lds_cptr;
typedef short v4i16_t __attribute__((ext_vector_type(4)));
__device__ __forceinline__ void kload8(bf16x8*kf,lds_cptr kp){
  kf[0]=*(const __attribute__((address_space(3))) bf16x8*)(kp);      kf[1]=*(const __attribute__((address_space(3))) bf16x8*)(kp+512);
  kf[2]=*(const __attribute__((address_space(3))) bf16x8*)(kp+2048); kf[3]=*(const __attribute__((address_space(3))) bf16x8*)(kp+2560);
  kf[4]=*(const __attribute__((address_space(3))) bf16x8*)(kp+4096); kf[5]=*(const __attribute__((address_space(3))) bf16x8*)(kp+4608);
  kf[6]=*(const __attribute__((address_space(3))) bf16x8*)(kp+6144); kf[7]=*(const __attribute__((address_space(3))) bf16x8*)(kp+6656);
}
__device__ __forceinline__ void kload2(bf16x8*kf,lds_cptr kp,int j){ kf[2*j]=*(const __attribute__((address_space(3))) bf16x8*)(kp+j*2048); kf[2*j+1]=*(const __attribute__((address_space(3))) bf16x8*)(kp+j*2048+512); }
__device__ __forceinline__ s16x4 vtr(lds_cptr p){ return __builtin_bit_cast(s16x4,__builtin_amdgcn_ds_read_tr16_b64_v4i16((__attribute__((address_space(3))) v4i16_t*)p)); }
__device__ __forceinline__ float rowmax(const f32x16&p0,const f32x16&p1){
  float a=max3f(p0[0],p0[1],p1[0]),b=max3f(p0[2],p0[3],p1[1]);a=max3f(a,p1[2],p1[3]);
  #pragma unroll
  for(int r=4;r<16;r+=4){a=max3f(a,p0[r],p0[r+1]);b=max3f(b,p0[r+2],p0[r+3]);a=max3f(a,p1[r],p1[r+1]);b=max3f(b,p1[r+2],p1[r+3]);}
  const float m=max2f(a,b);
  auto rr=__builtin_amdgcn_permlane32_swap(__float_as_uint(m),__float_as_uint(m),false,false);
  return max2f(__uint_as_float(rr[0]),__uint_as_float(rr[1]));
}
__device__ __forceinline__ void pv(f32x16*o,int vb,bf16x8 pa0,bf16x8 pa1,bf16x8 pa2,bf16x8 pa3){
  #pragma unroll
  for(int d0=0;d0<2;++d0){s16x4 lo[4],hi[4];
    #pragma unroll
    for(int ks=0;ks<4;++ks){
      asm volatile("ds_read_b64_tr_b16 %0,%1 offset:%c2":"=&v"(lo[ks]):"v"(vb),"i"(d0*4096+ks*1024):"memory");
      asm volatile("ds_read_b64_tr_b16 %0,%1 offset:%c2":"=&v"(hi[ks]):"v"(vb),"i"(d0*4096+ks*1024+512):"memory");}
    asm volatile("s_waitcnt lgkmcnt(0)":::"memory");SBAR();
    #define PK(k) (bf16x8){lo[k][0],lo[k][1],lo[k][2],lo[k][3],hi[k][0],hi[k][1],hi[k][2],hi[k][3]}
    o[d0]=__builtin_amdgcn_mfma_f32_32x32x16_bf16(pa0,PK(0),o[d0],0,0,0);
    o[d0]=__builtin_amdgcn_mfma_f32_32x32x16_bf16(pa1,PK(1),o[d0],0,0,0);
    o[d0]=__builtin_amdgcn_mfma_f32_32x32x16_bf16(pa2,PK(2),o[d0],0,0,0);
    o[d0]=__builtin_amdgcn_mfma_f32_32x32x16_bf16(pa3,PK(3),o[d0],0,0,0);
    #undef PK
  }
}

#ifndef ATTN_STORE16
#define ATTN_STORE16(p,v) (*(u32x4*)(p)=(v))
#endif
template<int THRL> __device__ __forceinline__ void attn_unit(int b,int h,int qb,const bf16*Q,const bf16*__restrict__ K,const bf16*__restrict__ V,bf16*O,char*shm){
  const int tid=threadIdx.x,lane=tid&63,r32=lane&31,hi=lane>>5; const int wid=__builtin_amdgcn_readfirstlane(tid>>6);
  const long rowbase=(long)b*SEQ; const int q0=qb*QB;
  const bf16*Qw=Q+(rowbase+q0+wid*QBLK)*QP+h*D;
  const bf16*Kh=K+rowbase*KVP+(h>>2)*D,*Vh=V+rowbase*KVP+(h>>2)*D;
  const unsigned lds0=(unsigned)(uintptr_t)shm;
  float*wsf=(float*)(shm+LDS_WS)+wid*64;
  const bf16*ksrc=Kh+(long)lane*KVP+wid*8;
  const bf16*vsrc=Vh+(long)(16*(wid&3)+(lane>>2))*KVP+(wid>>2)*32+(lane&3)*8;
  const unsigned kdst=lds0+LDS_K+wid*1024, vdst=lds0+LDS_V+wid*1024;
  #define DMA_K(t,slot) glds16(ksrc+(long)(t)*KVBLK*KVP,(unsigned)__builtin_amdgcn_readfirstlane(kdst+(slot)))
  #define DMA_V(t,slot) glds16(vsrc+(long)(t)*KVBLK*KVP,(unsigned)__builtin_amdgcn_readfirstlane(vdst+(slot)))
  const int vb0=(int)(lds0+LDS_V)+((lane>>4)&1)*32+(lane&3)*8+(4*hi+((lane&15)>>2))*64;
  const char*Kbase=shm+LDS_K; bf16x8 kf[8];
  const lds_cptr shm3=(lds_cptr)shm; const lds_cptr kp0=shm3+LDS_K+hi*1024+r32*16; const lds_cptr vp0=shm3+LDS_V+((lane>>4)&1)*32+(lane&3)*8+(4*hi+((lane&15)>>2))*64;
  const int NT=SEQ/KVBLK;
  DMA_K(0,0);DMA_V(0,0);DMA_K(1,SLOTB);
  bf16x8 qr[4];
  #pragma unroll
  for(int d0=0;d0<4;++d0)qr[d0]=*reinterpret_cast<const bf16x8*>(&Qw[(long)r32*QP+d0*16+hi*8]);
  float mhat=0.f,l_reg=0.f;f32x16 o[2];o[0]=f32x16{};o[1]=f32x16{};f32x16 negm=f32x16{};asm volatile("":"+v"(negm));
    #define CMASK(P0,P1,t) do{}while(0)
  bool resc=false;
  #define START(P0,P1) do{ const float rm=rowmax(P0,P1); resc=false; \
    { const float dl=rm; mhat=fadd_s(mhat,dl); \
      _Pragma("unroll") for(int r=0;r<16;++r){P0[r]=fsub_s(P0[r],dl);P1[r]=fsub_s(P1[r],dl);} \
      _Pragma("unroll") for(int r=0;r<16;++r)negm[r]=-mhat; asm volatile("":"+v"(negm)); } \
    _Pragma("unroll") for(int r=0;r<16;++r)P0[r]=__builtin_amdgcn_exp2f(P0[r]); }while(0)
  #define RESC() do{ if(resc){ asm volatile("s_waitcnt lgkmcnt(0)":::"memory"); \
      _Pragma("unroll") for(int d_=0;d_<2;++d_) _Pragma("unroll") for(int r=0;r<16;++r)o[d_][r]*=wsf[crow(r,hi)]; } }while(0)
  f32x16 pA0,pA1,pB0,pB1;
  int sl_prev=0,sl_cur=0,sl_next=SLOTB;
  #define ROT() do{sl_prev=sl_cur;sl_cur=sl_next;sl_next=(sl_next==(NSLOT-1)*SLOTB)?0:sl_next+SLOTB;}while(0)
  DMA_K(2,2*SLOTB);
  WAIT_BAR(3);
  qkt(pA0,pA1,Kbase,qr,negm,r32,hi);asm volatile("s_nop 15\n\ts_nop 7":"+v"(pA0),"+v"(pA1));CMASK(pA0,pA1,0);
  START(pA0,pA1);
  _Pragma("unroll") for(int r=0;r<16;++r)pA1[r]=__builtin_amdgcn_exp2f(pA1[r]);
  WAIT_BAR(0);
  DMA_K(3,0);DMA_V(1,SLOTB);
  ROT();
  kload8(kf,kp0+sl_cur);
  WAIT_BAR(2);
  s16x4 vlo[8],vhi[8]; u32x4 pw0,pw1,pw2,pw3;
  #define PKW(P,B) cvtpk_s(P[B],P[B+1])
  #define PAF(k) __builtin_bit_cast(bf16x8,pw##k)
  #define VFR(i) (bf16x8){vlo[i][0],vlo[i][1],vlo[i][2],vlo[i][3],vhi[i][0],vhi[i][1],vhi[i][2],vhi[i][3]}
  #define PIN(x) asm volatile("":"+v"(x))
  #define MX3(a,b,c) __builtin_fmaxf(__builtin_fmaxf((a),(b)),(c))
  #define GAPA(MF,A0,A1,A2,A3,W0,W1,PW) do{ MF; sacc+=A0; sacc+=A1; sacc+=A2; sacc+=A3; PIN(sacc); W0; W1; PIN(PW); SBAR(); }while(0)
  #define EX(v) __builtin_amdgcn_exp2f(v)
  #define GAPB(MF,X,B) do{ MF; X[B]=EX(X[B]); X[B+1]=EX(X[B+1]); X[B+2]=EX(X[B+2]); X[B+3]=EX(X[B+3]); PIN(X); SBAR(); }while(0)
  #define VRD(i) do{ vlo[i]=vtr(vp_+(((i)>>2)*4096+((i)&3)*1024)); vhi[i]=vtr(vp_+(((i)>>2)*4096+((i)&3)*1024+512)); }while(0)
  #define KRD(G,j) do{ if(G){ kload2(kf,kp0+sl_next,j); SBAR(); } }while(0)
  #define STEP(C0,C1,P0,P1,t,GK,GV,GL) do{ SBAR(); \
    const lds_cptr vp_=vp0+sl_prev; \
    VRD(0); SBAR(); float sacc=(P0[0]+P0[1]); \
    GAPA(C0=__builtin_amdgcn_mfma_f32_32x32x16_bf16(kf[0],qr[0],negm,0,0,0), P0[2],P0[3],P0[4],P0[5],     pw0[0]=PKW(P0,0), pw0[1]=PKW(P0,2), pw0); \
    VRD(4); SBAR(); GAPA(C1=__builtin_amdgcn_mfma_f32_32x32x16_bf16(kf[1],qr[0],negm,0,0,0), P0[6],P0[7],P0[8],P0[9],     pw0[2]=PKW(P0,4), pw0[3]=PKW(P0,6), pw0); \
    VRD(1); SBAR(); GAPA(C0=__builtin_amdgcn_mfma_f32_32x32x16_bf16(kf[2],qr[1],C0,0,0,0),   P0[10],P0[11],P0[12],P0[13], pw1[0]=PKW(P0,8), pw1[1]=PKW(P0,10), pw1); \
    VRD(5); SBAR(); GAPA(C1=__builtin_amdgcn_mfma_f32_32x32x16_bf16(kf[3],qr[1],C1,0,0,0),   P0[14],P0[15],P1[0],P1[1],   pw1[2]=PKW(P0,12),pw1[3]=PKW(P0,14), pw1); \
    VRD(2); SBAR(); GAPA(C0=__builtin_amdgcn_mfma_f32_32x32x16_bf16(kf[4],qr[2],C0,0,0,0),   P1[2],P1[3],P1[4],P1[5],     pw2[0]=PKW(P1,0), pw2[1]=PKW(P1,2), pw2); \
    VRD(6); SBAR(); GAPA(C1=__builtin_amdgcn_mfma_f32_32x32x16_bf16(kf[5],qr[2],C1,0,0,0),   P1[6],P1[7],P1[8],P1[9],     pw2[2]=PKW(P1,4), pw2[3]=PKW(P1,6), pw2); \
    VRD(3); SBAR(); GAPA(C0=__builtin_amdgcn_mfma_f32_32x32x16_bf16(kf[6],qr[3],C0,0,0,0),   P1[10],P1[11],P1[12],P1[13], pw3[0]=PKW(P1,8), pw3[1]=PKW(P1,10), pw3); \
    VRD(7); SBAR(); GAPA(C1=__builtin_amdgcn_mfma_f32_32x32x16_bf16(kf[7],qr[3],C1,0,0,0),   P1[14],P1[15],0.f,0.f,       pw3[2]=PKW(P1,12),pw3[3]=PKW(P1,14), pw3); \
    l_reg+=sacc; \
    if(GK){DMA_K((t)+3,sl_cur);} if(GV){DMA_V((t)+1,sl_next);} \
    CMASK(C0,C1,t); \
    { float a=MX3(C0[0],C0[1],C1[0]),b=MX3(C0[2],C0[3],C1[1]); a=MX3(a,C1[2],C1[3]); \
      _Pragma("unroll") for(int r=4;r<16;r+=4){a=MX3(a,C0[r],C0[r+1]);b=MX3(b,C0[r+2],C0[r+3]);a=MX3(a,C1[r],C1[r+1]);b=MX3(b,C1[r+2],C1[r+3]);} \
      float rm=__builtin_fmaxf(a,b); { auto rr=__builtin_amdgcn_permlane32_swap(__float_as_uint(rm),__float_as_uint(rm),false,false); rm=__builtin_fmaxf(__uint_as_float(rr[0]),__uint_as_float(rr[1])); } \
      resc=false; \
      if(__builtin_expect(__any(rm>(float)THRL),0)){ const float dl=__builtin_fmaxf(rm,0.f); mhat+=dl; \
        _Pragma("unroll") for(int r=0;r<16;++r){C0[r]-=dl;C1[r]-=dl;} \
        _Pragma("unroll") for(int r=0;r<16;++r)negm[r]=-mhat; asm volatile("":"+v"(negm)); \
        const float f=__builtin_amdgcn_exp2f(-dl); l_reg*=f; if(hi==0)wsf[r32]=f; resc=true; } } \
    SBAR(); \
    GAPB(o[0]=__builtin_amdgcn_mfma_f32_32x32x16_bf16(PAF(0),VFR(0),o[0],0,0,0), C0,0); \
    GAPB(o[1]=__builtin_amdgcn_mfma_f32_32x32x16_bf16(PAF(0),VFR(4),o[1],0,0,0), C0,4); \
    KRD(GL,0); GAPB(o[0]=__builtin_amdgcn_mfma_f32_32x32x16_bf16(PAF(1),VFR(1),o[0],0,0,0), C0,8); \
    KRD(GL,1); GAPB(o[1]=__builtin_amdgcn_mfma_f32_32x32x16_bf16(PAF(1),VFR(5),o[1],0,0,0), C0,12); \
    KRD(GL,2); GAPB(o[0]=__builtin_amdgcn_mfma_f32_32x32x16_bf16(PAF(2),VFR(2),o[0],0,0,0), C1,0); \
    KRD(GL,3); GAPB(o[1]=__builtin_amdgcn_mfma_f32_32x32x16_bf16(PAF(2),VFR(6),o[1],0,0,0), C1,4); \
    GAPB(o[0]=__builtin_amdgcn_mfma_f32_32x32x16_bf16(PAF(3),VFR(3),o[0],0,0,0), C1,8); \
    GAPB(o[1]=__builtin_amdgcn_mfma_f32_32x32x16_bf16(PAF(3),VFR(7),o[1],0,0,0), C1,12); \
    }while(0)
  int t=1;
  #undef CMASK
  #define CMASK(P0,P1,t) do{}while(0)
  for(;t+5<NT;t+=2){
    STEP(pB0,pB1,pA0,pA1,t,true,true,true);     WAIT_BAR(2); RESC(); ROT();
    STEP(pA0,pA1,pB0,pB1,t+1,true,true,true);   WAIT_BAR(2); RESC(); ROT();
  }
  #undef CMASK
  #define CMASK(P0,P1,t) do{}while(0)
  #define ENDW(tt) do{ if((tt)+3<NT){WAIT_BAR(2);} else if((tt)+2<NT){WAIT_BAR(1);} else {WAIT_BAR(0);} }while(0)
  for(;t+1<NT;t+=2){
    STEP(pB0,pB1,pA0,pA1,t,(t+3<NT),(t+1<NT),(t+1<NT));       ENDW(t);   RESC(); ROT();
    STEP(pA0,pA1,pB0,pB1,t+1,(t+4<NT),(t+2<NT),(t+2<NT));     ENDW(t+1); RESC(); ROT();
  }
  STEP(pB0,pB1,pA0,pA1,NT-1,false,false,false); RESC();
  { float sacc=pB0[0]+pB0[1]; _Pragma("unroll") for(int r=2;r<16;++r)sacc+=pB0[r]; _Pragma("unroll") for(int r=0;r<16;++r)sacc+=pB1[r]; l_reg+=sacc;
    pw0=(u32x4){PKW(pB0,0),PKW(pB0,2),PKW(pB0,4),PKW(pB0,6)};pw1=(u32x4){PKW(pB0,8),PKW(pB0,10),PKW(pB0,12),PKW(pB0,14)};pw2=(u32x4){PKW(pB1,0),PKW(pB1,2),PKW(pB1,4),PKW(pB1,6)};pw3=(u32x4){PKW(pB1,8),PKW(pB1,10),PKW(pB1,12),PKW(pB1,14)};
    SBAR(); pv(o,vb0+sl_cur,PAF(0),PAF(1),PAF(2),PAF(3)); }
  #undef PKW
  #undef PAF
  #undef VFR
  #undef PIN
  #undef MX3
  #undef GAPA
  #undef GAPB
  #undef EX
  #undef VRD
  #undef KRD
  #undef STEP
  #undef ENDW
  {auto rr=__builtin_amdgcn_permlane32_swap(__float_as_uint(l_reg),__float_as_uint(l_reg),false,false);l_reg=__uint_as_float(rr[0])+__uint_as_float(rr[1]);}
  if(hi==0)wsf[32+r32]=l_reg;asm volatile("s_waitcnt lgkmcnt(0)":::"memory");
  float rli[16];
  #pragma unroll
  for(int r=0;r<16;++r)rli[r]=__builtin_amdgcn_rcpf(wsf[32+crow(r,hi)]);
  bf16*Ow=O+(rowbase+q0+wid*QBLK)*OP+h*D;
  { bf16*stg=(bf16*)(shm+LDS_OST)+wid*2048;
    #pragma unroll
    for(int r=0;r<16;++r){const int orow=crow(r,hi);
      #pragma unroll
      for(int d0=0;d0<2;++d0)stg[orow*64+d0*32+r32]=__float2bfloat16(o[d0][r]*rli[r]);}
    asm volatile("s_waitcnt lgkmcnt(0)":::"memory");
    #pragma unroll
    for(int i=0;i<4;++i){const int row=i*8+(lane>>3),ch=lane&7; const u32x4 v=*(const u32x4*)(stg+row*64+ch*8); ATTN_STORE16(Ow+(long)row*OP+ch*8,v);} }
  asm volatile("s_waitcnt lgkmcnt(0)\n\ts_barrier":::"memory");
  #undef DMA_K
  #undef DMA_V
  #undef CMASK
  #undef START
  #undef RESC
  #undef ROT
}
constexpr int ATTN_LDS_BYTES=LDS_BYTES;
struct AttnTensors { const bf16* Q; const bf16* K; const bf16* V; bf16* O; };
struct AttnUnit { int b; int h; int qb; };
struct StaticOrder {
  int vcu, G;
  __device__ __forceinline__ StaticOrder(int grid,int vcu_):vcu(vcu_),G(grid){}
  __device__ __forceinline__ bool next(int i,AttnUnit&u)const{ const int L=i*G+vcu; if(L>=BATCH*NHEAD*NQB)return false;
    const int rnd=L>>8, x=(L>>5)&7, w=L&31; const int pair=x*2+(rnd>>2); const int uu=(rnd&3)*32+w;
    u.b=pair>>1; u.h=(pair&1)*4+(uu>>5); u.qb=uu&31; return true; }
};
template<class Sched,int THRL=8> __device__ __forceinline__ void attn_phase(char*lds,const AttnTensors&T,const Sched&S){
  AttnUnit u;
  for(int i=0;S.next(i,u);++i){ attn_unit<THRL>(u.b,u.h,u.qb,T.Q,T.K,T.V,T.O,lds); }
}
#undef SBAR
#undef WAIT_BAR
}
namespace attnb {
using attn_body::bf16; using attn_body::bf16x8; using attn_body::s16x4; using attn_body::f32x16; using attn_body::u32x4; using attn_body::lds_cptr;
using attn_body::crow; using attn_body::glds16; using attn_body::cvtpk_s; using attn_body::kload8;
constexpr int SEQ = 8192, PB = 768, OP = 768, OCOL = 512;
#define ATB_MX3(a,b,c) __builtin_fmaxf(__builtin_fmaxf((a),(b)),(c))
__device__ __forceinline__ void pvb(f32x16*o,int vb,bf16x8 pa0,bf16x8 pa1,bf16x8 pa2,bf16x8 pa3){
  #pragma unroll
  for(int d0=0;d0<2;++d0){s16x4 lo[4],hi[4];
    #pragma unroll
    for(int ks=0;ks<4;++ks){
      asm volatile("ds_read_b64_tr_b16 %0,%1 offset:%c2":"=&v"(lo[ks]):"v"(vb),"i"(d0*4096+ks*1024):"memory");
      asm volatile("ds_read_b64_tr_b16 %0,%1 offset:%c2":"=&v"(hi[ks]):"v"(vb),"i"(d0*4096+ks*1024+512):"memory");}
    asm volatile("s_waitcnt lgkmcnt(0)":::"memory");__builtin_amdgcn_sched_barrier(0);
    #define ATB_PK(k) (bf16x8){lo[k][0],lo[k][1],lo[k][2],lo[k][3],hi[k][0],hi[k][1],hi[k][2],hi[k][3]}
    o[d0]=__builtin_amdgcn_mfma_f32_32x32x16_bf16(pa0,ATB_PK(0),o[d0],0,0,0);
    o[d0]=__builtin_amdgcn_mfma_f32_32x32x16_bf16(pa1,ATB_PK(1),o[d0],0,0,0);
    o[d0]=__builtin_amdgcn_mfma_f32_32x32x16_bf16(pa2,ATB_PK(2),o[d0],0,0,0);
    o[d0]=__builtin_amdgcn_mfma_f32_32x32x16_bf16(pa3,ATB_PK(3),o[d0],0,0,0);
    #undef ATB_PK
  }
}
__device__ __forceinline__ void attnb_job(int b,int j,int tt,const bf16*Qb,const bf16*__restrict__ Kb,const bf16*__restrict__ Vb,bf16*O,char*wl,float*wsf){
  const int lane=threadIdx.x&63,r32=lane&31,hi=lane>>5;
  const long rowbase=(long)b*SEQ; const int T0=(tt>>4)*512+(tt&15);
  const unsigned lds0=(unsigned)__builtin_amdgcn_readfirstlane((int)(unsigned)(uintptr_t)wl);
  const lds_cptr kp0=(lds_cptr)wl+hi*1024+r32*16;
  const int vb0=(int)(lds0+8192u)+((lane>>4)&1)*32+(lane&3)*8+(4*hi+((lane&15)>>2))*64;
  float m_run=-INFINITY,l_run=0.f; f32x16 o[2]; o[0]=f32x16{}; o[1]=f32x16{};
  #pragma unroll 1
  for(int g=0;g<3;++g){
    const int sh=2*g,d=1<<sh,stride=16>>sh,ntile=(g==0)?10:((g==1)?4:3),hq=g*4+j;
    const float slope2=exp2f(-8.0f*(float)(hq+1)/12.0f)*(float)d*1.4426950408889634f;
    const int rc=T0&(d-1),s0=T0>>sh,sk0=s0-64,smax=(SEQ>>sh)-1,sq=s0+stride*r32;
    const bf16*Qw=Qb+(rowbase+T0+16*r32)*PB+hq*64;
    bf16x8 qr[4];
    #pragma unroll
    for(int d0=0;d0<4;++d0)qr[d0]=*reinterpret_cast<const bf16x8*>(Qw+d0*16+hi*8);
    const float lo_f=(float)max(-64,-sq),hi_f=(float)min(64,smax-sq);
    const bf16*Kg=Kb+(rowbase+rc)*PB+hq*64; const bf16*Vg=Vb+(rowbase+rc)*PB+hq*64+(lane&3)*8;
    #define ATB_DMAK(tau) do{ int s_=sk0+64*(tau)+lane; s_=min(max(s_,0),smax); const bf16*src_=Kg+(long)(d*s_)*PB; \
        _Pragma("unroll") for(int c_=0;c_<8;++c_)glds16(src_+c_*8,lds0+c_*1024u); }while(0)
    #define ATB_DMAV(tau) do{ _Pragma("unroll") for(int kg_=0;kg_<4;++kg_){ int s_=sk0+64*(tau)+16*kg_+(lane>>2); s_=min(max(s_,0),smax); const bf16*src_=Vg+(long)(d*s_)*PB; \
        glds16(src_,lds0+8192u+kg_*1024u); glds16(src_+32,lds0+8192u+(4+kg_)*1024u);} }while(0)
    ATB_DMAK(0); ATB_DMAV(0);
    #pragma unroll 1
    for(int tau=0;tau<ntile;++tau){
      asm volatile("s_waitcnt vmcnt(8)":::"memory");
      bf16x8 kf[8]; kload8(kf,kp0);
      asm volatile("s_waitcnt lgkmcnt(0)":::"memory");
      const bool more=(tau+1<ntile);
      if(more){ATB_DMAK(tau+1);}
      f32x16 p0=f32x16{},p1=f32x16{};
      #pragma unroll
      for(int d0=0;d0<4;++d0){ p0=__builtin_amdgcn_mfma_f32_32x32x16_bf16(kf[2*d0],qr[d0],p0,0,0,0); p1=__builtin_amdgcn_mfma_f32_32x32x16_bf16(kf[2*d0+1],qr[d0],p1,0,0,0); }
      const float basef=(float)(64*tau-64-stride*r32+4*hi);
      #pragma unroll
      for(int r=0;r<16;++r){ const float c0=basef+(float)((r&3)+8*(r>>2)),c1=c0+32.0f;
        p0[r]=(c0>=lo_f&&c0<=hi_f)?__builtin_fmaf(-slope2,__builtin_fabsf(c0),p0[r]):-INFINITY;
        p1[r]=(c1>=lo_f&&c1<=hi_f)?__builtin_fmaf(-slope2,__builtin_fabsf(c1),p1[r]):-INFINITY; }
      float rm;
      { float a=ATB_MX3(p0[0],p0[1],p1[0]),bb=ATB_MX3(p0[2],p0[3],p1[1]); a=ATB_MX3(a,p1[2],p1[3]);
        #pragma unroll
        for(int r=4;r<16;r+=4){a=ATB_MX3(a,p0[r],p0[r+1]);bb=ATB_MX3(bb,p0[r+2],p0[r+3]);a=ATB_MX3(a,p1[r],p1[r+1]);bb=ATB_MX3(bb,p1[r+2],p1[r+3]);}
        rm=__builtin_fmaxf(a,bb); auto rr=__builtin_amdgcn_permlane32_swap(__float_as_uint(rm),__float_as_uint(rm),false,false); rm=__builtin_fmaxf(__uint_as_float(rr[0]),__uint_as_float(rr[1])); }
      const float m_new=__builtin_fmaxf(m_run,rm); const float m_safe=(m_new==-INFINITY)?0.0f:m_new;
      const float alpha=__builtin_amdgcn_exp2f(m_run-m_safe);
      float sum=0.f;
      #pragma unroll
      for(int r=0;r<16;++r){ p0[r]=__builtin_amdgcn_exp2f(p0[r]-m_safe); p1[r]=__builtin_amdgcn_exp2f(p1[r]-m_safe); sum+=p0[r]+p1[r]; }
      l_run=l_run*alpha+sum; m_run=m_new;
      if(hi==0)wsf[r32]=alpha;
      asm volatile("s_waitcnt lgkmcnt(0)":::"memory");
      #pragma unroll
      for(int r=0;r<16;++r){ const float f=wsf[crow(r,hi)]; o[0][r]*=f; o[1][r]*=f; }
      u32x4 pw0,pw1,pw2,pw3;
      pw0=(u32x4){cvtpk_s(p0[0],p0[1]),cvtpk_s(p0[2],p0[3]),cvtpk_s(p0[4],p0[5]),cvtpk_s(p0[6],p0[7])};
      pw1=(u32x4){cvtpk_s(p0[8],p0[9]),cvtpk_s(p0[10],p0[11]),cvtpk_s(p0[12],p0[13]),cvtpk_s(p0[14],p0[15])};
      pw2=(u32x4){cvtpk_s(p1[0],p1[1]),cvtpk_s(p1[2],p1[3]),cvtpk_s(p1[4],p1[5]),cvtpk_s(p1[6],p1[7])};
      pw3=(u32x4){cvtpk_s(p1[8],p1[9]),cvtpk_s(p1[10],p1[11]),cvtpk_s(p1[12],p1[13]),cvtpk_s(p1[14],p1[15])};
      if(more){asm volatile("s_waitcnt vmcnt(8)":::"memory");}else{asm volatile("s_waitcnt vmcnt(0)":::"memory");}
      pvb(o,vb0,__builtin_bit_cast(bf16x8,pw0),__builtin_bit_cast(bf16x8,pw1),__builtin_bit_cast(bf16x8,pw2),__builtin_bit_cast(bf16x8,pw3));
      if(more){ATB_DMAV(tau+1);}
    }
    #undef ATB_DMAK
    #undef ATB_DMAV
  }
  {auto rr=__builtin_amdgcn_permlane32_swap(__float_as_uint(l_run),__float_as_uint(l_run),false,false);l_run=__uint_as_float(rr[0])+__uint_as_float(rr[1]);}
  if(hi==0)wsf[32+r32]=l_run;
  asm volatile("s_waitcnt lgkmcnt(0)":::"memory");
  float rli[16];
  #pragma unroll
  for(int r=0;r<16;++r)rli[r]=__builtin_amdgcn_rcpf(wsf[32+crow(r,hi)]);
  { bf16*stg=(bf16*)wl;
    #pragma unroll
    for(int r=0;r<16;++r){const int orow=crow(r,hi);
      #pragma unroll
      for(int d0=0;d0<2;++d0)stg[orow*64+d0*32+r32]=__float2bfloat16(o[d0][r]*rli[r]);}
    asm volatile("s_waitcnt lgkmcnt(0)":::"memory");
    bf16*Ow=O+(rowbase+T0)*OP+OCOL+j*64;
    #pragma unroll
    for(int i=0;i<4;++i){const int row=i*8+(lane>>3),ch=lane&7; const u32x4 v=*(const u32x4*)(stg+row*64+ch*8); *(u32x4*)(Ow+(long)(16*row)*OP+ch*8)=v;} }
  asm volatile("s_waitcnt lgkmcnt(0)":::"memory");
}
#undef ATB_MX3
}
constexpr int NWAVES = 8;
#ifndef MK_N_LAUNCHES
#define MK_N_LAUNCHES 1
#endif
constexpr int N_PHASES = 12;
constexpr int N_LAUNCHES = MK_N_LAUNCHES;

constexpr int BATCH = 8, SEQ = 8192, DM = 1024, M = BATCH * SEQ;
constexpr int N_IN = 5120, NE = 16, FF = 1024, CAP = 1024, MR = BATCH * NE * CAP;
constexpr float NORM_EPS = 1e-6f;

constexpr size_t MiB = 1u << 20;
constexpr size_t WS_CTL = 0, CTL_ZERO_BYTES = 1 * MiB;
constexpr size_t WS_AFF = 1 * MiB;
constexpr size_t WS_TOPI = 5 * MiB, WS_TOPG = WS_TOPI + 512 * 1024;
constexpr size_t WS_TSLOT = 6 * MiB;
constexpr size_t WS_WIN = 10 * MiB;
constexpr size_t WS_WO = 20 * MiB;
constexpr size_t WS_WOUT = 22 * MiB;
constexpr size_t WS_WGU = 24 * MiB;
constexpr size_t WS_WD = 88 * MiB;
constexpr size_t WS_XN = 120 * MiB;
constexpr size_t WS_QA = 248 * MiB, WS_KVA = 312 * MiB, WS_QB = 344 * MiB, WS_KB = 440 * MiB, WS_VB = 536 * MiB, WS_G = 632 * MiB;
constexpr size_t WS_OAB = 888 * MiB;
constexpr size_t WS_XG = 248 * MiB, WS_ACT = 504 * MiB, WS_Y = 760 * MiB;
constexpr size_t WS_END = 1016 * MiB;
static_assert(WS_WD + 32 * MiB <= WS_XN && WS_XN + 128 * MiB <= WS_QA && WS_G + 256 * MiB <= WS_OAB && WS_OAB + 96 * MiB <= WS_END && WS_Y + 256 * MiB <= WS_END, "d_ws map");
constexpr int CW_BAR = 4096;

constexpr int RING_OFF = 0, RING_BYTES = 131072;
constexpr int WSF_OFF = RING_BYTES;
constexpr int LDSCTL_OFF = RING_BYTES + 2048, MISC_OFF = LDSCTL_OFF + 320;
constexpr int LDS_BYTES = 147456;
static_assert(MISC_OFF + 128 <= LDS_BYTES, "LDS map");

#define GAS __attribute__((address_space(1)))
#define LAS __attribute__((address_space(3)))
typedef unsigned short bf16;
typedef unsigned v4u __attribute__((ext_vector_type(4)));
typedef float f32x4 __attribute__((ext_vector_type(4)));
typedef short bf16x8 __attribute__((ext_vector_type(8)));
typedef GAS unsigned gu32;
typedef GAS unsigned long long gu64;
#define RLX_AGENT __ATOMIC_RELAXED, __HIP_MEMORY_SCOPE_AGENT
#define LDS_WAIT() asm volatile("s_waitcnt lgkmcnt(0)" ::: "memory")
#define VM_WAIT() asm volatile("s_waitcnt vmcnt(0)" ::: "memory")
__device__ __forceinline__ unsigned long long rt() { return __builtin_amdgcn_s_memrealtime(); }
__device__ __forceinline__ unsigned f2bf(float f) { unsigned u = __builtin_bit_cast(unsigned, f); return (u + 0x7fffu + ((u >> 16) & 1u)) >> 16; }
__device__ __forceinline__ unsigned pk2(float lo, float hi) { return f2bf(lo) | (f2bf(hi) << 16); }

#define XB_TMO      128
#define XB_XCNT(j)  (256  + 64 * (j))
#define XB_XSUB(j)  (1280 + 64 * (j))
#define XB_XGEN(j)  (2304 + 64 * (j))
#define XB_TOP      3328
#define XB_TOPGEN   3392
#define XCD_BAR_WORDS 3456
#define XB_SPIN_CAP (1u << 18)

__device__ __forceinline__ unsigned xb_ld(unsigned* p)              { return __hip_atomic_load(p, __ATOMIC_RELAXED, __HIP_MEMORY_SCOPE_AGENT); }
__device__ __forceinline__ unsigned xb_add(unsigned* p, unsigned v) { return __hip_atomic_fetch_add(p, v, __ATOMIC_RELAXED, __HIP_MEMORY_SCOPE_AGENT); }
__device__ __forceinline__ unsigned xb_xcc_id() { return (unsigned)__builtin_amdgcn_s_getreg((3 << 11) | 20) & 0xFu; }
#define XB_SPIN(cond, bar) do { unsigned _sp = 0; while (cond) { __builtin_amdgcn_s_sleep(1); \
    if ((++_sp & 255u) == 0u) { if (xb_ld(&(bar)[XB_TMO])) break; if (_sp > XB_SPIN_CAP) { atomicAdd(&(bar)[XB_TMO], 1u); break; } } } } while (0)

struct XcdBarrier {
    unsigned* bar; unsigned x;
    volatile LAS unsigned* st;
};

__device__ __forceinline__ XcdBarrier xcd_barrier_post(unsigned* bar, volatile LAS unsigned* st) {
    XcdBarrier b; b.bar = bar; b.x = xb_xcc_id(); b.st = st;
    if (threadIdx.x == 0) (void)xb_add(&bar[XB_XCNT(b.x)], 1u);
    return b;
}
__device__ __forceinline__ void xcd_barrier_complete(unsigned* bar, unsigned x, unsigned& nloc, unsigned& nx) {
    const unsigned G = gridDim.x * gridDim.y * gridDim.z;
    unsigned sum, cnt, mine, sp = 0u;
    for (;;) {
        sum = 0u; cnt = 0u; mine = 0u;
#pragma unroll
        for (unsigned j = 0; j < 16; ++j) { const unsigned c = xb_ld(&bar[XB_XCNT(j)]); sum += c; cnt += (c > 0u) ? 1u : 0u; mine = (j == x) ? c : mine; }
        if (sum == G) break;
        __builtin_amdgcn_s_sleep(1);
        if ((++sp & 255u) == 0u) { if (xb_ld(&bar[XB_TMO])) break; if (sp > XB_SPIN_CAP) { atomicAdd(&bar[XB_TMO], 1u); break; } }
    }
    nloc = mine > 0u ? mine : 1u; nx = cnt > 0u ? cnt : 1u;
}

__device__ __forceinline__ void xcd_barrier(const XcdBarrier& b) {
    asm volatile("s_waitcnt vmcnt(0)" ::: "memory");
    __syncthreads();
    if (threadIdx.x == 0) {
        unsigned* bar = b.bar;
        __builtin_amdgcn_s_waitcnt(0);
        unsigned nloc = b.st[0], nx = b.st[1];
        if (nloc == 0u) { xcd_barrier_complete(bar, b.x, nloc, nx); b.st[0] = nloc; b.st[1] = nx; }
        const unsigned old = xb_add(&bar[XB_XSUB(b.x)], 1u);
        const unsigned gen = old / nloc;
        if (old + 1u == (gen + 1u) * nloc) {
            __builtin_amdgcn_fence(__ATOMIC_RELEASE, "agent");
            asm volatile("s_waitcnt vmcnt(0)" ::: "memory");
            const unsigned og = xb_add(&bar[XB_TOP], 1u);
            const unsigned tg = og / nx;
            if (og + 1u == (tg + 1u) * nx) xb_add(&bar[XB_TOPGEN], 1u);
            else XB_SPIN(xb_ld(&bar[XB_TOPGEN]) == tg, bar);
            __builtin_amdgcn_fence(__ATOMIC_ACQUIRE, "agent");
            xb_add(&bar[XB_XGEN(b.x)], 1u);
            asm volatile("s_waitcnt vmcnt(0)" ::: "memory");
        } else {
            XB_SPIN(xb_ld(&bar[XB_XGEN(b.x)]) == gen, bar);
            __builtin_amdgcn_fence(__ATOMIC_ACQUIRE, "agent");
            asm volatile("s_waitcnt vmcnt(0)" ::: "memory");
        }
    }
    __syncthreads();
}

struct Frame {
    LAS unsigned char* lds;
    volatile LAS unsigned* MISC;
    gu32* ctl;
    int tid, lane, wave;
    int vcu, G;
    const float *x, *norm1_g, *w_in, *b_gates, *q_norm_g, *k_norm_g, *w_o_a, *w_o_b, *w_out, *norm2_g, *w_router, *w_gate, *w_up, *w_down, *normf_g;
    float* out; unsigned char* ws;
};
__device__ __forceinline__ float wave_sum(float v) {
#pragma unroll
    for (int o = 1; o < 64; o <<= 1) v += __shfl_xor(v, o);
    return v;
}
__device__ __forceinline__ void p0_transpose_item(const float* W, int N, bf16* WT, int ldk, int drow0, int dcol0, LAS float* scr, int kb, int nb, int lane) {
    const int k0 = 64 * kb, n0 = 32 * nb;
#pragma unroll 8
    for (int i = 0; i < 32; ++i) { const int kk = 2 * i + (lane >> 5); scr[kk * 33 + (lane & 31)] = W[(size_t)(k0 + kk) * N + n0 + (lane & 31)]; }
    LDS_WAIT(); asm volatile("" ::: "memory");
    const int c = lane & 7;
#pragma unroll
    for (int j = 0; j < 4; ++j) { const int n = (lane >> 3) + 8 * j; const LAS float* s = scr + (8 * c) * 33 + n;
        v4u o; o.x = pk2(s[0 * 33], s[1 * 33]); o.y = pk2(s[2 * 33], s[3 * 33]); o.z = pk2(s[4 * 33], s[5 * 33]); o.w = pk2(s[6 * 33], s[7 * 33]);
        *(GAS v4u*)(WT + (size_t)(drow0 + n) * ldk + dcol0 + k0 + 8 * c) = o; }
    LDS_WAIT(); asm volatile("" ::: "memory");
}
__device__ __forceinline__ void p0_prologue(Frame& F) {
    LAS float* scr = (LAS float*)(F.lds + RING_OFF + F.wave * 16384);
    const int gw = F.vcu * NWAVES + F.wave, NGW = F.G * NWAVES;
    bf16* WIN = (bf16*)(F.ws + WS_WIN); bf16* WO = (bf16*)(F.ws + WS_WO); bf16* WOUT = (bf16*)(F.ws + WS_WOUT); bf16* WGU = (bf16*)(F.ws + WS_WGU); bf16* WD = (bf16*)(F.ws + WS_WD);
    constexpr int I_IN = 16 * 160, I_OA = 8 * 32, I_OB = 4 * 32, I_OUT = 16 * 32, I_E = 16 * 32, NITEMS = I_IN + I_OA + I_OB + I_OUT + 3 * 16 * I_E;
    for (int it = gw; it < NITEMS; it += NGW) {
        int r = it;
        if (r < I_IN) { p0_transpose_item(F.w_in, N_IN, WIN, 1024, 32 * (r % 160), 0, scr, r / 160, r % 160, F.lane); continue; } r -= I_IN;
        if (r < I_OA) { p0_transpose_item(F.w_o_a, DM, WO, 768, 32 * (r % 32), 0, scr, r / 32, r % 32, F.lane); continue; } r -= I_OA;
        if (r < I_OB) { p0_transpose_item(F.w_o_b, DM, WO, 768, 32 * (r % 32), 512, scr, r / 32, r % 32, F.lane); continue; } r -= I_OB;
        if (r < I_OUT) { p0_transpose_item(F.w_out, DM, WOUT, 1024, 32 * (r % 32), 0, scr, r / 32, r % 32, F.lane); continue; } r -= I_OUT;
        const int which = r / (16 * I_E); r -= which * 16 * I_E; const int e = r / I_E, rr = r % I_E, kb = rr / 32, nb = rr % 32, n0 = 32 * nb;
        if (which == 0) p0_transpose_item(F.w_gate + (size_t)e * DM * FF, FF, WGU + (size_t)e * 2048 * 1024, 1024, (n0 >> 7) * 256 + (n0 & 127), 0, scr, kb, nb, F.lane);
        else if (which == 1) p0_transpose_item(F.w_up + (size_t)e * DM * FF, FF, WGU + (size_t)e * 2048 * 1024, 1024, (n0 >> 7) * 256 + 128 + (n0 & 127), 0, scr, kb, nb, F.lane);
        else p0_transpose_item(F.w_down + (size_t)e * FF * DM, DM, WD + (size_t)e * 1024 * 1024, 1024, n0, 0, scr, kb, nb, F.lane);
    }
    bf16* XN = (bf16*)(F.ws + WS_XN);
    f32x4 gg[4];
#pragma unroll
    for (int j = 0; j < 4; ++j) gg[j] = ((const GAS f32x4*)F.norm1_g)[F.lane + 64 * j];
    for (int m = gw; m < M; m += NGW) {
        const GAS f32x4* xr = (const GAS f32x4*)(F.x + (size_t)m * DM) + F.lane;
        f32x4 v[4]; float s2 = 0.f;
#pragma unroll
        for (int j = 0; j < 4; ++j) { v[j] = xr[64 * j]; s2 += (v[j].x * v[j].x + v[j].y * v[j].y) + (v[j].z * v[j].z + v[j].w * v[j].w); }
        const float rs = 1.0f / sqrtf(wave_sum(s2) * (1.f / DM) + NORM_EPS);
        GAS unsigned long long* o8 = (GAS unsigned long long*)(XN + (size_t)m * DM) + F.lane;
#pragma unroll
        for (int j = 0; j < 4; ++j) { const f32x4 y = v[j] * rs * gg[j]; o8[64 * j] = (unsigned long long)pk2(y.x, y.y) | ((unsigned long long)pk2(y.z, y.w) << 32); }
    }
}
__device__ __forceinline__ void p2_qknorm_rope(Frame& F) {
    const int gw = F.vcu * NWAVES + F.wave, NGW = F.G * NWAVES, lane = F.lane, s = lane & 7;
    bf16* QA = (bf16*)(F.ws + WS_QA); bf16* KVA = (bf16*)(F.ws + WS_KVA);
    float qg[8], kg[8], invf[8];
#pragma unroll
    for (int i = 0; i < 8; ++i) { qg[i] = F.q_norm_g[s * 8 + i]; kg[i] = F.k_norm_g[s * 8 + i]; invf[i] = exp2f(-(float)((s & 1) * 8 + i) * 0.8304820237218406f) * 0.15915494309189535f; }
    const bool first = (s & 2) == 0;
    for (int m = gw; m < M; m += NGW) {
        const int t = m & (SEQ - 1); const float pos = (float)((s < 4) ? (t >> 6) : (t & 63));
        float cs[8], sn[8];
#pragma unroll
        for (int i = 0; i < 8; ++i) { float rev = pos * invf[i]; rev -= rintf(rev); cs[i] = __builtin_amdgcn_cosf(rev); sn[i] = __builtin_amdgcn_sinf(rev); if (first) sn[i] = -sn[i]; }
#pragma unroll
        for (int pass = 0; pass < 2; ++pass) {
            const bool act = (pass == 0) || (lane < 16);
            GAS v4u* p = pass == 0 ? (GAS v4u*)(QA + (size_t)m * 512) + lane : (GAS v4u*)(KVA + (size_t)m * 256) + (lane & 15);
            v4u w = (v4u){0u, 0u, 0u, 0u}; if (act) w = *p;
            float v[8] = {__uint_as_float(w.x << 16), __uint_as_float(w.x & 0xffff0000u), __uint_as_float(w.y << 16), __uint_as_float(w.y & 0xffff0000u),
                          __uint_as_float(w.z << 16), __uint_as_float(w.z & 0xffff0000u), __uint_as_float(w.w << 16), __uint_as_float(w.w & 0xffff0000u)};
            float ss = 0.f;
#pragma unroll
            for (int i = 0; i < 8; ++i) ss += v[i] * v[i];
            ss += __shfl_xor(ss, 1); ss += __shfl_xor(ss, 2); ss += __shfl_xor(ss, 4);
            const float rs = (1.0f / sqrtf(ss * (1.f / 64.f) + NORM_EPS)) * (pass == 0 ? pg8::QSCALE : 1.0f);
            float o[8];
#pragma unroll
            for (int i = 0; i < 8; ++i) { const float y = v[i] * rs * (pass == 0 ? qg[i] : kg[i]); const float pr = __shfl_xor(y, 2); o[i] = y * cs[i] + pr * sn[i]; }
            w.x = pk2(o[0], o[1]); w.y = pk2(o[2], o[3]); w.z = pk2(o[4], o[5]); w.w = pk2(o[6], o[7]);
            if (act) *p = w;
        }
    }
}
__device__ __forceinline__ void p6_norm2_router(Frame& F) {
    LAS float* Wt = (LAS float*)(F.lds + RING_OFF);
    for (int i = F.tid; i < DM * NE; i += NWAVES * 64) Wt[(i & 15) * DM + (i >> 4)] = F.w_router[i];
    __syncthreads();
    const int gw = F.vcu * NWAVES + F.wave, NGW = F.G * NWAVES, lane = F.lane;
    bf16* XN = (bf16*)(F.ws + WS_XN); float* AFF = (float*)(F.ws + WS_AFF);
    f32x4 gg[4];
#pragma unroll
    for (int j = 0; j < 4; ++j) gg[j] = ((const GAS f32x4*)F.norm2_g)[lane + 64 * j];
    const bool b5 = (lane & 32) != 0, b4 = (lane & 16) != 0, b3 = (lane & 8) != 0, b2 = (lane & 4) != 0;
    const int e_mine = ((lane >> 5) & 1) * 8 + ((lane >> 4) & 1) * 4 + ((lane >> 3) & 1) * 2 + ((lane >> 2) & 1);
    for (int m = gw; m < M; m += NGW) {
        const GAS f32x4* xr = (const GAS f32x4*)(F.out + (size_t)m * DM) + lane;
        f32x4 v[4]; float s2 = 0.f;
#pragma unroll
        for (int j = 0; j < 4; ++j) { v[j] = xr[64 * j]; s2 += (v[j].x * v[j].x + v[j].y * v[j].y) + (v[j].z * v[j].z + v[j].w * v[j].w); }
        const float rs = 1.0f / sqrtf(wave_sum(s2) * (1.f / DM) + NORM_EPS);
        GAS unsigned long long* o8 = (GAS unsigned long long*)(XN + (size_t)m * DM) + lane;
#pragma unroll
        for (int j = 0; j < 4; ++j) { v[j] = v[j] * rs * gg[j]; o8[64 * j] = (unsigned long long)pk2(v[j].x, v[j].y) | ((unsigned long long)pk2(v[j].z, v[j].w) << 32); }
        float part[16];
#pragma unroll
        for (int e = 0; e < 16; ++e) { float a = 0.f;
#pragma unroll
            for (int j = 0; j < 4; ++j) { const f32x4 w = *(const LAS f32x4*)(Wt + e * DM + 4 * lane + 256 * j); a += (v[j].x * w.x + v[j].y * w.y) + (v[j].z * w.z + v[j].w * w.w); }
            part[e] = a; if (e & 1) asm volatile("" ::: "memory"); }
        float r8[8], r4[4], r2[2];
#pragma unroll
        for (int i = 0; i < 8; ++i) { const float keep = b5 ? part[8 + i] : part[i], send = b5 ? part[i] : part[8 + i]; r8[i] = keep + __shfl_xor(send, 32); }
#pragma unroll
        for (int i = 0; i < 4; ++i) { const float keep = b4 ? r8[4 + i] : r8[i], send = b4 ? r8[i] : r8[4 + i]; r4[i] = keep + __shfl_xor(send, 16); }
#pragma unroll
        for (int i = 0; i < 2; ++i) { const float keep = b3 ? r4[2 + i] : r4[i], send = b3 ? r4[i] : r4[2 + i]; r2[i] = keep + __shfl_xor(send, 8); }
        float lg; { const float keep = b2 ? r2[1] : r2[0], send = b2 ? r2[0] : r2[1]; lg = keep + __shfl_xor(send, 4); }
        lg += __shfl_xor(lg, 1); lg += __shfl_xor(lg, 2);
        float mx = lg;
#pragma unroll
        for (int o = 4; o < 64; o <<= 1) mx = fmaxf(mx, __shfl_xor(mx, o));
        const float ex = __expf(lg - mx); float sm = ex;
#pragma unroll
        for (int o = 4; o < 64; o <<= 1) sm += __shfl_xor(sm, o);
        if ((lane & 3) == 0) AFF[(size_t)m * NE + e_mine] = ex / sm;
    }
    __syncthreads();
}
__device__ __forceinline__ int block_excl_scan(int v, LAS int* sc, int tid, int lane, int wave, int& total) {
    int inc = v;
#pragma unroll
    for (int o = 1; o < 64; o <<= 1) { const int t = __shfl_up(inc, o); if (lane >= o) inc += t; }
    __syncthreads();
    if (lane == 63) sc[wave] = inc;
    __syncthreads();
    int base = 0, tot = 0;
#pragma unroll
    for (int w = 0; w < NWAVES; ++w) { const int t = sc[w]; if (w < wave) base += t; tot += t; }
    total = tot; return base + inc - v;
}
__device__ __forceinline__ void p7_topk(Frame& F) {
    LAS unsigned* hist = (LAS unsigned*)(F.lds + RING_OFF);
    LAS int* sc = (LAS int*)(F.lds + RING_OFF + 1024);
    LAS unsigned* sel = (LAS unsigned*)(F.lds + RING_OFF + 1024 + 64);
    const float* AFF = (const float*)(F.ws + WS_AFF); int* TOPI = (int*)(F.ws + WS_TOPI); float* TOPG = (float*)(F.ws + WS_TOPG); int* TSLOT = (int*)(F.ws + WS_TSLOT);
    const int tid = F.tid, lane = F.lane, wave = F.wave;
    for (int g = blockIdx.x; g < BATCH * NE; g += F.G) {
        const int b = g >> 4, e = g & 15;
        unsigned k[16];
#pragma unroll
        for (int i = 0; i < 16; ++i) k[i] = __float_as_uint(AFF[((size_t)b * SEQ + tid * 16 + i) * NE + e]);
        unsigned prefix = 0u, mask = 0u, remaining = CAP;
#pragma unroll 1
        for (int pass = 3; pass >= 0; --pass) {
            const int shift = pass * 8;
            __syncthreads();
            if (tid < 256) hist[tid] = 0u;
            __syncthreads();
#pragma unroll
            for (int i = 0; i < 16; ++i) if ((k[i] & mask) == prefix) atomicAdd((unsigned*)&hist[(k[i] >> shift) & 255u], 1u);
            __syncthreads();
            if (wave == 0) {
                unsigned c[4]; unsigned tot = 0u;
#pragma unroll
                for (int q = 0; q < 4; ++q) { c[q] = hist[255 - 4 * lane - q]; tot += c[q]; }
                unsigned inc = tot;
#pragma unroll
                for (int o = 1; o < 64; o <<= 1) { const unsigned t = __shfl_up(inc, o); if (lane >= o) inc += t; }
                const unsigned exc = inc - tot;
                if (exc < remaining && remaining <= inc) { unsigned cum = exc, rem = 0u; int bin = 0; bool found = false;
#pragma unroll
                    for (int q = 0; q < 4; ++q) { if (!found && cum + c[q] >= remaining) { bin = 255 - 4 * lane - q; rem = remaining - cum; found = true; } cum += c[q]; }
                    sel[0] = (unsigned)bin; sel[1] = rem; }
            }
            __syncthreads();
            prefix |= sel[0] << shift; mask |= 255u << shift; remaining = sel[1];
        }
        int cgt = 0, ceq = 0;
#pragma unroll
        for (int i = 0; i < 16; ++i) { cgt += (k[i] > prefix) ? 1 : 0; ceq += (k[i] == prefix) ? 1 : 0; }
        int toteq; const int eq0 = block_excl_scan(ceq, sc, tid, lane, wave, toteq);
        int nsel = cgt; { int rk = eq0;
#pragma unroll
            for (int i = 0; i < 16; ++i) if (k[i] == prefix) { if ((unsigned)rk < remaining) ++nsel; ++rk; } }
        int totsel; int pos = block_excl_scan(nsel, sc, tid, lane, wave, totsel);
        int rk = eq0;
#pragma unroll
        for (int i = 0; i < 16; ++i) {
            const int stok = tid * 16 + i; bool take = k[i] > prefix;
            if (k[i] == prefix) { take = (unsigned)rk < remaining; ++rk; }
            int slot = -1;
            if (take) { slot = pos; TOPI[g * CAP + pos] = stok; TOPG[g * CAP + pos] = __uint_as_float(k[i]); ++pos; }
            TSLOT[((size_t)b * SEQ + stok) * NE + e] = slot;
        }
    }
    __syncthreads();
}
__device__ __forceinline__ void p8_gather(Frame& F) {
    const int gw = F.vcu * NWAVES + F.wave, NGW = F.G * NWAVES, lane = F.lane;
    const bf16* XN = (const bf16*)(F.ws + WS_XN); bf16* XG = (bf16*)(F.ws + WS_XG); const int* TOPI = (const int*)(F.ws + WS_TOPI);
    for (int r = gw; r < MR; r += NGW) {
        const int b = r >> 14; const int tok = TOPI[r];
        const GAS v4u* src = (const GAS v4u*)(XN + ((size_t)b * SEQ + tok) * DM) + lane; GAS v4u* dst = (GAS v4u*)(XG + (size_t)r * DM) + lane;
        const v4u a = src[0], c = src[64]; dst[0] = a; dst[64] = c;
    }
}
__device__ __forceinline__ void p11_final(Frame& F, bool poison) {
    const int gw = F.vcu * NWAVES + F.wave, NGW = F.G * NWAVES, lane = F.lane;
    const bf16* Y = (const bf16*)(F.ws + WS_Y); const int* TSLOT = (const int*)(F.ws + WS_TSLOT);
    f32x4 gg[4];
#pragma unroll
    for (int j = 0; j < 4; ++j) gg[j] = ((const GAS f32x4*)F.normf_g)[lane + 64 * j];
    const float qnan = __builtin_nanf("");
    for (int m = gw; m < M; m += NGW) {
        GAS f32x4* xr = (GAS f32x4*)(F.out + (size_t)m * DM) + lane;
        f32x4 v[4];
#pragma unroll
        for (int j = 0; j < 4; ++j) v[j] = xr[64 * j];
        const int b = m >> 13; const int myslot = TSLOT[(size_t)m * NE + (lane & 15)];
#pragma unroll 1
        for (int e = 0; e < NE; ++e) {
            const int sl = __builtin_amdgcn_readlane(myslot, e);
            if (sl >= 0) { const GAS unsigned long long* yr = (const GAS unsigned long long*)(Y + ((size_t)(b * NE + e) * CAP + sl) * DM) + lane;
#pragma unroll
                for (int j = 0; j < 4; ++j) { const unsigned long long w = yr[64 * j]; const unsigned lo = (unsigned)w, hi = (unsigned)(w >> 32);
                    v[j].x += __uint_as_float(lo << 16); v[j].y += __uint_as_float(lo & 0xffff0000u); v[j].z += __uint_as_float(hi << 16); v[j].w += __uint_as_float(hi & 0xffff0000u); } }
        }
        float s2 = 0.f;
#pragma unroll
        for (int j = 0; j < 4; ++j) s2 += (v[j].x * v[j].x + v[j].y * v[j].y) + (v[j].z * v[j].z + v[j].w * v[j].w);
        const float rs = 1.0f / sqrtf(wave_sum(s2) * (1.f / DM) + NORM_EPS);
#pragma unroll
        for (int j = 0; j < 4; ++j) { f32x4 o = v[j] * rs * gg[j]; if (poison) o = (f32x4){qnan, qnan, qnan, qnan}; xr[64 * j] = o; }
    }
}

struct Args { const float* in[15]; float* out; unsigned char* ws; int ph_lo, ph_hi; };
__global__ void __launch_bounds__(NWAVES * 64, 2) hyb_fwd(Args args) {
    extern __shared__ __attribute__((aligned(16))) unsigned char lds[];
    Frame F;
    F.lds = (LAS unsigned char*)lds;
    F.MISC = (volatile LAS unsigned*)(F.lds + MISC_OFF);
    F.tid = threadIdx.x; F.lane = F.tid & 63; F.wave = __builtin_amdgcn_readfirstlane(F.tid >> 6);
    F.G = gridDim.x; { const int bx = blockIdx.x; F.vcu = (F.G % 8 == 0) ? (bx % 8) * (F.G / 8) + bx / 8 : bx; }
    F.ws = args.ws; F.ctl = (gu32*)(args.ws + WS_CTL); F.out = args.out;
    F.x = args.in[0]; F.norm1_g = args.in[1]; F.w_in = args.in[2]; F.b_gates = args.in[3]; F.q_norm_g = args.in[4]; F.k_norm_g = args.in[5]; F.w_o_a = args.in[6]; F.w_o_b = args.in[7];
    F.w_out = args.in[8]; F.norm2_g = args.in[9]; F.w_router = args.in[10]; F.w_gate = args.in[11]; F.w_up = args.in[12]; F.w_down = args.in[13]; F.normf_g = args.in[14];
    for (int u = F.tid; u < (LDS_BYTES - LDSCTL_OFF) / 4; u += NWAVES * 64) ((LAS unsigned*)(F.lds + LDSCTL_OFF))[u] = 0u;
    __syncthreads();
    XcdBarrier bar; bar.bar = (unsigned*)(F.ctl + CW_BAR); bar.x = 0; bar.st = nullptr;
    if (N_LAUNCHES == 1) bar = xcd_barrier_post((unsigned*)(F.ctl + CW_BAR), F.MISC + 8);
#define GRID_BAR() do { if (N_LAUNCHES == 1) { xcd_barrier(bar); } } while (0)
    const int lo = args.ph_lo, hi = args.ph_hi;
#ifndef PH_MASK
#define PH_MASK 0xFFF
#endif
#define IN(k) (((PH_MASK >> (k)) & 1) && lo <= (k) && (k) < hi)
#define BOTH(k) (IN(k) && IN((k) + 1))
    unsigned char* ws = args.ws;
    pg8::bf16_t* XN = (pg8::bf16_t*)(ws + WS_XN);

    if (IN(0)) { p0_prologue(F); if (BOTH(0)) GRID_BAR(); }

    if (IN(1)) {
        pg8::Gemm g{XN, (const pg8::bf16_t*)(ws + WS_WIN), DM, DM, DM}; pg8::StaticOrder S; S.init(M, N_IN, F.G, (int)blockIdx.x);
        pg8::EpiZ E{(pg8::bf16_t*)(ws + WS_QA), (pg8::bf16_t*)(ws + WS_KVA), (pg8::bf16_t*)(ws + WS_QB), (pg8::bf16_t*)(ws + WS_KB), (pg8::bf16_t*)(ws + WS_VB), (pg8::bf16_t*)(ws + WS_G), F.b_gates};
        pg8::gemm_phase<pg8::EpiZ, pg8::StaticOrder, true, true>(F.lds + RING_OFF, g, S, E);
        if (BOTH(1)) GRID_BAR();
    }
    if (IN(2)) { p2_qknorm_rope(F); if (BOTH(2)) GRID_BAR(); }

    if (IN(3)) {
        static_assert(attn_body::ATTN_LDS_BYTES <= RING_BYTES, "attention body geometry vs frame");
        const attn_body::AttnTensors AT{(const attn_body::bf16*)(ws + WS_QA), (const attn_body::bf16*)(ws + WS_KVA), (const attn_body::bf16*)(ws + WS_KVA) + 128, (attn_body::bf16*)(ws + WS_OAB)};
        const attn_body::StaticOrder S((int)F.G, F.vcu);
        attn_body::attn_phase<attn_body::StaticOrder>((char*)lds + RING_OFF, AT, S);
        __syncthreads();
        {
            const int gw = F.vcu * NWAVES + F.wave, NGW = F.G * NWAVES;
            char* wl = (char*)lds + RING_OFF + F.wave * 16384; float* wsf = (float*)((char*)lds + WSF_OFF) + F.wave * 64;
#pragma unroll 1
            for (int J = gw; J < BATCH * 4 * 256; J += NGW)
                attnb::attnb_job(J >> 10, (J >> 8) & 3, J & 255, (const attn_body::bf16*)(ws + WS_QB), (const attn_body::bf16*)(ws + WS_KB), (const attn_body::bf16*)(ws + WS_VB), (attn_body::bf16*)(ws + WS_OAB), wl, wsf);
        }
        asm volatile("s_waitcnt vmcnt(0) lgkmcnt(0)" ::: "memory");
        __syncthreads();
        if (BOTH(3)) GRID_BAR();
    }
    if (IN(4)) {
        const pg8::bf16_t* OAB = (const pg8::bf16_t*)(ws + WS_OAB); const pg8::bf16_t* WO = (const pg8::bf16_t*)(ws + WS_WO); const pg8::bf16_t* Gt = (const pg8::bf16_t*)(ws + WS_G);
        pg8::StaticOrder S; S.init(M, DM, F.G, (int)blockIdx.x);
        { pg8::Gemm g{OAB, WO, 512, 768, 768}; pg8::EpiGate<false> E{Gt, XN}; pg8::gemm_phase<pg8::EpiGate<false>, pg8::StaticOrder, true, true>(F.lds + RING_OFF, g, S, E); }
        { pg8::Gemm g{OAB + 512, WO + 512, 256, 768, 768}; pg8::EpiGate<true> E{Gt + 1024, XN}; pg8::gemm_phase<pg8::EpiGate<true>, pg8::StaticOrder, true, true>(F.lds + RING_OFF, g, S, E); }
        if (BOTH(4)) GRID_BAR();
    }
    if (IN(5)) {
        pg8::Gemm g{XN, (const pg8::bf16_t*)(ws + WS_WOUT), DM, DM, DM}; pg8::StaticOrder S; S.init(M, DM, F.G, (int)blockIdx.x);
        pg8::EpiResF32 E{F.x, F.out};
        pg8::gemm_phase<pg8::EpiResF32, pg8::StaticOrder, true, true>(F.lds + RING_OFF, g, S, E);
        if (BOTH(5)) GRID_BAR();
    }
    if (IN(6)) { p6_norm2_router(F); if (BOTH(6)) GRID_BAR(); }
    if (IN(7)) { p7_topk(F); if (BOTH(7)) GRID_BAR(); }
    if (IN(8)) { p8_gather(F); if (BOTH(8)) GRID_BAR(); }
    if (IN(9)) {
        pg8::Gemm g{(const pg8::bf16_t*)(ws + WS_XG), (const pg8::bf16_t*)(ws + WS_WGU), DM, DM, DM}; pg8::MoeOrderGU S{F.G, F.vcu};
        pg8::EpiSwiglu E{(pg8::bf16_t*)(ws + WS_ACT)};
        pg8::gemm_phase<pg8::EpiSwiglu, pg8::MoeOrderGU, true, true>(F.lds + RING_OFF, g, S, E);
        if (BOTH(9)) GRID_BAR();
    }
    if (IN(10)) {
        pg8::Gemm g{(const pg8::bf16_t*)(ws + WS_ACT), (const pg8::bf16_t*)(ws + WS_WD), FF, FF, FF}; pg8::MoeOrderDown S{F.G, F.vcu};
        pg8::EpiDown E{(pg8::bf16_t*)(ws + WS_Y), (const float*)(ws + WS_TOPG)};
        pg8::gemm_phase<pg8::EpiDown, pg8::MoeOrderDown, true, true>(F.lds + RING_OFF, g, S, E);
        if (BOTH(10)) GRID_BAR();
    }
    if (IN(11)) {
        bool poison = false;
        if (N_LAUNCHES == 1) poison = __hip_atomic_load((gu32*)((const unsigned*)(F.ctl + CW_BAR) + XB_TMO), RLX_AGENT) != 0u;
        p11_final(F, poison);
    }
#undef IN
#undef BOTH
#undef GRID_BAR
}

extern "C" void kernel_launch(void* const* d_in, const int* in_sizes, int n_in, void* d_out, int out_size, void* d_ws, size_t ws_size, hipStream_t stream) {
    static int grid = 0;
    if (grid == 0) {
        if (n_in != 15 || in_sizes[0] != M * DM || out_size != M * DM || ws_size < WS_END) { fprintf(stderr, "kernel_launch: unexpected shapes / workspace (n_in %d, in0 %d, out %d, ws %zu < %zu); nothing launched\n", n_in, n_in > 0 ? in_sizes[0] : -1, out_size, ws_size, (size_t)WS_END); grid = -1; return; }
        int dev = 0, cus = 0, per_cu = 0;
        if (hipGetDevice(&dev) != hipSuccess || hipDeviceGetAttribute(&cus, hipDeviceAttributeMultiprocessorCount, dev) != hipSuccess) { grid = -1; return; }
        if (hipFuncSetAttribute((const void*)hyb_fwd, hipFuncAttributeMaxDynamicSharedMemorySize, LDS_BYTES) != hipSuccess) { fprintf(stderr, "kernel_launch: hipFuncSetAttribute failed\n"); grid = -1; return; }
        if (hipOccupancyMaxActiveBlocksPerMultiprocessor(&per_cu, (const void*)hyb_fwd, NWAVES * 64, LDS_BYTES) != hipSuccess || per_cu < 1) { fprintf(stderr, "kernel_launch: occupancy query reports %d workgroups per CU\n", per_cu); }
        (void)hipGetLastError();
        grid = cus;
    }
    if (grid < 0) return;
    if (hipMemsetAsync((char*)d_ws + WS_CTL, 0, CTL_ZERO_BYTES, stream) != hipSuccess) return;
    Args a{};
    for (int i = 0; i < 15; ++i) a.in[i] = (const float*)d_in[i];
    a.out = (float*)d_out; a.ws = (unsigned char*)d_ws;
    for (int li = 0; li < N_LAUNCHES; ++li) {
        a.ph_lo = (N_LAUNCHES == 1) ? 0 : li; a.ph_hi = (N_LAUNCHES == 1) ? N_PHASES : li + 1;
        hipLaunchKernelGGL(hyb_fwd, dim3(grid), dim3(NWAVES * 64), LDS_BYTES, stream, a);
        if (hipPeekAtLastError() != hipSuccess) { fprintf(stderr, "kernel_launch: launch %d failed\n", li); break; }
    }
}
```

```cpp
#include <hip/hip_runtime.h>
#include <cstdio>
#include <cstdint>
namespace pg8 {
#define PG8_LAS __attribute__((address_space(3)))
typedef unsigned short bf16_t;
typedef short bf16x8 __attribute__((ext_vector_type(8)));
typedef float f32x4 __attribute__((ext_vector_type(4)));
typedef unsigned u32x4 __attribute__((ext_vector_type(4)));
constexpr int BM = 256, BK = 64, HALF = 128, HTB = HALF * BK * 2  , STAGE_BYTES = 8 * HTB, NXCD = 8, WGM = 8;

__host__ __device__ __forceinline__ int lds_byte(int r, int c) { const int st = (r >> 4) * 2 + (c >> 5), rr = r & 15, cc = c & 31, ob = rr * 64 + cc * 2; return st * 1024 + (ob ^ (((ob >> 9) & 1) << 5)); }
__host__ __device__ __forceinline__ void stage_rc(int b, int& R, int& C) { const int st = b / 1024, sb = b % 1024, swz = sb ^ (((sb >> 9) & 1) << 5); R = (st >> 1) * 16 + swz / 64; C = (st & 1) * 32 + (swz % 64) / 2; }
__host__ __device__ __forceinline__ int perm32(int rho) { const int n = rho >> 4, i = rho & 15; return 8 * (i >> 2) + 4 * n + (i & 3); }

struct Unit { int pm, pn, pb; };
struct Gemm { const bf16_t* A; const bf16_t* Bt; int K, lda, ldb; const int* gidx; };

struct StaticOrder {
    int nM, nN, nwg, G, c, wgm;
    __host__ __device__ void init(int M, int N, int G_, int c_, int wgm_ = WGM) { nM = M / BM; nN = N / BM; nwg = nM * nN; G = G_; c = c_; wgm = wgm_; }
    __host__ __device__ bool next(int i, Unit& u) const {
        const long L = (long)i * G + c; if (L >= nwg) return false;
        int wgid = (int)L; { const int q = nwg / NXCD, r = nwg % NXCD, xcd = wgid % NXCD, off = wgid / NXCD; wgid = (xcd < r ? xcd * (q + 1) : r * (q + 1) + (xcd - r) * q) + off; }
        const int nig = wgm * nN, gid = wgid / nig, fm = gid * wgm, gsz = (nM - fm) < wgm ? (nM - fm) : wgm;
        u.pm = fm + ((wgid % nig) % gsz); u.pn = (wgid % nig) / gsz; u.pb = u.pn; return true;
    }
    __device__ __forceinline__ void a_ready(const Unit&) const {}
    __device__ __forceinline__ void done(const Unit&) const {}
};
struct MoeOrderGU {
    int G, vcu;
    __device__ __forceinline__ bool next(int i, Unit& u) const {
        const int L = i * G + vcu; if (L >= 4096) return false;
        const int rnd = L >> 8, x = (L >> 5) & 7, w = L & 31; const int e = 2 * x + (rnd >> 3), b = rnd & 7, g = b * 16 + e;
        u.pm = g * 4 + (w & 3); u.pn = w >> 2; u.pb = e * 8 + u.pn; return true; }
    __device__ __forceinline__ void a_ready(const Unit&) const {}
    __device__ __forceinline__ void done(const Unit&) const {}
};
struct MoeOrderDown {
    int G, vcu;
    __device__ __forceinline__ bool next(int i, Unit& u) const {
        const int L = i * G + vcu; if (L >= 2048) return false;
        const int rnd = L >> 8, x = (L >> 5) & 7, w = L & 31; const int jj = 2 * rnd + (w >> 4), w16 = w & 15; const int e = 2 * x + (jj >> 3), b = jj & 7, g = b * 16 + e;
        u.pm = g * 4 + (w16 & 3); u.pn = w16 >> 2; u.pb = e * 4 + u.pn; return true; }
    __device__ __forceinline__ void a_ready(const Unit&) const {}
    __device__ __forceinline__ void done(const Unit&) const {}
};

__device__ __forceinline__ unsigned cvt_pk_bf16(float lo, float hi) { unsigned r; asm volatile("v_cvt_pk_bf16_f32 %0, %1, %2" : "=v"(r) : "v"(lo), "v"(hi)); return r; }
__device__ __forceinline__ float bf_lo(unsigned w) { return __uint_as_float(w << 16); }
__device__ __forceinline__ float bf_hi(unsigned w) { return __uint_as_float(w & 0xffff0000u); }
__device__ __forceinline__ float sigmoidf_fast(float v) { return __builtin_amdgcn_rcpf(1.0f + __builtin_amdgcn_exp2f(-1.4426950408889634f * v)); }
constexpr float QSCALE = 0.125f * 1.4426950408889634f;

typedef int i32x8 __attribute__((ext_vector_type(8)));
typedef int i32x4 __attribute__((ext_vector_type(4)));
__device__ __forceinline__ i32x8 cat8(bf16x8 lo, bf16x8 hi) { return __builtin_shufflevector(__builtin_bit_cast(i32x4, lo), __builtin_bit_cast(i32x4, hi), 0, 1, 2, 3, 4, 5, 6, 7); }
__device__ __forceinline__ unsigned pk4_fp8(float a, float b, float c, float d) {
    a = __builtin_amdgcn_fmed3f(a, -448.f, 448.f); b = __builtin_amdgcn_fmed3f(b, -448.f, 448.f); c = __builtin_amdgcn_fmed3f(c, -448.f, 448.f); d = __builtin_amdgcn_fmed3f(d, -448.f, 448.f);
    int w = __builtin_amdgcn_cvt_pk_fp8_f32(a, b, 0, false); w = __builtin_amdgcn_cvt_pk_fp8_f32(c, d, w, true); return (unsigned)w; }
constexpr float Y_SCALE = 64.0f;
constexpr float F8_ACT_SCALE = 8.0f, F8_W_SCALE = 64.0f, F8_DEQ = 1.0f / (F8_ACT_SCALE * F8_W_SCALE);
struct EpiZ {
    static constexpr bool PERM = true, AFTER_DRAIN = false;
    bf16_t *QA, *KVA, *QB, *KB, *VB, *G; const float* bg; float deq;
    __device__ __forceinline__ void operator()(const f32x4 (&acc)[2][2][4][2], const Unit& u, int wr, int wc, int fr, int fq) const {
        const int pn = u.pn; int ldc, colt; float sc = deq; const bool gate = pn >= 12;
        long boff;
        if (pn < 2) { boff = 0; ldc = 512; colt = pn * 256; }
        else if (pn == 2) { boff = KVA - QA; ldc = 256; colt = 0; }
        else if (pn < 6) { boff = QB - QA; ldc = 768; colt = (pn - 3) * 256; sc = QSCALE * deq; }
        else if (pn < 9) { boff = KB - QA; ldc = 768; colt = (pn - 6) * 256; }
        else { boff = VB - QA; ldc = 768; colt = (pn - 9) * 256; }
        bf16_t* base = QA + boff;
        const int row0 = u.pm * BM + wr * 64 + fr, col0 = colt + wc * 32 + 8 * fq;
        if (gate) {
            const int gcol = (pn - 12) * HALF + wc * 32 + 8 * fq; const float k2 = sc * -1.4426950408889634f;
            f32x4 ba[2], bb[2];
#pragma unroll
            for (int n = 0; n < 2; ++n) { ba[n] = *(const f32x4*)(bg + gcol + 4 * n) * (-1.4426950408889634f); bb[n] = *(const f32x4*)(bg + 1024 + gcol + 4 * n) * (-1.4426950408889634f); }
#pragma unroll
            for (int ai = 0; ai < 2; ++ai)
#pragma unroll
                for (int m = 0; m < 4; ++m) { bf16_t* rowp = G + (size_t)(row0 + ai * HALF + m * 16) * 2048 + gcol;
                    f32x4 rr[2], gb[2];
#pragma unroll
                    for (int n = 0; n < 2; ++n) { f32x4 ea = acc[ai][0][m][n] * k2 + ba[n], eb = acc[ai][1][m][n] * k2 + bb[n];
#pragma unroll
                        for (int q = 0; q < 4; ++q) { ea[q] = __builtin_amdgcn_exp2f(ea[q]); eb[q] = __builtin_amdgcn_exp2f(eb[q]); }
                        ea = ea + 1.0f; eb = eb + 1.0f;
#pragma unroll
                        for (int q = 0; q < 4; ++q) { ea[q] = __builtin_amdgcn_rcpf(ea[q]); gb[n][q] = __builtin_amdgcn_rcpf(eb[q]); }
                        rr[n] = ea * eb; }
                    u32x4 w; w.x = cvt_pk_bf16(rr[0][0], rr[0][1]); w.y = cvt_pk_bf16(rr[0][2], rr[0][3]); w.z = cvt_pk_bf16(rr[1][0], rr[1][1]); w.w = cvt_pk_bf16(rr[1][2], rr[1][3]);
                    *(u32x4*)rowp = w;
                    w.x = cvt_pk_bf16(gb[0][0], gb[0][1]); w.y = cvt_pk_bf16(gb[0][2], gb[0][3]); w.z = cvt_pk_bf16(gb[1][0], gb[1][1]); w.w = cvt_pk_bf16(gb[1][2], gb[1][3]);
                    *(u32x4*)(rowp + 1024) = w; }
            return; }
#pragma unroll
        for (int ai = 0; ai < 2; ++ai)
#pragma unroll
            for (int m = 0; m < 4; ++m) { bf16_t* rowp = base + (size_t)(row0 + ai * HALF + m * 16) * ldc + col0;
#pragma unroll
                for (int bj = 0; bj < 2; ++bj) { const f32x4 v0 = acc[ai][bj][m][0] * sc, v1 = acc[ai][bj][m][1] * sc;
                    u32x4 w; w.x = cvt_pk_bf16(v0[0], v0[1]); w.y = cvt_pk_bf16(v0[2], v0[3]); w.z = cvt_pk_bf16(v1[0], v1[1]); w.w = cvt_pk_bf16(v1[2], v1[3]);
                    *(u32x4*)(rowp + bj * HALF) = w; } }
    }
};
struct EpiNull {
    static constexpr bool PERM = true, AFTER_DRAIN = false;
    __device__ __forceinline__ void operator()(const f32x4 (&acc)[2][2][4][2], const Unit&, int, int, int, int) const {
#pragma unroll
        for (int a = 0; a < 2; ++a)
#pragma unroll
            for (int b = 0; b < 2; ++b)
#pragma unroll
                for (int m = 0; m < 4; ++m)
#pragma unroll
                    for (int n = 0; n < 2; ++n) asm volatile("" :: "v"(acc[a][b][m][n]));
    }
};
template <bool ADD> struct EpiGate {
    static constexpr bool PERM = true, AFTER_DRAIN = false;
    const bf16_t* Gt; bf16_t* O;
    __device__ __forceinline__ void operator()(const f32x4 (&acc)[2][2][4][2], const Unit& u, int wr, int wc, int fr, int fq) const {
        const int row0 = u.pm * BM + wr * 64 + fr, col0 = u.pn * BM + wc * 32 + 8 * fq;
#pragma unroll
        for (int ai = 0; ai < 2; ++ai)
#pragma unroll
            for (int m = 0; m < 4; ++m) { const size_t row = (size_t)(row0 + ai * HALF + m * 16);
#pragma unroll
                for (int bj = 0; bj < 2; ++bj) { const u32x4 gw = *(const u32x4*)(Gt + row * 2048 + col0 + bj * HALF); bf16_t* op = O + row * 1024 + col0 + bj * HALF;
                    f32x4 v0 = acc[ai][bj][m][0], v1 = acc[ai][bj][m][1];
                    v0[0] *= bf_lo(gw.x); v0[1] *= bf_hi(gw.x); v0[2] *= bf_lo(gw.y); v0[3] *= bf_hi(gw.y); v1[0] *= bf_lo(gw.z); v1[1] *= bf_hi(gw.z); v1[2] *= bf_lo(gw.w); v1[3] *= bf_hi(gw.w);
                    if (ADD) { const u32x4 t = *(const u32x4*)op; v0[0] += bf_lo(t.x); v0[1] += bf_hi(t.x); v0[2] += bf_lo(t.y); v0[3] += bf_hi(t.y); v1[0] += bf_lo(t.z); v1[1] += bf_hi(t.z); v1[2] += bf_lo(t.w); v1[3] += bf_hi(t.w); }
                    u32x4 w; w.x = cvt_pk_bf16(v0[0], v0[1]); w.y = cvt_pk_bf16(v0[2], v0[3]); w.z = cvt_pk_bf16(v1[0], v1[1]); w.w = cvt_pk_bf16(v1[2], v1[3]);
                    *(u32x4*)op = w; } }
    }
};
struct EpiGateHook {
    static constexpr bool PERM = true, AFTER_DRAIN = false, HAS_MID = true; static constexpr int MID_KT = 8;
    const bf16_t* Gt; bf16_t* O;
    __device__ __forceinline__ void mid(f32x4 (&acc)[2][2][4][2], const Unit& u, int wr, int wc, int fr, int fq) const {
        const int row0 = u.pm * BM + wr * 64 + fr, col0 = u.pn * BM + wc * 32 + 8 * fq;
#pragma unroll
        for (int ai = 0; ai < 2; ++ai)
#pragma unroll
            for (int m = 0; m < 4; ++m) { const size_t row = (size_t)(row0 + ai * HALF + m * 16);
#pragma unroll
                for (int bj = 0; bj < 2; ++bj) { const u32x4 ga = *(const u32x4*)(Gt + row * 2048 + col0 + bj * HALF);
                    f32x4& v0 = acc[ai][bj][m][0]; f32x4& v1 = acc[ai][bj][m][1];
                    v0[0] *= bf_lo(ga.x); v0[1] *= bf_hi(ga.x); v0[2] *= bf_lo(ga.y); v0[3] *= bf_hi(ga.y); v1[0] *= bf_lo(ga.z); v1[1] *= bf_hi(ga.z); v1[2] *= bf_lo(ga.w); v1[3] *= bf_hi(ga.w); }
                if (m & 1) asm volatile("" ::: "memory"); }
    }
    __device__ __forceinline__ void operator()(const f32x4 (&acc)[2][2][4][2], const Unit& u, int wr, int wc, int fr, int fq) const {
        const int row0 = u.pm * BM + wr * 64 + fr, col0 = u.pn * BM + wc * 32 + 8 * fq;
#pragma unroll
        for (int ai = 0; ai < 2; ++ai)
#pragma unroll
            for (int m = 0; m < 4; ++m) { const size_t row = (size_t)(row0 + ai * HALF + m * 16);
#pragma unroll
                for (int bj = 0; bj < 2; ++bj) { const u32x4 gw = *(const u32x4*)(Gt + row * 2048 + 1024 + col0 + bj * HALF); bf16_t* op = O + row * 1024 + col0 + bj * HALF;
                    f32x4 v0 = acc[ai][bj][m][0], v1 = acc[ai][bj][m][1];
                    v0[0] *= bf_lo(gw.x); v0[1] *= bf_hi(gw.x); v0[2] *= bf_lo(gw.y); v0[3] *= bf_hi(gw.y); v1[0] *= bf_lo(gw.z); v1[1] *= bf_hi(gw.z); v1[2] *= bf_lo(gw.w); v1[3] *= bf_hi(gw.w);
                    u32x4 w; w.x = cvt_pk_bf16(v0[0], v0[1]); w.y = cvt_pk_bf16(v0[2], v0[3]); w.z = cvt_pk_bf16(v1[0], v1[1]); w.w = cvt_pk_bf16(v1[2], v1[3]);
                    *(u32x4*)op = w; } }
    }
};
template <class E, class = void> struct epi_has_mid { static constexpr bool value = false; };
template <class E> struct epi_has_mid<E, decltype((void)E::HAS_MID)> { static constexpr bool value = E::HAS_MID; };
struct EpiResF32 {
    static constexpr bool PERM = false, AFTER_DRAIN = false;
    const float* base; float* out;
    __device__ __forceinline__ void operator()(const f32x4 (&acc)[2][2][4][2], const Unit& u, int wr, int wc, int fr, int fq) const {
        const int row0 = u.pm * BM + wr * 64 + fr, col0 = u.pn * BM + wc * 32 + 4 * fq;
#pragma unroll
        for (int ai = 0; ai < 2; ++ai)
#pragma unroll
            for (int m = 0; m < 4; ++m) { const size_t off = (size_t)(row0 + ai * HALF + m * 16) * 1024 + col0;
#pragma unroll
                for (int bj = 0; bj < 2; ++bj)
#pragma unroll
                    for (int n = 0; n < 2; ++n) { const f32x4 bs = *(const f32x4*)(base + off + bj * HALF + n * 16); *(f32x4*)(out + off + bj * HALF + n * 16) = bs + acc[ai][bj][m][n]; }
                if (m & 1) asm volatile("" ::: "memory"); }
    }
};
struct EpiResBf16 {
    static constexpr bool PERM = true, AFTER_DRAIN = false;
    const float* base; bf16_t* out;
    __device__ __forceinline__ void operator()(const f32x4 (&acc)[2][2][4][2], const Unit& u, int wr, int wc, int fr, int fq) const {
        const int row0 = u.pm * BM + wr * 64 + fr, col0 = u.pn * BM + wc * 32 + 8 * fq;
#pragma unroll
        for (int ai = 0; ai < 2; ++ai)
#pragma unroll
            for (int m = 0; m < 4; ++m) { const size_t off = (size_t)(row0 + ai * HALF + m * 16) * 1024 + col0;
#pragma unroll
                for (int bj = 0; bj < 2; ++bj) { const f32x4 x0 = *(const f32x4*)(base + off + bj * HALF), x1 = *(const f32x4*)(base + off + bj * HALF + 4);
                    const f32x4 v0 = acc[ai][bj][m][0] + x0, v1 = acc[ai][bj][m][1] + x1;
                    u32x4 w; w.x = cvt_pk_bf16(v0[0], v0[1]); w.y = cvt_pk_bf16(v0[2], v0[3]); w.z = cvt_pk_bf16(v1[0], v1[1]); w.w = cvt_pk_bf16(v1[2], v1[3]);
                    *(u32x4*)(out + off + bj * HALF) = w; }
                if (m == 3) asm volatile("" ::: "memory"); }
    }
};
template <bool STORE = true> struct EpiSwigluT {
    static constexpr bool PERM = true, AFTER_DRAIN = false;
    unsigned char* O;
    __device__ __forceinline__ void operator()(const f32x4 (&acc)[2][2][4][2], const Unit& u, int wr, int wc, int fr, int fq) const {
        const int row0 = u.pm * BM + wr * 64 + fr, col0 = u.pn * HALF + wc * 32 + 8 * fq;
#pragma unroll
        for (int ai = 0; ai < 2; ++ai)
#pragma unroll
            for (int m = 0; m < 4; ++m) { unsigned char* op = O + (size_t)(row0 + ai * HALF + m * 16) * 1024 + col0;
                typedef float f32x2 __attribute__((ext_vector_type(2)));
                f32x4 h0, h1;
#pragma unroll
                for (int n = 0; n < 2; ++n)
#pragma unroll
                    for (int q = 0; q < 4; q += 2) { const f32x2 gv = {acc[ai][0][m][n][q], acc[ai][0][m][n][q + 1]}, uv = {acc[ai][1][m][n][q], acc[ai][1][m][n][q + 1]};
                        const f32x2 ea = gv * (-1.4426950408889634f * F8_DEQ); f32x2 ex; ex.x = __builtin_amdgcn_exp2f(ea.x); ex.y = __builtin_amdgcn_exp2f(ea.y);
                        const f32x2 dn = ex + 1.0f; f32x2 rc; rc.x = __builtin_amdgcn_rcpf(dn.x); rc.y = __builtin_amdgcn_rcpf(dn.y);
                        const f32x2 hv = (gv * uv) * (rc * (F8_DEQ * F8_DEQ * F8_ACT_SCALE));
                        if (n == 0) { h0[q] = hv.x; h0[q + 1] = hv.y; } else { h1[q] = hv.x; h1[q + 1] = hv.y; } }
                typedef unsigned u32x2 __attribute__((ext_vector_type(2)));
                u32x2 w; w.x = pk4_fp8(h0[0], h0[1], h0[2], h0[3]); w.y = pk4_fp8(h1[0], h1[1], h1[2], h1[3]);
                if (STORE) *(u32x2*)op = w; else asm volatile("" :: "v"(w)); }
    }
};
typedef EpiSwigluT<true> EpiSwiglu;
struct EpiDown {
    static constexpr bool PERM = true, AFTER_DRAIN = false;
    unsigned char* O; const float* gv;
    __device__ __forceinline__ void operator()(const f32x4 (&acc)[2][2][4][2], const Unit& u, int wr, int wc, int fr, int fq) const {
        const int row0 = u.pm * BM + wr * 64 + fr, col0 = u.pn * BM + wc * 32 + 8 * fq;
        typedef unsigned u32x2 __attribute__((ext_vector_type(2)));
#pragma unroll
        for (int ai = 0; ai < 2; ++ai)
#pragma unroll
            for (int m = 0; m < 4; ++m) { const int row = row0 + ai * HALF + m * 16; const float gsc = gv[row] * (F8_DEQ * Y_SCALE); unsigned char* op = O + (size_t)row * 1024 + col0;
#pragma unroll
                for (int bj = 0; bj < 2; ++bj) { const f32x4 v0 = acc[ai][bj][m][0] * gsc, v1 = acc[ai][bj][m][1] * gsc;
                    u32x2 w; w.x = pk4_fp8(v0[0], v0[1], v0[2], v0[3]); w.y = pk4_fp8(v1[0], v1[1], v1[2], v1[3]);
                    *(u32x2*)(op + bj * HALF) = w; } }
    }
};

template <class Epi, class Sched, bool ALIGN_EPI = false, bool SP2 = false, bool FP8 = false, bool GATHER = false>
__device__ __forceinline__ void gemm_phase(PG8_LAS unsigned char* lds, const Gemm g, const Sched& S, const Epi& E) {
    const int tid = threadIdx.x, wid = __builtin_amdgcn_readfirstlane(tid >> 6), lane = tid & 63, wr = wid >> 2, wc = wid & 3, fr = lane & 15, fq = lane >> 4;
    const int K = g.K, nt = K / BK;
    unsigned voffA[2], voffB[2]; int rowA[2], colA2[2];
    static_assert(!GATHER || SP2, "the gathered-A path is written for the SP2 loop only");
#pragma unroll
    for (int i = 0; i < 2; ++i) { int R, C; stage_rc(tid * 16 + i * 8192, R, C); const int Rb = Epi::PERM ? ((R & ~31) + perm32(R & 31)) : R;
        voffA[i] = (unsigned)(R * g.lda + C) * 2u; voffB[i] = (unsigned)(Rb * g.ldb + C) * 2u; rowA[i] = R; colA2[i] = C * 2; }
    const size_t kstep = (size_t)(BK * 2);
    const size_t hstepA = (size_t)HALF * g.lda * 2, hstepB = (size_t)HALF * g.ldb * 2;
    const size_t tstepA = 2 * hstepA, tstepB = 2 * hstepB;
    const unsigned ldsw = (unsigned)wid * 1024u;
    const int aoff = lds_byte(wr * 64 + fr, fq * 8), boff = lds_byte(wc * 32 + fr, fq * 8);
#define PG8_SA(b, h) (((b) * 2 + (h)) * HTB)
#define PG8_SB(b, h) ((4 + (b) * 2 + (h)) * HTB)
#define PG8_STAGE(bufoff, gbase, voff) do { _Pragma("unroll") for (int _i = 0; _i < 2; ++_i) { unsigned vo_ = (voff)[_i]; asm volatile("" : "+v"(vo_));     \
        __builtin_amdgcn_global_load_lds((const unsigned*)((const char*)(gbase) + vo_), (PG8_LAS unsigned*)(lds + (bufoff) + ldsw + _i * 8192), 16, 0, 0); } } while (0)
#define PG8_LDA(dst, b, h) do { if constexpr (FP8) { _Pragma("unroll") for (int m = 0; m < 4; ++m) { const i32x4 lo_ = *(const PG8_LAS i32x4*)(lds + PG8_SA(b, h) + aoff + m * 2048), hi_ = *(const PG8_LAS i32x4*)(lds + PG8_SA(b, h) + aoff + m * 2048 + 1024); dst##8[m] = __builtin_shufflevector(lo_, hi_, 0, 1, 2, 3, 4, 5, 6, 7); } } \
        else { _Pragma("unroll") for (int m = 0; m < 4; ++m) _Pragma("unroll") for (int k = 0; k < 2; ++k) dst[m][k] = *(const PG8_LAS bf16x8*)(lds + PG8_SA(b, h) + aoff + m * 2048 + k * 1024); } } while (0)
#define PG8_LDB(dst, b, h) do { if constexpr (FP8) { _Pragma("unroll") for (int n = 0; n < 2; ++n) { const i32x4 lo_ = *(const PG8_LAS i32x4*)(lds + PG8_SB(b, h) + boff + n * 2048), hi_ = *(const PG8_LAS i32x4*)(lds + PG8_SB(b, h) + boff + n * 2048 + 1024); dst##8[n] = __builtin_shufflevector(lo_, hi_, 0, 1, 2, 3, 4, 5, 6, 7); } } \
        else { _Pragma("unroll") for (int n = 0; n < 2; ++n) _Pragma("unroll") for (int k = 0; k < 2; ++k) dst[n][k] = *(const PG8_LAS bf16x8*)(lds + PG8_SB(b, h) + boff + n * 2048 + k * 1024); } } while (0)
#define PG8_MMA(ai, bj, At, Bt) do { __builtin_amdgcn_s_setprio(1); _Pragma("unroll") for (int m = 0; m < 4; ++m) _Pragma("unroll") for (int n = 0; n < 2; ++n) { \
        if constexpr (FP8) { asm volatile("v_mfma_f32_16x16x128_f8f6f4 %0, %1, %2, %0" : "+v"(acc[ai][bj][m][n]) : "v"(Bt##8[n]), "v"(At##8[m])); }     \
        else { _Pragma("unroll") for (int k = 0; k < 2; ++k) acc[ai][bj][m][n] = __builtin_amdgcn_mfma_f32_16x16x32_bf16(Bt[n][k], At[m][k], acc[ai][bj][m][n], 0, 0, 0); } } \
        __builtin_amdgcn_s_setprio(0); } while (0)
#define PG8_WAIT_V(n) asm volatile("s_waitcnt vmcnt(" #n ")" ::: "memory")
#define PG8_WAIT_L(n) asm volatile("s_waitcnt lgkmcnt(" #n ")" ::: "memory")
#define PG8_BAR __builtin_amdgcn_s_barrier()
#define PG8_SCHED __builtin_amdgcn_sched_barrier(0)
    unsigned gcur[2][2] = {{0u, 0u}, {0u, 0u}}, gnxt[2][2] = {{0u, 0u}, {0u, 0u}}; int graw[2][2] = {{0, 0}, {0, 0}};
#define PG8_GIDX_ISSUE(U) do { _Pragma("unroll") for (int h_ = 0; h_ < 2; ++h_) _Pragma("unroll") for (int i_ = 0; i_ < 2; ++i_) { const unsigned bo_ = (unsigned)((U).pm * BM + h_ * HALF + rowA[i_]) * 4u; \
        asm volatile("global_load_dword %0, %1, %2" : "=v"(graw[h_][i_]) : "v"(bo_), "s"(g.gidx) : "memory"); } } while (0)
#define PG8_GIDX_CONV(dst, U) do { _Pragma("unroll") for (int h_ = 0; h_ < 2; ++h_) _Pragma("unroll") for (int i_ = 0; i_ < 2; ++i_) { asm volatile("" : "+v"(graw[h_][i_])); \
        dst[h_][i_] = (unsigned)(((U).pm >> 6) * 8192 + graw[h_][i_]) * (unsigned)(g.lda * 2) + (unsigned)colA2[i_]; } } while (0)
#define PG8_STAGE_A(bufoff, ptr, h, nx) do { if constexpr (GATHER) { PG8_STAGE(bufoff, ptr, ((nx) ? gsel[h] : gcur[h])); } else { PG8_STAGE(bufoff, (ptr) + ((h) ? hstepA : 0), voffA); } } while (0)
    Unit cur, nxt; int ui = 0;
    if (!S.next(0, cur)) return;
    if constexpr (GATHER) { PG8_GIDX_ISSUE(cur); asm volatile("s_waitcnt vmcnt(0)" ::: "memory"); PG8_GIDX_CONV(gcur, cur); }
    unsigned gsel[2][2] = {{0u, 0u}, {0u, 0u}};
    f32x4 acc[2][2][4][2];
#pragma unroll
    for (int a = 0; a < 2; ++a)
#pragma unroll
        for (int b = 0; b < 2; ++b)
#pragma unroll
            for (int m = 0; m < 4; ++m)
#pragma unroll
                for (int n = 0; n < 2; ++n) acc[a][b][m][n] = (f32x4){0.f, 0.f, 0.f, 0.f};
    bf16x8 At[4][2], B0[2][2], B1[2][2];
    i32x8 At8[4], B08[2], B18[2];
    const char* cA = (const char*)g.A + (GATHER ? (size_t)0 : (size_t)cur.pm * tstepA); const char* cB = (const char*)g.Bt + (size_t)cur.pb * tstepB;
    S.a_ready(cur);
    if constexpr (SP2) {
        PG8_STAGE(PG8_SB(0, 0), cB, voffB); PG8_STAGE(PG8_SB(0, 1), cB + hstepB, voffB); PG8_STAGE_A(PG8_SA(0, 0), cA, 0, false); PG8_STAGE_A(PG8_SA(0, 1), cA, 1, false);
        if (wr == 1) PG8_BAR;
        PG8_WAIT_V(2); PG8_BAR;
        PG8_STAGE(PG8_SB(1, 0), cB + kstep, voffB); PG8_STAGE_A(PG8_SA(1, 0), cA + kstep, 0, false); PG8_STAGE(PG8_SB(1, 1), cB + hstepB + kstep, voffB);
        PG8_WAIT_V(6); PG8_BAR;
    } else {
        PG8_STAGE(PG8_SB(0, 0), cB, voffB); PG8_STAGE(PG8_SA(0, 0), cA, voffA); PG8_STAGE(PG8_SB(0, 1), cB + hstepB, voffB); PG8_STAGE(PG8_SA(0, 1), cA + hstepA, voffA);
        if (wr == 1) PG8_BAR;
        PG8_WAIT_V(4); PG8_BAR;
        PG8_STAGE(PG8_SB(1, 0), cB + kstep, voffB); PG8_STAGE(PG8_SA(1, 0), cA + kstep, voffA); PG8_STAGE(PG8_SB(1, 1), cB + hstepB + kstep, voffB);
        PG8_WAIT_V(6); PG8_BAR;
    }
    for (;;) {
        const bool has_next = S.next(ui + 1, nxt);
        if constexpr (GATHER) { if (has_next) PG8_GIDX_ISSUE(nxt); }
        const char* nA = has_next ? (const char*)g.A + (GATHER ? (size_t)0 : (size_t)nxt.pm * tstepA) : cA; const char* nB = has_next ? (const char*)g.Bt + (size_t)nxt.pb * tstepB : cB;
#pragma unroll 1
        for (int t = 0; t < nt; t += 2) {
            const bool last = (t == nt - 2);
            const char* a1 = cA + (size_t)(t + 1) * kstep;
            const char* a2 = last ? nA : cA + (size_t)(t + 2) * kstep; const char* b2 = last ? nB : cB + (size_t)(t + 2) * kstep;
            const char* a3 = a2 + kstep; const char* b3 = b2 + kstep;
            if (last && has_next) S.a_ready(nxt);
            if constexpr (GATHER) { if (last) { if (has_next) { PG8_GIDX_CONV(gnxt, nxt); } else { _Pragma("unroll") for (int h_ = 0; h_ < 2; ++h_) _Pragma("unroll") for (int i_ = 0; i_ < 2; ++i_) gnxt[h_][i_] = gcur[h_][i_]; } }
                _Pragma("unroll") for (int h_ = 0; h_ < 2; ++h_) _Pragma("unroll") for (int i_ = 0; i_ < 2; ++i_) gsel[h_][i_] = last ? gnxt[h_][i_] : gcur[h_][i_]; }
            if constexpr (SP2) {
            PG8_LDB(B0, 0, 0); PG8_LDB(B1, 0, 1); PG8_SCHED; PG8_LDA(At, 0, 0); PG8_STAGE_A(PG8_SA(1, 1), a1, 1, false);
            PG8_WAIT_V(8); PG8_WAIT_L(0); PG8_BAR; PG8_MMA(0, 0, At, B0); PG8_MMA(0, 1, At, B1); PG8_BAR; PG8_SCHED;
            PG8_LDA(At, 0, 1); PG8_STAGE(PG8_SB(0, 0), b2, voffB); PG8_STAGE(PG8_SB(0, 1), b2 + hstepB, voffB); PG8_STAGE_A(PG8_SA(0, 0), a2, 0, true);
            PG8_WAIT_V(8); PG8_WAIT_L(0); PG8_BAR; PG8_MMA(1, 0, At, B0); PG8_MMA(1, 1, At, B1); PG8_BAR; PG8_SCHED;
            PG8_LDB(B0, 1, 0); PG8_LDB(B1, 1, 1); PG8_SCHED; PG8_LDA(At, 1, 0); PG8_STAGE_A(PG8_SA(0, 1), a2, 1, true);
            PG8_WAIT_V(8); PG8_WAIT_L(0); PG8_BAR; PG8_MMA(0, 0, At, B0); PG8_MMA(0, 1, At, B1); PG8_BAR; PG8_SCHED;
            PG8_LDA(At, 1, 1); PG8_STAGE(PG8_SB(1, 0), b3, voffB); PG8_STAGE(PG8_SB(1, 1), b3 + hstepB, voffB); PG8_STAGE_A(PG8_SA(1, 0), a3, 0, true);
            PG8_WAIT_V(8); PG8_WAIT_L(0); PG8_BAR; PG8_MMA(1, 0, At, B0); PG8_MMA(1, 1, At, B1); PG8_BAR; PG8_SCHED;
            if constexpr (epi_has_mid<Epi>::value) { if (t + 2 == Epi::MID_KT) E.mid(acc, cur, wr, wc, fr, fq); }
            } else {
            PG8_LDB(B0, 0, 0); PG8_SCHED; PG8_LDA(At, 0, 0); PG8_STAGE(PG8_SA(1, 1), a1 + hstepA, voffA);
            PG8_WAIT_L(8); PG8_BAR; PG8_WAIT_L(0); PG8_MMA(0, 0, At, B0); PG8_BAR; PG8_SCHED;
            PG8_LDB(B1, 0, 1); PG8_STAGE(PG8_SB(0, 0), b2, voffB);
            PG8_BAR; PG8_WAIT_L(0); PG8_MMA(0, 1, At, B1); PG8_BAR;
            PG8_LDA(At, 0, 1); PG8_STAGE(PG8_SA(0, 0), a2, voffA);
            PG8_BAR; PG8_WAIT_L(0); PG8_MMA(1, 0, At, B0); PG8_BAR; PG8_SCHED;
            PG8_STAGE(PG8_SB(0, 1), b2 + hstepB, voffB);
            PG8_WAIT_V(6); PG8_BAR; PG8_MMA(1, 1, At, B1); PG8_BAR;
            PG8_LDB(B0, 1, 0); PG8_SCHED; PG8_LDA(At, 1, 0); PG8_STAGE(PG8_SA(0, 1), a2 + hstepA, voffA);
            PG8_WAIT_L(8); PG8_BAR; PG8_WAIT_L(0); PG8_MMA(0, 0, At, B0); PG8_BAR; PG8_SCHED;
            PG8_LDB(B1, 1, 1); PG8_STAGE(PG8_SB(1, 0), b3, voffB);
            PG8_BAR; PG8_WAIT_L(0); PG8_MMA(0, 1, At, B1); PG8_BAR;
            PG8_LDA(At, 1, 1); PG8_STAGE(PG8_SA(1, 0), a3, voffA);
            PG8_BAR; PG8_WAIT_L(0); PG8_MMA(1, 0, At, B0); PG8_BAR; PG8_SCHED;
            PG8_STAGE(PG8_SB(1, 1), b3 + hstepB, voffB);
            PG8_WAIT_V(6); PG8_BAR; PG8_MMA(1, 1, At, B1); PG8_BAR;
            }
        }
        if constexpr (ALIGN_EPI) { if (wr == 0) PG8_BAR; }
        if constexpr (FP8) {
            asm volatile("s_nop 15\n\ts_nop 15" ::: "memory");
#pragma unroll
            for (int a = 0; a < 2; ++a)
#pragma unroll
                for (int b = 0; b < 2; ++b)
#pragma unroll
                    for (int m = 0; m < 4; ++m)
#pragma unroll
                        for (int n = 0; n < 2; ++n) asm volatile("" : "+v"(acc[a][b][m][n]));
        }
        if constexpr (!Epi::AFTER_DRAIN) { E(acc, cur, wr, wc, fr, fq); S.done(cur); }
        if (!has_next) break;
#pragma unroll
        for (int a = 0; a < 2; ++a)
#pragma unroll
            for (int b = 0; b < 2; ++b)
#pragma unroll
                for (int m = 0; m < 4; ++m)
#pragma unroll
                    for (int n = 0; n < 2; ++n) acc[a][b][m][n] = (f32x4){0.f, 0.f, 0.f, 0.f};
        cur = nxt; cA = nA; cB = nB; ++ui;
        if constexpr (GATHER) { _Pragma("unroll") for (int h_ = 0; h_ < 2; ++h_) _Pragma("unroll") for (int i_ = 0; i_ < 2; ++i_) gcur[h_][i_] = gnxt[h_][i_]; }
        if constexpr (ALIGN_EPI) { if (wr == 1) PG8_BAR; }
    }
    PG8_WAIT_V(0);
    if constexpr (!ALIGN_EPI) { if (wr == 0) PG8_BAR; }
    PG8_BAR;
    if constexpr (Epi::AFTER_DRAIN) { E.fused(acc, cur, wr, wc, fr, fq, lds, wid, lane); S.done(cur); }
#undef PG8_SA
#undef PG8_SB
#undef PG8_STAGE
#undef PG8_LDA
#undef PG8_LDB
#undef PG8_MMA
#undef PG8_WAIT_V
#undef PG8_WAIT_L
#undef PG8_BAR
#undef PG8_SCHED
#undef PG8_GIDX_ISSUE
#undef PG8_GIDX_CONV
#undef PG8_STAGE_A
}
}
#include <hip/hip_bf16.h>
#include <cmath>
namespace attn_body {
using bf16=__hip_bfloat16;
using bf16x8=__attribute__((ext_vector_type(8)))short;
using s16x4=__attribute__((ext_vector_type(4)))short;
using f32x16=__attribute__((ext_vector_type(16)))float;
using u32x4=__attribute__((ext_vector_type(4)))unsigned;
constexpr int BATCH=8,NHEAD=8,NKVH=2,SEQ=8192,D=64,QP=512,KVP=256,OP=768;
constexpr int NW=8,QBLK=32,QB=QBLK*NW,KVBLK=64,NQB=SEQ/QB;
constexpr int ATTN_UNIT_ROWS=QB;
__device__ __forceinline__ int crow(int r,int hi){return (r&3)+8*(r>>2)+4*hi;}
#define SBAR() __builtin_amdgcn_sched_barrier(0)
__device__ __forceinline__ void cmask(f32x16&p0,f32x16&p1,int jb,int qrel,int hi){
  const float NEG=-INFINITY; int kb=64*jb+4*hi;
  #pragma unroll
  for(int r=0;r<16;++r){int kv=kb+(r&3)+8*(r>>2); if(kv>qrel)p0[r]=NEG; if(kv+32>qrel)p1[r]=NEG;}
}

constexpr int NSLOT=3, SLOTB=8192;
constexpr int LDS_K=0, LDS_V=NSLOT*SLOTB, LDS_WS=2*NSLOT*SLOTB, LDS_OST=LDS_WS+NW*64*4, LDS_BYTES=LDS_OST+NW*4096;
constexpr float C2=0.125f*1.4426950408889634f;
__device__ __forceinline__ void glds16(const void*gsrc,unsigned lds_dst){unsigned keep;
  asm volatile("s_mov_b32 %0, m0\n\ts_mov_b32 m0, %2\n\ts_nop 0\n\tglobal_load_lds_dwordx4 %1, off\n\ts_mov_b32 m0, %0":"=&s"(keep):"v"(gsrc),"s"(lds_dst):"memory");}
__device__ __forceinline__ float max3f(float a,float b,float c){float r;asm("v_max3_f32 %0, %1, %2, %3":"=v"(r):"v"(a),"v"(b),"v"(c));return r;}
__device__ __forceinline__ float max2f(float a,float b){float r;asm("v_max_f32_e32 %0, %1, %2":"=v"(r):"v"(a),"v"(b));return r;}
__device__ __forceinline__ float fadd_s(float a,float b){float r;asm("v_add_f32_e32 %0, %1, %2":"=v"(r):"v"(a),"v"(b));return r;}
__device__ __forceinline__ float fsub_s(float a,float b){float r;asm("v_sub_f32_e32 %0, %1, %2":"=v"(r):"v"(a),"v"(b));return r;}
typedef float f32x2_t __attribute__((ext_vector_type(2))); typedef __bf16 bf16x2_t __attribute__((ext_vector_type(2)));
__device__ __forceinline__ unsigned cvtpk_s(float lo,float hi){f32x2_t v={lo,hi};bf16x2_t b=__builtin_convertvector(v,bf16x2_t);return __builtin_bit_cast(unsigned,b);}
#define WAIT_BAR(N) asm volatile("s_waitcnt vmcnt(" #N ") lgkmcnt(0)\n\ts_barrier":::"memory")

__device__ __forceinline__ void qkt(f32x16&p0,f32x16&p1,const char*Kslot,const bf16x8*qr,const f32x16&negm,int r32,int hi){
  const char*kb=Kslot+hi*1024+r32*16;
  #pragma unroll
  for(int d0=0;d0<4;++d0){
    const bf16x8 b0=*reinterpret_cast<const bf16x8*>(kb+d0*2048);
    const bf16x8 b1=*reinterpret_cast<const bf16x8*>(kb+d0*2048+512);
    if(d0==0){p0=__builtin_amdgcn_mfma_f32_32x32x16_bf16(b0,qr[0],negm,0,0,0);p1=__builtin_amdgcn_mfma_f32_32x32x16_bf16(b1,qr[0],negm,0,0,0);}
    else{p0=__builtin_amdgcn_mfma_f32_32x32x16_bf16(b0,qr[d0],p0,0,0,0);p1=__builtin_amdgcn_mfma_f32_32x32x16_bf16(b1,qr[d0],p1,0,0,0);}}
}
typedef __attribute__((address_space(3))) const char* lds_cptr;
typedef short v4i16_t __attribute__((ext_vector_type(4)));
__device__ __forceinline__ void kload8(bf16x8*kf,lds_cptr kp){
  kf[0]=*(const __attribute__((address_space(3))) bf16x8*)(kp);      kf[1]=*(const __attribute__((address_space(3))) bf16x8*)(kp+512);
  kf[2]=*(const __attribute__((address_space(3))) bf16x8*)(kp+2048); kf[3]=*(const __attribute__((address_space(3))) bf16x8*)(kp+2560);
  kf[4]=*(const __attribute__((address_space(3))) bf16x8*)(kp+4096); kf[5]=*(const __attribute__((address_space(3))) bf16x8*)(kp+4608);
  kf[6]=*(const __attribute__((address_space(3))) bf16x8*)(kp+6144); kf[7]=*(const __attribute__((address_space(3))) bf16x8*)(kp+6656);
}
__device__ __forceinline__ void kload2(bf16x8*kf,lds_cptr kp,int j){ kf[2*j]=*(const __attribute__((address_space(3))) bf16x8*)(kp+j*2048); kf[2*j+1]=*(const __attribute__((address_space(3))) bf16x8*)(kp+j*2048+512); }
__device__ __forceinline__ s16x4 vtr(lds_cptr p){ return __builtin_bit_cast(s16x4,__builtin_amdgcn_ds_read_tr16_b64_v4i16((__attribute__((address_space(3))) v4i16_t*)p)); }
__device__ __forceinline__ float rowmax(const f32x16&p0,const f32x16&p1){
  float a=max3f(p0[0],p0[1],p1[0]),b=max3f(p0[2],p0[3],p1[1]);a=max3f(a,p1[2],p1[3]);
  #pragma unroll
  for(int r=4;r<16;r+=4){a=max3f(a,p0[r],p0[r+1]);b=max3f(b,p0[r+2],p0[r+3]);a=max3f(a,p1[r],p1[r+1]);b=max3f(b,p1[r+2],p1[r+3]);}
  const float m=max2f(a,b);
  auto rr=__builtin_amdgcn_permlane32_swap(__float_as_uint(m),__float_as_uint(m),false,false);
  return max2f(__uint_as_float(rr[0]),__uint_as_float(rr[1]));
}
__device__ __forceinline__ void pv(f32x16*o,int vb,bf16x8 pa0,bf16x8 pa1,bf16x8 pa2,bf16x8 pa3){
  #pragma unroll
  for(int d0=0;d0<2;++d0){s16x4 lo[4],hi[4];
    #pragma unroll
    for(int ks=0;ks<4;++ks){
      asm volatile("ds_read_b64_tr_b16 %0,%1 offset:%c2":"=&v"(lo[ks]):"v"(vb),"i"(d0*4096+ks*1024):"memory");
      asm volatile("ds_read_b64_tr_b16 %0,%1 offset:%c2":"=&v"(hi[ks]):"v"(vb),"i"(d0*4096+ks*1024+512):"memory");}
    asm volatile("s_waitcnt lgkmcnt(0)":::"memory");SBAR();
    #define PK(k) (bf16x8){lo[k][0],lo[k][1],lo[k][2],lo[k][3],hi[k][0],hi[k][1],hi[k][2],hi[k][3]}
    o[d0]=__builtin_amdgcn_mfma_f32_32x32x16_bf16(pa0,PK(0),o[d0],0,0,0);
    o[d0]=__builtin_amdgcn_mfma_f32_32x32x16_bf16(pa1,PK(1),o[d0],0,0,0);
    o[d0]=__builtin_amdgcn_mfma_f32_32x32x16_bf16(pa2,PK(2),o[d0],0,0,0);
    o[d0]=__builtin_amdgcn_mfma_f32_32x32x16_bf16(pa3,PK(3),o[d0],0,0,0);
    #undef PK
  }
}

#ifndef ATTN_STORE16
#define ATTN_STORE16(p,v) (*(u32x4*)(p)=(v))
#endif
template<int THRL,bool FIXREF> __device__ __forceinline__ void attn_unit(int b,int h,int qb,const bf16*Q,const bf16*__restrict__ K,const bf16*__restrict__ V,bf16*O,char*shm,float cref){
  const int tid=threadIdx.x,lane=tid&63,r32=lane&31,hi=lane>>5; const int wid=__builtin_amdgcn_readfirstlane(tid>>6);
  const long rowbase=(long)b*SEQ; const int q0=qb*QB;
  const bf16*Qw=Q+(rowbase+q0+wid*QBLK)*QP+h*D;
  const bf16*Kh=K+rowbase*KVP+(h>>2)*D,*Vh=V+rowbase*KVP+(h>>2)*D;
  const unsigned lds0=(unsigned)(uintptr_t)shm;
  float*wsf=(float*)(shm+LDS_WS)+wid*64;
  const bf16*ksrc=Kh+(long)lane*KVP+wid*8;
  const bf16*vsrc=Vh+(long)(16*(wid&3)+(lane>>2))*KVP+(wid>>2)*32+(lane&3)*8;
  const unsigned kdst=lds0+LDS_K+wid*1024, vdst=lds0+LDS_V+wid*1024;
  #define DMA_K(t,slot) glds16(ksrc+(long)(t)*KVBLK*KVP,(unsigned)__builtin_amdgcn_readfirstlane(kdst+(slot)))
  #define DMA_V(t,slot) glds16(vsrc+(long)(t)*KVBLK*KVP,(unsigned)__builtin_amdgcn_readfirstlane(vdst+(slot)))
  const int vb0=(int)(lds0+LDS_V)+((lane>>4)&1)*32+(lane&3)*8+(4*hi+((lane&15)>>2))*64;
  const char*Kbase=shm+LDS_K; bf16x8 kf[8];
  const lds_cptr shm3=(lds_cptr)shm; const lds_cptr kp0=shm3+LDS_K+hi*1024+r32*16; const lds_cptr vp0=shm3+LDS_V+((lane>>4)&1)*32+(lane&3)*8+(4*hi+((lane&15)>>2))*64;
  const int NT=SEQ/KVBLK;
  DMA_K(0,0);DMA_V(0,0);DMA_K(1,SLOTB);
  bf16x8 qr[4];
  #pragma unroll
  for(int d0=0;d0<4;++d0)qr[d0]=*reinterpret_cast<const bf16x8*>(&Qw[(long)r32*QP+d0*16+hi*8]);
  float mhat=0.f,l_reg=0.f;f32x16 o[2];o[0]=f32x16{};o[1]=f32x16{};f32x16 negm=f32x16{};
  if constexpr(FIXREF){ _Pragma("unroll") for(int r=0;r<16;++r)negm[r]=-cref; }
  asm volatile("":"+v"(negm));
    #define CMASK(P0,P1,t) do{}while(0)
  bool resc=false;
  #define START(P0,P1) do{ resc=false; if constexpr(!FIXREF) \
    { const float rm=rowmax(P0,P1); const float dl=rm; mhat=fadd_s(mhat,dl); \
      _Pragma("unroll") for(int r=0;r<16;++r){P0[r]=fsub_s(P0[r],dl);P1[r]=fsub_s(P1[r],dl);} \
      _Pragma("unroll") for(int r=0;r<16;++r)negm[r]=-mhat; asm volatile("":"+v"(negm)); } \
    _Pragma("unroll") for(int r=0;r<16;++r)P0[r]=__builtin_amdgcn_exp2f(P0[r]); }while(0)
  #define RESC() do{ if(resc){ asm volatile("s_waitcnt lgkmcnt(0)":::"memory"); \
      _Pragma("unroll") for(int d_=0;d_<2;++d_) _Pragma("unroll") for(int r=0;r<16;++r)o[d_][r]*=wsf[crow(r,hi)]; } }while(0)
  f32x16 pA0,pA1,pB0,pB1;
  int sl_prev=0,sl_cur=0,sl_next=SLOTB;
  #define ROT() do{sl_prev=sl_cur;sl_cur=sl_next;sl_next=(sl_next==(NSLOT-1)*SLOTB)?0:sl_next+SLOTB;}while(0)
  DMA_K(2,2*SLOTB);
  WAIT_BAR(3);
  qkt(pA0,pA1,Kbase,qr,negm,r32,hi);asm volatile("s_nop 15\n\ts_nop 7":"+v"(pA0),"+v"(pA1));CMASK(pA0,pA1,0);
  START(pA0,pA1);
  _Pragma("unroll") for(int r=0;r<16;++r)pA1[r]=__builtin_amdgcn_exp2f(pA1[r]);
  WAIT_BAR(0);
  DMA_K(3,0);DMA_V(1,SLOTB);
  ROT();
  kload8(kf,kp0+sl_cur);
  WAIT_BAR(2);
  s16x4 vlo[8],vhi[8]; u32x4 pw0,pw1,pw2,pw3;
  #define PKW(P,B) cvtpk_s(P[B],P[B+1])
  #define PAF(k) __builtin_bit_cast(bf16x8,pw##k)
  #define VFR(i) (bf16x8){vlo[i][0],vlo[i][1],vlo[i][2],vlo[i][3],vhi[i][0],vhi[i][1],vhi[i][2],vhi[i][3]}
  #define PIN(x) asm volatile("":"+v"(x))
  #define MX3(a,b,c) __builtin_fmaxf(__builtin_fmaxf((a),(b)),(c))
  #define GAPA(MF,A0,A1,A2,A3,W0,W1,PW) do{ MF; sacc+=A0; sacc+=A1; sacc+=A2; sacc+=A3; PIN(sacc); W0; W1; PIN(PW); SBAR(); }while(0)
  #define EX(v) __builtin_amdgcn_exp2f(v)
  #define GAPB(MF,X,B) do{ MF; X[B]=EX(X[B]); X[B+1]=EX(X[B+1]); X[B+2]=EX(X[B+2]); X[B+3]=EX(X[B+3]); PIN(X); SBAR(); }while(0)
  #define VRD(i) do{ vlo[i]=vtr(vp_+(((i)>>2)*4096+((i)&3)*1024)); vhi[i]=vtr(vp_+(((i)>>2)*4096+((i)&3)*1024+512)); }while(0)
  #define KRD(G,j) do{ if(G){ kload2(kf,kp0+sl_next,j); SBAR(); } }while(0)
  #define STEP(C0,C1,P0,P1,t,GK,GV,GL) do{ SBAR(); \
    const lds_cptr vp_=vp0+sl_prev; \
    VRD(0); SBAR(); float sacc=(P0[0]+P0[1]); \
    GAPA(C0=__builtin_amdgcn_mfma_f32_32x32x16_bf16(kf[0],qr[0],negm,0,0,0), P0[2],P0[3],P0[4],P0[5],     pw0[0]=PKW(P0,0), pw0[1]=PKW(P0,2), pw0); \
    VRD(4); SBAR(); GAPA(C1=__builtin_amdgcn_mfma_f32_32x32x16_bf16(kf[1],qr[0],negm,0,0,0), P0[6],P0[7],P0[8],P0[9],     pw0[2]=PKW(P0,4), pw0[3]=PKW(P0,6), pw0); \
    VRD(1); SBAR(); GAPA(C0=__builtin_amdgcn_mfma_f32_32x32x16_bf16(kf[2],qr[1],C0,0,0,0),   P0[10],P0[11],P0[12],P0[13], pw1[0]=PKW(P0,8), pw1[1]=PKW(P0,10), pw1); \
    VRD(5); SBAR(); GAPA(C1=__builtin_amdgcn_mfma_f32_32x32x16_bf16(kf[3],qr[1],C1,0,0,0),   P0[14],P0[15],P1[0],P1[1],   pw1[2]=PKW(P0,12),pw1[3]=PKW(P0,14), pw1); \
    VRD(2); SBAR(); GAPA(C0=__builtin_amdgcn_mfma_f32_32x32x16_bf16(kf[4],qr[2],C0,0,0,0),   P1[2],P1[3],P1[4],P1[5],     pw2[0]=PKW(P1,0), pw2[1]=PKW(P1,2), pw2); \
    VRD(6); SBAR(); GAPA(C1=__builtin_amdgcn_mfma_f32_32x32x16_bf16(kf[5],qr[2],C1,0,0,0),   P1[6],P1[7],P1[8],P1[9],     pw2[2]=PKW(P1,4), pw2[3]=PKW(P1,6), pw2); \
    VRD(3); SBAR(); GAPA(C0=__builtin_amdgcn_mfma_f32_32x32x16_bf16(kf[6],qr[3],C0,0,0,0),   P1[10],P1[11],P1[12],P1[13], pw3[0]=PKW(P1,8), pw3[1]=PKW(P1,10), pw3); \
    VRD(7); SBAR(); GAPA(C1=__builtin_amdgcn_mfma_f32_32x32x16_bf16(kf[7],qr[3],C1,0,0,0),   P1[14],P1[15],0.f,0.f,       pw3[2]=PKW(P1,12),pw3[3]=PKW(P1,14), pw3); \
    l_reg+=sacc; \
    if(GK){DMA_K((t)+3,sl_cur);} if(GV){DMA_V((t)+1,sl_next);} \
    CMASK(C0,C1,t); \
    if constexpr(!FIXREF){ float a=MX3(C0[0],C0[1],C1[0]),b=MX3(C0[2],C0[3],C1[1]); a=MX3(a,C1[2],C1[3]); \
      _Pragma("unroll") for(int r=4;r<16;r+=4){a=MX3(a,C0[r],C0[r+1]);b=MX3(b,C0[r+2],C0[r+3]);a=MX3(a,C1[r],C1[r+1]);b=MX3(b,C1[r+2],C1[r+3]);} \
      float rm=__builtin_fmaxf(a,b); { auto rr=__builtin_amdgcn_permlane32_swap(__float_as_uint(rm),__float_as_uint(rm),false,false); rm=__builtin_fmaxf(__uint_as_float(rr[0]),__uint_as_float(rr[1])); } \
      resc=false; \
      if(__builtin_expect(__any(rm>(float)THRL),0)){ const float dl=__builtin_fmaxf(rm,0.f); mhat+=dl; \
        _Pragma("unroll") for(int r=0;r<16;++r){C0[r]-=dl;C1[r]-=dl;} \
        _Pragma("unroll") for(int r=0;r<16;++r)negm[r]=-mhat; asm volatile("":"+v"(negm)); \
        const float f=__builtin_amdgcn_exp2f(-dl); l_reg*=f; if(hi==0)wsf[r32]=f; resc=true; } } \
    SBAR(); \
    GAPB(o[0]=__builtin_amdgcn_mfma_f32_32x32x16_bf16(PAF(0),VFR(0),o[0],0,0,0), C0,0); \
    GAPB(o[1]=__builtin_amdgcn_mfma_f32_32x32x16_bf16(PAF(0),VFR(4),o[1],0,0,0), C0,4); \
    KRD(GL,0); GAPB(o[0]=__builtin_amdgcn_mfma_f32_32x32x16_bf16(PAF(1),VFR(1),o[0],0,0,0), C0,8); \
    KRD(GL,1); GAPB(o[1]=__builtin_amdgcn_mfma_f32_32x32x16_bf16(PAF(1),VFR(5),o[1],0,0,0), C0,12); \
    KRD(GL,2); GAPB(o[0]=__builtin_amdgcn_mfma_f32_32x32x16_bf16(PAF(2),VFR(2),o[0],0,0,0), C1,0); \
    KRD(GL,3); GAPB(o[1]=__builtin_amdgcn_mfma_f32_32x32x16_bf16(PAF(2),VFR(6),o[1],0,0,0), C1,4); \
    GAPB(o[0]=__builtin_amdgcn_mfma_f32_32x32x16_bf16(PAF(3),VFR(3),o[0],0,0,0), C1,8); \
    GAPB(o[1]=__builtin_amdgcn_mfma_f32_32x32x16_bf16(PAF(3),VFR(7),o[1],0,0,0), C1,12); \
    }while(0)
  int t=1;
  #undef CMASK
  #define CMASK(P0,P1,t) do{}while(0)
  for(;t+5<NT;t+=2){
    STEP(pB0,pB1,pA0,pA1,t,true,true,true);     WAIT_BAR(2); RESC(); ROT();
    STEP(pA0,pA1,pB0,pB1,t+1,true,true,true);   WAIT_BAR(2); RESC(); ROT();
  }
  #undef CMASK
  #define CMASK(P0,P1,t) do{}while(0)
  #define ENDW(tt) do{ if((tt)+3<NT){WAIT_BAR(2);} else if((tt)+2<NT){WAIT_BAR(1);} else {WAIT_BAR(0);} }while(0)
  for(;t+1<NT;t+=2){
    STEP(pB0,pB1,pA0,pA1,t,(t+3<NT),(t+1<NT),(t+1<NT));       ENDW(t);   RESC(); ROT();
    STEP(pA0,pA1,pB0,pB1,t+1,(t+4<NT),(t+2<NT),(t+2<NT));     ENDW(t+1); RESC(); ROT();
  }
  STEP(pB0,pB1,pA0,pA1,NT-1,false,false,false); RESC();
  { float sacc=pB0[0]+pB0[1]; _Pragma("unroll") for(int r=2;r<16;++r)sacc+=pB0[r]; _Pragma("unroll") for(int r=0;r<16;++r)sacc+=pB1[r]; l_reg+=sacc;
    pw0=(u32x4){PKW(pB0,0),PKW(pB0,2),PKW(pB0,4),PKW(pB0,6)};pw1=(u32x4){PKW(pB0,8),PKW(pB0,10),PKW(pB0,12),PKW(pB0,14)};pw2=(u32x4){PKW(pB1,0),PKW(pB1,2),PKW(pB1,4),PKW(pB1,6)};pw3=(u32x4){PKW(pB1,8),PKW(pB1,10),PKW(pB1,12),PKW(pB1,14)};
    SBAR(); pv(o,vb0+sl_cur,PAF(0),PAF(1),PAF(2),PAF(3)); }
  #undef PKW
  #undef PAF
  #undef VFR
  #undef PIN
  #undef MX3
  #undef GAPA
  #undef GAPB
  #undef EX
  #undef VRD
  #undef KRD
  #undef STEP
  #undef ENDW
  {auto rr=__builtin_amdgcn_permlane32_swap(__float_as_uint(l_reg),__float_as_uint(l_reg),false,false);l_reg=__uint_as_float(rr[0])+__uint_as_float(rr[1]);}
  if(hi==0)wsf[32+r32]=l_reg;asm volatile("s_waitcnt lgkmcnt(0)":::"memory");
  float rli[16];
  #pragma unroll
  for(int r=0;r<16;++r)rli[r]=__builtin_amdgcn_rcpf(wsf[32+crow(r,hi)]);
  bf16*Ow=O+(rowbase+q0+wid*QBLK)*OP+h*D;
  { bf16*stg=(bf16*)(shm+LDS_OST)+wid*2048;
    #pragma unroll
    for(int r=0;r<16;++r){const int orow=crow(r,hi);
      #pragma unroll
      for(int d0=0;d0<2;++d0)stg[orow*64+d0*32+r32]=__float2bfloat16(o[d0][r]*rli[r]);}
    asm volatile("s_waitcnt lgkmcnt(0)":::"memory");
    #pragma unroll
    for(int i=0;i<4;++i){const int row=i*8+(lane>>3),ch=lane&7; const u32x4 v=*(const u32x4*)(stg+row*64+ch*8); ATTN_STORE16(Ow+(long)row*OP+ch*8,v);} }
  asm volatile("s_waitcnt lgkmcnt(0)\n\ts_barrier":::"memory");
  #undef DMA_K
  #undef DMA_V
  #undef CMASK
  #undef START
  #undef RESC
  #undef ROT
}
constexpr int ATTN_LDS_BYTES=LDS_BYTES;
struct AttnTensors { const bf16* Q; const bf16* K; const bf16* V; bf16* O; };
struct AttnUnit { int b; int h; int qb; };
struct StaticOrder {
  int vcu, G;
  __device__ __forceinline__ StaticOrder(int grid,int vcu_):vcu(vcu_),G(grid){}
  __device__ __forceinline__ bool next(int i,AttnUnit&u)const{ const int L=i*G+vcu; if(L>=BATCH*NHEAD*NQB)return false;
    const int rnd=L>>8, x=(L>>5)&7, w=L&31; const int pair=x*2+(rnd>>2); const int uu=(rnd&3)*32+w;
    u.b=pair>>1; u.h=(pair&1)*4+(uu>>5); u.qb=uu&31; return true; }
};
template<class Sched,int THRL=8> __device__ __forceinline__ void attn_phase(char*lds,const AttnTensors&T,const Sched&S,float cref){
  AttnUnit u;
  for(int i=0;S.next(i,u);++i){ attn_unit<THRL,true>(u.b,u.h,u.qb,T.Q,T.K,T.V,T.O,lds,cref); }
}
#undef SBAR
#undef WAIT_BAR
}
namespace attnb {
using attn_body::bf16; using attn_body::bf16x8; using attn_body::s16x4; using attn_body::f32x16; using attn_body::u32x4; using attn_body::lds_cptr;
using attn_body::crow; using attn_body::glds16; using attn_body::cvtpk_s; using attn_body::kload8;
constexpr int SEQ = 8192, PB = 768, OP = 768, OCOL = 512;
#define ATB_MX3(a,b,c) __builtin_fmaxf(__builtin_fmaxf((a),(b)),(c))
__device__ __forceinline__ void pvb(f32x16*o,int vb,bf16x8 pa0,bf16x8 pa1,bf16x8 pa2,bf16x8 pa3){
  #pragma unroll
  for(int d0=0;d0<2;++d0){s16x4 lo[4],hi[4];
    #pragma unroll
    for(int ks=0;ks<4;++ks){
      asm volatile("ds_read_b64_tr_b16 %0,%1 offset:%c2":"=&v"(lo[ks]):"v"(vb),"i"(d0*4096+ks*1024):"memory");
      asm volatile("ds_read_b64_tr_b16 %0,%1 offset:%c2":"=&v"(hi[ks]):"v"(vb),"i"(d0*4096+ks*1024+512):"memory");}
    asm volatile("s_waitcnt lgkmcnt(0)":::"memory");__builtin_amdgcn_sched_barrier(0);
    #define ATB_PK(k) (bf16x8){lo[k][0],lo[k][1],lo[k][2],lo[k][3],hi[k][0],hi[k][1],hi[k][2],hi[k][3]}
    o[d0]=__builtin_amdgcn_mfma_f32_32x32x16_bf16(pa0,ATB_PK(0),o[d0],0,0,0);
    o[d0]=__builtin_amdgcn_mfma_f32_32x32x16_bf16(pa1,ATB_PK(1),o[d0],0,0,0);
    o[d0]=__builtin_amdgcn_mfma_f32_32x32x16_bf16(pa2,ATB_PK(2),o[d0],0,0,0);
    o[d0]=__builtin_amdgcn_mfma_f32_32x32x16_bf16(pa3,ATB_PK(3),o[d0],0,0,0);
    #undef ATB_PK
  }
}
__device__ __forceinline__ void attnb_job(int b,int j,int tt,const bf16*Qb,const bf16*__restrict__ Kb,const bf16*__restrict__ Vb,bf16*O,char*wl,float*wsf){
  const int lane=threadIdx.x&63,r32=lane&31,hi=lane>>5;
  const long rowbase=(long)b*SEQ; const int T0=(tt>>4)*512+(tt&15);
  const unsigned lds0=(unsigned)__builtin_amdgcn_readfirstlane((int)(unsigned)(uintptr_t)wl);
  const lds_cptr kp0=(lds_cptr)wl+hi*1024+r32*16;
  const int vb0=(int)(lds0+8192u)+((lane>>4)&1)*32+(lane&3)*8+(4*hi+((lane&15)>>2))*64;
  float m_run=-INFINITY,l_run=0.f; f32x16 o[2]; o[0]=f32x16{}; o[1]=f32x16{};
  #pragma unroll 1
  for(int g=0;g<3;++g){
    const int sh=2*g,d=1<<sh,stride=16>>sh,ntile=(g==0)?10:((g==1)?4:3),hq=g*4+j;
    const float slope2=exp2f(-8.0f*(float)(hq+1)/12.0f)*(float)d*1.4426950408889634f;
    const int rc=T0&(d-1),s0=T0>>sh,sk0=s0-64,smax=(SEQ>>sh)-1,sq=s0+stride*r32;
    const bf16*Qw=Qb+(rowbase+T0+16*r32)*PB+hq*64;
    bf16x8 qr[4];
    #pragma unroll
    for(int d0=0;d0<4;++d0)qr[d0]=*reinterpret_cast<const bf16x8*>(Qw+d0*16+hi*8);
    const float lo_f=(float)max(-64,-sq),hi_f=(float)min(64,smax-sq);
    const bf16*Kg=Kb+(rowbase+rc)*PB+hq*64; const bf16*Vg=Vb+(rowbase+rc)*PB+hq*64+(lane&3)*8;
    #define ATB_DMAK(tau) do{ int s_=sk0+64*(tau)+lane; s_=min(max(s_,0),smax); const bf16*src_=Kg+(long)(d*s_)*PB; \
        _Pragma("unroll") for(int c_=0;c_<8;++c_)glds16(src_+c_*8,lds0+c_*1024u); }while(0)
    #define ATB_DMAV(tau) do{ _Pragma("unroll") for(int kg_=0;kg_<4;++kg_){ int s_=sk0+64*(tau)+16*kg_+(lane>>2); s_=min(max(s_,0),smax); const bf16*src_=Vg+(long)(d*s_)*PB; \
        glds16(src_,lds0+8192u+kg_*1024u); glds16(src_+32,lds0+8192u+(4+kg_)*1024u);} }while(0)
    ATB_DMAK(0); ATB_DMAV(0);
    #pragma unroll 1
    for(int tau=0;tau<ntile;++tau){
      asm volatile("s_waitcnt vmcnt(8)":::"memory");
      bf16x8 kf[8]; kload8(kf,kp0);
      asm volatile("s_waitcnt lgkmcnt(0)":::"memory");
      const bool more=(tau+1<ntile);
      if(more){ATB_DMAK(tau+1);}
      f32x16 p0=f32x16{},p1=f32x16{};
      #pragma unroll
      for(int d0=0;d0<4;++d0){ p0=__builtin_amdgcn_mfma_f32_32x32x16_bf16(kf[2*d0],qr[d0],p0,0,0,0); p1=__builtin_amdgcn_mfma_f32_32x32x16_bf16(kf[2*d0+1],qr[d0],p1,0,0,0); }
      const float basef=(float)(64*tau-64-stride*r32+4*hi);
      #pragma unroll
      for(int r=0;r<16;++r){ const float c0=basef+(float)((r&3)+8*(r>>2)),c1=c0+32.0f;
        p0[r]=(c0>=lo_f&&c0<=hi_f)?__builtin_fmaf(-slope2,__builtin_fabsf(c0),p0[r]):-INFINITY;
        p1[r]=(c1>=lo_f&&c1<=hi_f)?__builtin_fmaf(-slope2,__builtin_fabsf(c1),p1[r]):-INFINITY; }
      float rm;
      { float a=ATB_MX3(p0[0],p0[1],p1[0]),bb=ATB_MX3(p0[2],p0[3],p1[1]); a=ATB_MX3(a,p1[2],p1[3]);
        #pragma unroll
        for(int r=4;r<16;r+=4){a=ATB_MX3(a,p0[r],p0[r+1]);bb=ATB_MX3(bb,p0[r+2],p0[r+3]);a=ATB_MX3(a,p1[r],p1[r+1]);bb=ATB_MX3(bb,p1[r+2],p1[r+3]);}
        rm=__builtin_fmaxf(a,bb); auto rr=__builtin_amdgcn_permlane32_swap(__float_as_uint(rm),__float_as_uint(rm),false,false); rm=__builtin_fmaxf(__uint_as_float(rr[0]),__uint_as_float(rr[1])); }
      const float m_new=__builtin_fmaxf(m_run,rm); const float m_safe=(m_new==-INFINITY)?0.0f:m_new;
      const float alpha=__builtin_amdgcn_exp2f(m_run-m_safe);
      float sum=0.f;
      #pragma unroll
      for(int r=0;r<16;++r){ p0[r]=__builtin_amdgcn_exp2f(p0[r]-m_safe); p1[r]=__builtin_amdgcn_exp2f(p1[r]-m_safe); sum+=p0[r]+p1[r]; }
      l_run=l_run*alpha+sum; m_run=m_new;
      if(hi==0)wsf[r32]=alpha;
      asm volatile("s_waitcnt lgkmcnt(0)":::"memory");
      #pragma unroll
      for(int r=0;r<16;++r){ const float f=wsf[crow(r,hi)]; o[0][r]*=f; o[1][r]*=f; }
      u32x4 pw0,pw1,pw2,pw3;
      pw0=(u32x4){cvtpk_s(p0[0],p0[1]),cvtpk_s(p0[2],p0[3]),cvtpk_s(p0[4],p0[5]),cvtpk_s(p0[6],p0[7])};
      pw1=(u32x4){cvtpk_s(p0[8],p0[9]),cvtpk_s(p0[10],p0[11]),cvtpk_s(p0[12],p0[13]),cvtpk_s(p0[14],p0[15])};
      pw2=(u32x4){cvtpk_s(p1[0],p1[1]),cvtpk_s(p1[2],p1[3]),cvtpk_s(p1[4],p1[5]),cvtpk_s(p1[6],p1[7])};
      pw3=(u32x4){cvtpk_s(p1[8],p1[9]),cvtpk_s(p1[10],p1[11]),cvtpk_s(p1[12],p1[13]),cvtpk_s(p1[14],p1[15])};
      if(more){asm volatile("s_waitcnt vmcnt(8)":::"memory");}else{asm volatile("s_waitcnt vmcnt(0)":::"memory");}
      pvb(o,vb0,__builtin_bit_cast(bf16x8,pw0),__builtin_bit_cast(bf16x8,pw1),__builtin_bit_cast(bf16x8,pw2),__builtin_bit_cast(bf16x8,pw3));
      if(more){ATB_DMAV(tau+1);}
    }
    #undef ATB_DMAK
    #undef ATB_DMAV
  }
  {auto rr=__builtin_amdgcn_permlane32_swap(__float_as_uint(l_run),__float_as_uint(l_run),false,false);l_run=__uint_as_float(rr[0])+__uint_as_float(rr[1]);}
  if(hi==0)wsf[32+r32]=l_run;
  asm volatile("s_waitcnt lgkmcnt(0)":::"memory");
  float rli[16];
  #pragma unroll
  for(int r=0;r<16;++r)rli[r]=__builtin_amdgcn_rcpf(wsf[32+crow(r,hi)]);
  { bf16*stg=(bf16*)wl;
    #pragma unroll
    for(int r=0;r<16;++r){const int orow=crow(r,hi);
      #pragma unroll
      for(int d0=0;d0<2;++d0)stg[orow*64+d0*32+r32]=__float2bfloat16(o[d0][r]*rli[r]);}
    asm volatile("s_waitcnt lgkmcnt(0)":::"memory");
    bf16*Ow=O+(rowbase+T0)*OP+OCOL+j*64;
    #pragma unroll
    for(int i=0;i<4;++i){const int row=i*8+(lane>>3),ch=lane&7; const u32x4 v=*(const u32x4*)(stg+row*64+ch*8); *(u32x4*)(Ow+(long)(16*row)*OP+ch*8)=v;} }
  asm volatile("s_waitcnt lgkmcnt(0)":::"memory");
}
#undef ATB_MX3
}
namespace attn8 {
using attn_body::bf16; using attn_body::f32x16; using attn_body::u32x4; using attn_body::crow; using attn_body::glds16;
typedef int i32x4 __attribute__((ext_vector_type(4)));
typedef int i32x8 __attribute__((ext_vector_type(8)));
constexpr int SEQ=8192,QP=512,KP=128,OP=768,NW=8,QBLK=32,QB=256,KVBLK=64,NT=SEQ/KVBLK;
constexpr int SLOT=4096,NSLOT=8,LDS_K=0,LDS_V=NSLOT*SLOT,LDS_WS=2*NSLOT*SLOT,LDS_OST=LDS_WS+NW*256,LDS_BYTES=LDS_OST+NW*4096;
typedef __attribute__((address_space(3))) const char* lds_cptr;
__device__ __forceinline__ i32x8 frag2(lds_cptr a,lds_cptr b){ const i32x4 lo=*(const __attribute__((address_space(3))) i32x4*)a, hi=*(const __attribute__((address_space(3))) i32x4*)b; return __builtin_shufflevector(lo,hi,0,1,2,3,4,5,6,7); }
__device__ __forceinline__ int pk4_bf8(float a,float b,float c,float d){ int w=__builtin_amdgcn_cvt_pk_bf8_f32(a,b,0,false); return __builtin_amdgcn_cvt_pk_bf8_f32(c,d,w,true); }
__device__ __forceinline__ int pk4_e5m2(float a,float b,float c,float d){
  const unsigned h0=__builtin_bit_cast(unsigned,__builtin_amdgcn_cvt_pkrtz(a,b)), h1=__builtin_bit_cast(unsigned,__builtin_amdgcn_cvt_pkrtz(c,d));
  return (int)__builtin_amdgcn_perm(h1,h0,0x07050301u); }
template<int MODE=0,bool ZC=false> __device__ __forceinline__ void unit(int b,int h,int qb,const unsigned char*Q8,const unsigned char*K8,const unsigned char*VT8,bf16*O,char*shm,float cref){
  const int tid=threadIdx.x,lane=tid&63,r32=lane&31,hi=lane>>5; const int wid=__builtin_amdgcn_readfirstlane(tid>>6);
  const long rowbase=(long)b*SEQ; const int q0=qb*QB,kvh=h>>2;
  const unsigned lds0=(unsigned)(uintptr_t)shm;
  const unsigned char*src0; long sstep; unsigned dst0;
  if(wid<4){ const int rho=lane,key=32*(rho>>5)+16*((rho>>2)&1)+(rho&3)+4*((rho&31)>>3); src0=K8+(rowbase+key)*KP+kvh*64+wid*16; sstep=(long)KVBLK*KP; dst0=lds0+LDS_K+wid*1024; }
  else { src0=VT8+((long)(b*2+kvh)*64+lane)*SEQ+(wid-4)*16; sstep=KVBLK; dst0=lds0+LDS_V+(wid-4)*1024; }
  #define A8_DMA(t,slot) glds16(src0+(long)(t)*sstep,(unsigned)__builtin_amdgcn_readfirstlane(dst0+(slot)*SLOT))
  A8_DMA(0,0); A8_DMA(1,1); A8_DMA(2,2); A8_DMA(3,3);
  const unsigned char*qp=Q8+(rowbase+q0+wid*QBLK+r32)*QP+h*64+hi*32;
  i32x8 qr=__builtin_shufflevector(*(const i32x4*)qp,*(const i32x4*)(qp+16),0,1,2,3,4,5,6,7);
  asm volatile("":"+v"(qr));
  f32x16 negm=f32x16{}; if(!ZC){ _Pragma("unroll") for(int r=0;r<16;++r)negm[r]=-cref; }
  f32x16 o0=f32x16{},o1=f32x16{}; typedef float f32x4_ __attribute__((ext_vector_type(4))); f32x4_ ol={0.f,0.f,0.f,0.f};
  i32x8 ones; { const int w_=(((lane>>4)&1)==0)==((lane&15)<8)?0x38383838:0; _Pragma("unroll") for(int r=0;r<8;++r)ones[r]=w_; } asm volatile("":"+v"(ones));
  #define A8_ML(a,c) __builtin_amdgcn_mfma_scale_f32_16x16x128_f8f6f4(a,ones,c,1,0,0,0,0,0)
  const lds_cptr kp=(lds_cptr)shm+LDS_K+(2*hi)*1024+r32*16, vp=(lds_cptr)shm+LDS_V+hi*1024+r32*16;
  #define A8_MF(a,bq,c,fa) __builtin_amdgcn_mfma_scale_f32_32x32x64_f8f6f4(a,bq,c,fa,0,0,0,0,0)
  f32x16 pA0,pA1,pB0,pB1; i32x8 paA,paB; _Pragma("unroll") for(int r=0;r<8;++r){paA[r]=0;paB[r]=0;}
  asm volatile("s_waitcnt vmcnt(3) lgkmcnt(0)\n\ts_barrier":::"memory");
  { const i32x8 kf0=frag2(kp,kp+1024),kf1=frag2(kp+512,kp+1024+512); pA0=A8_MF(kf0,qr,negm,0); pA1=A8_MF(kf1,qr,negm,0); }
  int s_k=1,s_v=NSLOT-1,s_d=4;
  #define A8_ROT(x) x=((x)==NSLOT-1)?0:(x)+1
  #define A8_STEP(PC0,PC1,PN0,PN1,PAO,PAN,HAVE_NEXT,DO_PV) do{ \
    const lds_cptr ks_=kp+s_k*SLOT, vs_=vp+s_v*SLOT; \
    if(HAVE_NEXT){ const i32x8 kf0_=frag2(ks_,ks_+1024),kf1_=frag2(ks_+512,ks_+1024+512); if(!(MODE&4)){ PN0=A8_MF(kf0_,qr,negm,0); PN1=A8_MF(kf1_,qr,negm,0); } else { PN0=negm; PN1=negm; asm volatile(""::"v"(kf0_),"v"(kf1_)); } } \
    if(DO_PV){ const i32x8 vf0_=frag2(vs_,vs_+2048),vf1_=frag2(vs_+512,vs_+2048+512); if(!(MODE&8)){ o0=A8_MF(PAO,vf0_,o0,1); o1=A8_MF(PAO,vf1_,o1,1); ol=A8_ML(PAO,ol); } else { asm volatile(""::"v"(vf0_),"v"(vf1_),"v"(PAO)); } } \
    if(!(MODE&1)){ _Pragma("unroll") for(int r_=0;r_<16;++r_){ PC0[r_]=__builtin_amdgcn_exp2f(PC0[r_]); PC1[r_]=__builtin_amdgcn_exp2f(PC1[r_]); } } \
    if(!(MODE&2)){ PAN[0]=pk4_e5m2(PC0[0],PC0[1],PC0[2],PC0[3]); PAN[1]=pk4_e5m2(PC0[4],PC0[5],PC0[6],PC0[7]); PAN[2]=pk4_e5m2(PC0[8],PC0[9],PC0[10],PC0[11]); PAN[3]=pk4_e5m2(PC0[12],PC0[13],PC0[14],PC0[15]); \
      PAN[4]=pk4_e5m2(PC1[0],PC1[1],PC1[2],PC1[3]); PAN[5]=pk4_e5m2(PC1[4],PC1[5],PC1[6],PC1[7]); PAN[6]=pk4_e5m2(PC1[8],PC1[9],PC1[10],PC1[11]); PAN[7]=pk4_e5m2(PC1[12],PC1[13],PC1[14],PC1[15]); } else { asm volatile(""::"v"(PC0),"v"(PC1)); } \
    _Pragma("unroll") for(int g_=0;g_<5;++g_){ __builtin_amdgcn_sched_group_barrier(0x008,1,0); __builtin_amdgcn_sched_group_barrier(0x002,12,0); } \
    A8_ROT(s_k); A8_ROT(s_v); }while(0)
  #define A8_TOP(t) do{ if((t)+3<NT){ asm volatile("s_waitcnt vmcnt(1) lgkmcnt(0)\n\ts_barrier":::"memory"); } else { asm volatile("s_waitcnt vmcnt(0) lgkmcnt(0)\n\ts_barrier":::"memory"); } \
    if((t)+5<NT){ A8_DMA((t)+4,s_d); A8_DMA((t)+5,s_d+1); } s_d=(s_d==NSLOT-2)?0:s_d+2; }while(0)
  A8_TOP(0); A8_STEP(pA0,pA1,pB0,pB1,paB,paA,true,false);
             A8_STEP(pB0,pB1,pA0,pA1,paA,paB,true,true);
  #pragma unroll 1
  for(int t=2;t<NT;t+=2){
    A8_TOP(t); A8_STEP(pA0,pA1,pB0,pB1,paB,paA,true,true);
               A8_STEP(pB0,pB1,pA0,pA1,paA,paB,(t+2<NT),true);
  }
  { const lds_cptr vs_=vp+s_v*SLOT; const i32x8 vf0_=frag2(vs_,vs_+2048),vf1_=frag2(vs_+512,vs_+2048+512); if(!(MODE&8)){ o0=A8_MF(paB,vf0_,o0,1); o1=A8_MF(paB,vf1_,o1,1); ol=A8_ML(paB,ol); } }
  #undef A8_DMA
  #undef A8_MF
  #undef A8_ML
  #undef A8_ROT
  #undef A8_STEP
  #undef A8_TOP
  float rli[16];
  { float*wsf=(float*)(shm+LDS_WS)+wid*64; const int j_=lane&15,g_=lane>>4;
    if((j_&7)==0){ float*d_=wsf+2*j_+4*g_; d_[0]=ol[0]; d_[1]=ol[1]; d_[2]=ol[2]; d_[3]=ol[3]; }
    asm volatile("s_waitcnt lgkmcnt(0)":::"memory");
    #pragma unroll
    for(int r=0;r<16;++r)rli[r]=__builtin_amdgcn_rcpf(wsf[crow(r,hi)]); }
  bf16*Ow=O+(rowbase+q0+wid*QBLK)*OP+h*64;
  { bf16*stg=(bf16*)(shm+LDS_OST)+wid*2048;
    #pragma unroll
    for(int r=0;r<16;++r){const int orow=crow(r,hi); stg[orow*64+r32]=__float2bfloat16(o0[r]*rli[r]); stg[orow*64+32+r32]=__float2bfloat16(o1[r]*rli[r]);}
    asm volatile("s_waitcnt lgkmcnt(0)":::"memory");
    #pragma unroll
    for(int i=0;i<4;++i){const int row=i*8+(lane>>3),ch=lane&7; const u32x4 v=*(const u32x4*)(stg+row*64+ch*8); *(u32x4*)(Ow+(long)row*OP+ch*8)=v;} }
  asm volatile("s_waitcnt lgkmcnt(0)\n\ts_barrier":::"memory");
}
constexpr int ATTN8_LDS_BYTES=LDS_BYTES;
}
namespace attnb2 {
using attn_body::bf16; using attn_body::bf16x8; using attn_body::s16x4; using attn_body::f32x16; using attn_body::u32x4;
using attn_body::crow; using attn_body::glds16; using attn_body::cvtpk_s; using attnb::pvb;
constexpr int SEQ = 8192, PB = 768, OP = 768, OCOL = 512;
#define AB2_MX3(a,b,c) __builtin_fmaxf(__builtin_fmaxf((a),(b)),(c))
__device__ __forceinline__ void pvb2(f32x16*o,int vb,bf16x8 pa0,bf16x8 pa1,bf16x8 pa2,bf16x8 pa3){
  #pragma unroll
  for(int d0=0;d0<2;++d0){s16x4 lo[4],hi[4];
    #pragma unroll
    for(int ks=0;ks<4;++ks){
      asm volatile("ds_read_b64_tr_b16 %0,%1 offset:%c2":"=&v"(lo[ks]):"v"(vb),"i"(d0*64+ks*2048):"memory");
      asm volatile("ds_read_b64_tr_b16 %0,%1 offset:%c2":"=&v"(hi[ks]):"v"(vb),"i"(d0*64+ks*2048+1024):"memory");}
    asm volatile("s_waitcnt lgkmcnt(0)":::"memory");__builtin_amdgcn_sched_barrier(0);
    #define AB2_PK(k) (bf16x8){lo[k][0],lo[k][1],lo[k][2],lo[k][3],hi[k][0],hi[k][1],hi[k][2],hi[k][3]}
    o[d0]=__builtin_amdgcn_mfma_f32_32x32x16_bf16(pa0,AB2_PK(0),o[d0],0,0,0);
    o[d0]=__builtin_amdgcn_mfma_f32_32x32x16_bf16(pa1,AB2_PK(1),o[d0],0,0,0);
    o[d0]=__builtin_amdgcn_mfma_f32_32x32x16_bf16(pa2,AB2_PK(2),o[d0],0,0,0);
    o[d0]=__builtin_amdgcn_mfma_f32_32x32x16_bf16(pa3,AB2_PK(3),o[d0],0,0,0);
    #undef AB2_PK
  }
}
__device__ __forceinline__ void gload16(bf16x8&dst,const void*p){asm volatile("global_load_dwordx4 %0, %1, off":"=v"(dst):"v"(p):"memory");}
#define AB2_PIN8(N,kf) asm volatile("s_waitcnt vmcnt(" #N ")":"+v"(kf[0]),"+v"(kf[1]),"+v"(kf[2]),"+v"(kf[3]),"+v"(kf[4]),"+v"(kf[5]),"+v"(kf[6]),"+v"(kf[7])::"memory")
#define AB2_WAITV(N) asm volatile("s_waitcnt vmcnt(" #N ")":::"memory")
template<int BM=0> __device__ __forceinline__ void b2_tile(int lane_in,int b,int j,int g,int k,int c,const bf16*Qb,const bf16*__restrict__ Kb,const bf16*__restrict__ Vb,bf16*O,float*LSE,char*wl,float*wsf){
  int lane=lane_in; asm volatile("":"+v"(lane));
  const int r32=lane&31,hi=lane>>5;
  const int sh=2*g,d=1<<sh,Lg=SEQ>>sh,hq=g*4+j;
  int rc,sfirst; if(g==2){rc=k;sfirst=32*c;} else if(g==1){rc=k&3;sfirst=128*c+32*(k>>2);} else {rc=0;sfirst=512*c+32*k;}
  const float slope2=exp2f(-8.0f*(float)(hq+1)/12.0f)*(float)d*1.4426950408889634f;
  const long rowbase=(long)b*SEQ+rc;
  const int sq=sfirst+r32; const float lo_f=(float)max(-64,-sq),hi_f=(float)min(64,Lg-1-sq);
  const unsigned slot0=(unsigned)__builtin_amdgcn_readfirstlane((int)(unsigned)(uintptr_t)wl),slot1=slot0+8192u;
  const int vb0=(int)slot0+((lane>>4)&1)*32+(lane&3)*8+(4*hi+((lane&15)>>2))*128,vb1=vb0+8192;
  const bool mrg=(g!=2);
  bf16x8 qr[4],kfA[8];
  { const bf16*Qp=Qb+(rowbase+(long)d*sq)*PB+hq*64+hi*8;
    #pragma unroll
    for(int d0=0;d0<4;++d0)gload16(qr[d0],Qp+d0*16); }
  #define AB2_KLOAD(kf,tau) do{ const bf16*k0_=Kb+(rowbase+(long)d*min(max(sfirst-64+64*(tau)+r32,0),Lg-1))*PB+hq*64+hi*8; const bf16*k1_=Kb+(rowbase+(long)d*min(max(sfirst-32+64*(tau)+r32,0),Lg-1))*PB+hq*64+hi*8; \
      if(!(BM&2)){ _Pragma("unroll") for(int d0=0;d0<4;++d0){ gload16(kf[2*d0],k0_+16*d0); gload16(kf[2*d0+1],k1_+16*d0);} } else { _Pragma("unroll") for(int i_=0;i_<8;++i_){ asm volatile("s_nop 0":"=v"(kf[i_])); } } }while(0)
  #define AB2_VDMA(tau,slot) do{ _Pragma("unroll") for(int i_=0;i_<8;++i_){ const int s_=min(max(sfirst-64+64*(tau)+8*i_+(lane>>3),0),Lg-1); const bf16*src_=Vb+(rowbase+(long)d*s_)*PB+hq*64+(lane&7)*8; \
      if(!(BM&4)) glds16(src_,(slot)+i_*1024u);} }while(0)
  AB2_KLOAD(kfA,1); AB2_VDMA(1,slot0); AB2_VDMA(0,slot1);
  float m_run=0.f,l_run=0.f; f32x16 o[2]; o[0]=f32x16{}; o[1]=f32x16{};
  u32x4 pw0,pw1,pw2,pw3; f32x16 p0,p1;
  #define AB2_QK(kf) do{ p0=f32x16{}; p1=f32x16{}; _Pragma("unroll") for(int d0=0;d0<4;++d0){ p0=__builtin_amdgcn_mfma_f32_32x32x16_bf16(kf[2*d0],qr[d0],p0,0,0,0); p1=__builtin_amdgcn_mfma_f32_32x32x16_bf16(kf[2*d0+1],qr[d0],p1,0,0,0); } }while(0)
  #define AB2_SOFTMAX(tau,FIRST) do{ if(BM&1){ m_run=0.f; l_run=1.f; } else { float basef=(float)(64*(tau)-64-r32+4*hi); asm volatile("":"+v"(basef));     \
      _Pragma("unroll") for(int r=0;r<16;++r){ const float c0=basef+(float)((r&3)+8*(r>>2)),c1=c0+32.0f; \
        p0[r]=(c0>=lo_f&&c0<=hi_f)?__builtin_fmaf(-slope2,__builtin_fabsf(c0),p0[r]):-INFINITY; p1[r]=(c1>=lo_f&&c1<=hi_f)?__builtin_fmaf(-slope2,__builtin_fabsf(c1),p1[r]):-INFINITY; } \
      float rm; { float a=AB2_MX3(p0[0],p0[1],p1[0]),bb=AB2_MX3(p0[2],p0[3],p1[1]); a=AB2_MX3(a,p1[2],p1[3]); \
        _Pragma("unroll") for(int r=4;r<16;r+=4){a=AB2_MX3(a,p0[r],p0[r+1]);bb=AB2_MX3(bb,p0[r+2],p0[r+3]);a=AB2_MX3(a,p1[r],p1[r+1]);bb=AB2_MX3(bb,p1[r+2],p1[r+3]);} \
        rm=__builtin_fmaxf(a,bb); auto rr=__builtin_amdgcn_permlane32_swap(__float_as_uint(rm),__float_as_uint(rm),false,false); rm=__builtin_fmaxf(__uint_as_float(rr[0]),__uint_as_float(rr[1])); } \
      const float m_new=(FIRST)?rm:__builtin_fmaxf(m_run,rm); float sum=0.f; \
      _Pragma("unroll") for(int r=0;r<16;++r){ p0[r]=__builtin_amdgcn_exp2f(p0[r]-m_new); p1[r]=__builtin_amdgcn_exp2f(p1[r]-m_new); sum+=p0[r]+p1[r]; } \
      if(FIRST){ l_run=sum; } else { const float alpha=__builtin_amdgcn_exp2f(m_run-m_new); l_run=l_run*alpha+sum; \
        if(!__all(m_new==m_run)){ if(hi==0)wsf[r32]=alpha; asm volatile("s_waitcnt lgkmcnt(0)":::"memory");     \
        _Pragma("unroll") for(int r=0;r<16;++r){ const float f=wsf[crow(r,hi)]; o[0][r]*=f; o[1][r]*=f; } } } \
      m_run=m_new; \
      } \
      pw0=(u32x4){cvtpk_s(p0[0],p0[1]),cvtpk_s(p0[2],p0[3]),cvtpk_s(p0[4],p0[5]),cvtpk_s(p0[6],p0[7])}; pw1=(u32x4){cvtpk_s(p0[8],p0[9]),cvtpk_s(p0[10],p0[11]),cvtpk_s(p0[12],p0[13]),cvtpk_s(p0[14],p0[15])}; \
      pw2=(u32x4){cvtpk_s(p1[0],p1[1]),cvtpk_s(p1[2],p1[3]),cvtpk_s(p1[4],p1[5]),cvtpk_s(p1[6],p1[7])}; pw3=(u32x4){cvtpk_s(p1[8],p1[9]),cvtpk_s(p1[10],p1[11]),cvtpk_s(p1[12],p1[13]),cvtpk_s(p1[14],p1[15])}; }while(0)
  #define AB2_PV(vb) if(!(BM&4)) pvb2(o,vb,__builtin_bit_cast(bf16x8,pw0),__builtin_bit_cast(bf16x8,pw1),__builtin_bit_cast(bf16x8,pw2),__builtin_bit_cast(bf16x8,pw3))
  asm volatile("s_waitcnt vmcnt(16)":"+v"(qr[0]),"+v"(qr[1]),"+v"(qr[2]),"+v"(qr[3])::"memory");
  AB2_PIN8(16,kfA);
  AB2_QK(kfA);
  asm volatile("s_nop 7":"+v"(p0),"+v"(p1));
  AB2_KLOAD(kfA,0);
  AB2_SOFTMAX(1,true);
  AB2_WAITV(16); AB2_PV(vb0);
  AB2_VDMA(2,slot0);
  AB2_PIN8(8,kfA);
  AB2_QK(kfA);
  asm volatile("s_nop 7":"+v"(p0),"+v"(p1));
  AB2_KLOAD(kfA,2);
  AB2_SOFTMAX(0,false);
  AB2_PV(vb1);
  const long rowO=(long)b*SEQ+rc+(long)d*sfirst;
  int lse_old_bits=0;
  {
    #pragma unroll
    for(int i=0;i<4;++i){ const bf16*src_=O+(rowO+(long)d*(i*8+(lane>>3)))*OP+OCOL+j*64+(lane&7)*8; glds16(src_,slot1+i*1024u); }
    const float*lp=LSE+(rowO+(long)d*r32)*4+j; asm volatile("global_load_dword %0, %1, off":"=v"(lse_old_bits):"v"(lp):"memory"); }
  AB2_PIN8(5,kfA);
  AB2_QK(kfA); AB2_SOFTMAX(2,false);
  AB2_PV(vb0);
  {auto rr=__builtin_amdgcn_permlane32_swap(__float_as_uint(l_run),__float_as_uint(l_run),false,false);l_run=__uint_as_float(rr[0])+__uint_as_float(rr[1]);}
  const float lse_g=m_run+__builtin_amdgcn_logf(l_run);
  float w_old=0.f,w_new=__builtin_amdgcn_rcpf(l_run),lse_new=lse_g;
  asm volatile("s_waitcnt vmcnt(0)":"+v"(lse_old_bits)::"memory");
  if(mrg){ const float lse_old=__int_as_float(lse_old_bits);
    const float mx=__builtin_fmaxf(lse_old,lse_g); const float eo=__builtin_amdgcn_exp2f(lse_old-mx),eg=__builtin_amdgcn_exp2f(lse_g-mx); const float inv=__builtin_amdgcn_rcpf(eo+eg);
    lse_new=mx+__builtin_amdgcn_logf(eo+eg); w_old=eo*inv; w_new=eg*inv*__builtin_amdgcn_rcpf(l_run); }
  if(hi==0){wsf[r32]=w_old;wsf[32+r32]=w_new;}
  asm volatile("s_waitcnt lgkmcnt(0)":::"memory");
  { const unsigned short*oldp=(const unsigned short*)(wl+8192); bf16*stg=(bf16*)wl;
    #pragma unroll
    for(int r=0;r<16;++r){ const int orow=crow(r,hi); const float fo=wsf[orow],fn=wsf[32+orow];
      #pragma unroll
      for(int d0=0;d0<2;++d0){ float v=o[d0][r]*fn; if(mrg)v=__builtin_fmaf(__uint_as_float((unsigned)oldp[orow*64+d0*32+r32]<<16),fo,v); stg[orow*64+d0*32+r32]=__float2bfloat16(v); } }
    asm volatile("s_waitcnt lgkmcnt(0)":::"memory");
    #pragma unroll
    for(int i=0;i<4;++i){const int row=i*8+(lane>>3),ch=lane&7; const u32x4 v=*(const u32x4*)(stg+row*64+ch*8); *(u32x4*)(O+(rowO+(long)d*row)*OP+OCOL+j*64+ch*8)=v;}
    if(g!=0&&hi==0)LSE[(rowO+(long)d*r32)*4+j]=lse_new; }
  asm volatile("s_waitcnt lgkmcnt(0)":::"memory");
  #undef AB2_KLOAD
  #undef AB2_VDMA
  #undef AB2_QK
  #undef AB2_SOFTMAX
  #undef AB2_PV
}
template<int BM=0> __device__ __forceinline__ void b2_unit(int lane,int b,int j,int c,int wave,const bf16*Qb,const bf16*Kb,const bf16*Vb,bf16*O,float*LSE,char*wl,float*wsf){
  #pragma unroll 1
  for(int g=2;g>=0;--g){
    #pragma unroll 1
    for(int kk=0;kk<2;++kk)b2_tile<BM>(lane,b,j,g,2*wave+kk,c,Qb,Kb,Vb,O,LSE,wl,wsf);
    asm volatile("s_waitcnt vmcnt(0)":::"memory");
    __syncthreads();
  }
}
#undef AB2_MX3
#undef AB2_PIN8
#undef AB2_WAITV
}
#ifndef ATTN_FP8
#define ATTN_FP8 1
#endif
#ifndef GEMM1_WGM
#define GEMM1_WGM 8
#endif
#ifndef GEMM1_FP8
#define GEMM1_FP8 1
#endif
constexpr int NWAVES = 8;
#ifndef MK_N_LAUNCHES
#define MK_N_LAUNCHES 1
#endif
constexpr int N_PHASES = 12;
constexpr int N_LAUNCHES = MK_N_LAUNCHES;

constexpr int BATCH = 8, SEQ = 8192, DM = 1024, M = BATCH * SEQ;
constexpr int N_IN = 5120, NE = 16, FF = 1024, CAP = 1024, MR = BATCH * NE * CAP;
constexpr float NORM_EPS = 1e-6f;

constexpr size_t MiB = 1u << 20;
constexpr size_t WS_CTL = 0, CTL_ZERO_BYTES = 1 * MiB;
constexpr size_t WS_AFF = 1 * MiB;
constexpr size_t WS_TOPI = 5 * MiB, WS_TOPG = WS_TOPI + 512 * 1024;
constexpr size_t WS_TSLOT = 6 * MiB;
constexpr size_t WS_WIN = 10 * MiB;
constexpr size_t WS_WO = 20 * MiB;
constexpr size_t WS_WOUT = 22 * MiB;
constexpr size_t WS_WGU = 24 * MiB;
constexpr size_t WS_WD = 88 * MiB;
constexpr size_t WS_XN = 120 * MiB;
constexpr size_t WS_QA = 248 * MiB, WS_KVA = 312 * MiB, WS_QB = 344 * MiB, WS_KB = 440 * MiB, WS_VB = 536 * MiB, WS_G = 632 * MiB;
constexpr size_t WS_Q8 = WS_XN, WS_K8 = WS_XN + 32 * MiB, WS_VT8 = WS_XN + 40 * MiB;
constexpr size_t WS_OAB = 888 * MiB;
constexpr size_t WS_XB = 440 * MiB;
constexpr size_t WS_XG = 248 * MiB, WS_ACT = 632 * MiB, WS_Y = 760 * MiB;
constexpr size_t WS_END = 1016 * MiB;
static_assert(WS_WD + 32 * MiB <= WS_XN && WS_XN + 128 * MiB <= WS_QA && WS_G + 256 * MiB <= WS_OAB && WS_OAB + 96 * MiB <= WS_END && WS_Y + 256 * MiB <= WS_END, "d_ws map");
constexpr int CW_BAR = 4096;

constexpr int RING_OFF = 0, RING_BYTES = 131072;
constexpr int WSF_OFF = RING_BYTES;
constexpr int LDSCTL_OFF = RING_BYTES + 2048, MISC_OFF = LDSCTL_OFF + 320;
constexpr int LDS_BYTES = 147456;
static_assert(MISC_OFF + 128 <= LDS_BYTES, "LDS map");

#define GAS __attribute__((address_space(1)))
#define LAS __attribute__((address_space(3)))
typedef unsigned short bf16;
typedef unsigned v4u __attribute__((ext_vector_type(4)));
typedef float f32x4 __attribute__((ext_vector_type(4)));
typedef short bf16x8 __attribute__((ext_vector_type(8)));
typedef GAS unsigned gu32;
typedef GAS unsigned long long gu64;
#define RLX_AGENT __ATOMIC_RELAXED, __HIP_MEMORY_SCOPE_AGENT
#define LDS_WAIT() asm volatile("s_waitcnt lgkmcnt(0)" ::: "memory")
#define VM_WAIT() asm volatile("s_waitcnt vmcnt(0)" ::: "memory")
__device__ __forceinline__ unsigned long long rt() { return __builtin_amdgcn_s_memrealtime(); }
__device__ __forceinline__ unsigned f2bf(float f) { unsigned u = __builtin_bit_cast(unsigned, f); return (u + 0x7fffu + ((u >> 16) & 1u)) >> 16; }
__device__ __forceinline__ unsigned pk2(float lo, float hi) { return f2bf(lo) | (f2bf(hi) << 16); }

#define XB_TMO      128
#define XB_XCNT(j)  (256  + 64 * (j))
#define XB_XSUB(j)  (1280 + 64 * (j))
#define XB_XGEN(j)  (2304 + 64 * (j))
#define XB_TOP      3328
#define XB_TOPGEN   3392
#define XCD_BAR_WORDS 3456
#define XB_SPIN_CAP (1u << 18)

__device__ __forceinline__ unsigned xb_ld(unsigned* p)              { return __hip_atomic_load(p, __ATOMIC_RELAXED, __HIP_MEMORY_SCOPE_AGENT); }
__device__ __forceinline__ unsigned xb_add(unsigned* p, unsigned v) { return __hip_atomic_fetch_add(p, v, __ATOMIC_RELAXED, __HIP_MEMORY_SCOPE_AGENT); }
__device__ __forceinline__ unsigned xb_xcc_id() { return (unsigned)__builtin_amdgcn_s_getreg((3 << 11) | 20) & 0xFu; }
#define XB_SPIN(cond, bar) do { unsigned _sp = 0; while (cond) { __builtin_amdgcn_s_sleep(1); \
    if ((++_sp & 255u) == 0u) { if (xb_ld(&(bar)[XB_TMO])) break; if (_sp > XB_SPIN_CAP) { atomicAdd(&(bar)[XB_TMO], 1u); break; } } } } while (0)

struct XcdBarrier {
    unsigned* bar; unsigned x;
    volatile LAS unsigned* st;
};

__device__ __forceinline__ XcdBarrier xcd_barrier_post(unsigned* bar, volatile LAS unsigned* st) {
    XcdBarrier b; b.bar = bar; b.x = xb_xcc_id(); b.st = st;
    if (threadIdx.x == 0) (void)xb_add(&bar[XB_XCNT(b.x)], 1u);
    return b;
}
__device__ __forceinline__ void xcd_barrier_complete(unsigned* bar, unsigned x, unsigned& nloc, unsigned& nx) {
    const unsigned G = gridDim.x * gridDim.y * gridDim.z;
    unsigned sum, cnt, mine, sp = 0u;
    for (;;) {
        sum = 0u; cnt = 0u; mine = 0u;
#pragma unroll
        for (unsigned j = 0; j < 16; ++j) { const unsigned c = xb_ld(&bar[XB_XCNT(j)]); sum += c; cnt += (c > 0u) ? 1u : 0u; mine = (j == x) ? c : mine; }
        if (sum == G) break;
        __builtin_amdgcn_s_sleep(1);
        if ((++sp & 255u) == 0u) { if (xb_ld(&bar[XB_TMO])) break; if (sp > XB_SPIN_CAP) { atomicAdd(&bar[XB_TMO], 1u); break; } }
    }
    nloc = mine > 0u ? mine : 1u; nx = cnt > 0u ? cnt : 1u;
}

__device__ __forceinline__ void xcd_barrier(const XcdBarrier& b) {
    asm volatile("s_waitcnt vmcnt(0)" ::: "memory");
    __syncthreads();
    if (threadIdx.x == 0) {
        unsigned* bar = b.bar;
        __builtin_amdgcn_s_waitcnt(0);
        unsigned nloc = b.st[0], nx = b.st[1];
        if (nloc == 0u) { xcd_barrier_complete(bar, b.x, nloc, nx); b.st[0] = nloc; b.st[1] = nx; }
        const unsigned old = xb_add(&bar[XB_XSUB(b.x)], 1u);
        const unsigned gen = old / nloc;
        if (old + 1u == (gen + 1u) * nloc) {
            __builtin_amdgcn_fence(__ATOMIC_RELEASE, "agent");
            asm volatile("s_waitcnt vmcnt(0)" ::: "memory");
            const unsigned og = xb_add(&bar[XB_TOP], 1u);
            const unsigned tg = og / nx;
            if (og + 1u == (tg + 1u) * nx) xb_add(&bar[XB_TOPGEN], 1u);
            else XB_SPIN(xb_ld(&bar[XB_TOPGEN]) == tg, bar);
            __builtin_amdgcn_fence(__ATOMIC_ACQUIRE, "agent");
            xb_add(&bar[XB_XGEN(b.x)], 1u);
            asm volatile("s_waitcnt vmcnt(0)" ::: "memory");
        } else {
            XB_SPIN(xb_ld(&bar[XB_XGEN(b.x)]) == gen, bar);
            __builtin_amdgcn_fence(__ATOMIC_ACQUIRE, "agent");
            asm volatile("s_waitcnt vmcnt(0)" ::: "memory");
        }
    }
    __syncthreads();
}

struct Frame {
    LAS unsigned char* lds;
    volatile LAS unsigned* MISC;
    gu32* ctl;
    int tid, lane, wave;
    int vcu, G;
    float* out; unsigned char* ws;
};
enum InIdx { IN_X = 0, IN_NORM1_G, IN_W_IN, IN_B_GATES, IN_Q_NORM_G, IN_K_NORM_G, IN_W_O_A, IN_W_O_B, IN_W_OUT, IN_NORM2_G, IN_W_ROUTER, IN_W_GATE, IN_W_UP, IN_W_DOWN, IN_NORMF_G };
__device__ __forceinline__ const float* inptr(const Frame& F, int k) {
    volatile LAS unsigned* pt = (volatile LAS unsigned*)(F.lds + LDSCTL_OFF + 64);
    const unsigned lo = pt[2 * k], hi = pt[2 * k + 1];
    const GAS float* gp = (const GAS float*)(((unsigned long long)(unsigned)__builtin_amdgcn_readfirstlane((int)hi) << 32) | (unsigned)__builtin_amdgcn_readfirstlane((int)lo));
    return (const float*)gp;
}

__device__ __forceinline__ float wave_sum(float v) {
#pragma unroll
    for (int o = 1; o < 64; o <<= 1) v += __shfl_xor(v, o);
    return v;
}
__device__ __forceinline__ void p0_transpose_item(const float* W, int N, bf16* WT, int ldk, int drow0, int dcol0, LAS float* scr, int kb, int nb, int lane) {
    const int k0 = 64 * kb, n0 = 32 * nb;
#pragma unroll 8
    for (int i = 0; i < 32; ++i) { const int kk = 2 * i + (lane >> 5); scr[kk * 33 + (lane & 31)] = W[(size_t)(k0 + kk) * N + n0 + (lane & 31)]; }
    LDS_WAIT(); asm volatile("" ::: "memory");
    const int c = lane & 7;
#pragma unroll
    for (int j = 0; j < 4; ++j) { const int n = (lane >> 3) + 8 * j; const LAS float* s = scr + (8 * c) * 33 + n;
        v4u o; o.x = pk2(s[0 * 33], s[1 * 33]); o.y = pk2(s[2 * 33], s[3 * 33]); o.z = pk2(s[4 * 33], s[5 * 33]); o.w = pk2(s[6 * 33], s[7 * 33]);
        *(GAS v4u*)(WT + (size_t)(drow0 + n) * ldk + dcol0 + k0 + 8 * c) = o; }
    LDS_WAIT(); asm volatile("" ::: "memory");
}
__device__ __forceinline__ void p0_transpose_item_f8(const float* W, int N, unsigned char* WT, int ldk, int drow0, float wscale, LAS float* scr, int kb, int nb, int lane) {
    const int k0 = 64 * kb, n0 = 32 * nb;
#pragma unroll 8
    for (int i = 0; i < 32; ++i) { const int kk = 2 * i + (lane >> 5); scr[kk * 33 + (lane & 31)] = W[(size_t)(k0 + kk) * N + n0 + (lane & 31)]; }
    LDS_WAIT(); asm volatile("" ::: "memory");
    const int c = lane & 7;
#pragma unroll
    for (int j = 0; j < 4; ++j) { const int n = (lane >> 3) + 8 * j; const LAS float* s = scr + (8 * c) * 33 + n;
        const unsigned lo = pg8::pk4_fp8(s[0 * 33] * wscale, s[1 * 33] * wscale, s[2 * 33] * wscale, s[3 * 33] * wscale), hi = pg8::pk4_fp8(s[4 * 33] * wscale, s[5 * 33] * wscale, s[6 * 33] * wscale, s[7 * 33] * wscale);
        *(GAS unsigned long long*)(WT + (size_t)(drow0 + n) * ldk + k0 + 8 * c) = (unsigned long long)lo | ((unsigned long long)hi << 32); }
    LDS_WAIT(); asm volatile("" ::: "memory");
}
__device__ __forceinline__ void p0_prologue(Frame& F) {
    LAS float* scr = (LAS float*)(F.lds + RING_OFF + F.wave * 16384);
    const int gw = F.vcu * NWAVES + F.wave, NGW = F.G * NWAVES;
    bf16* WIN = (bf16*)(F.ws + WS_WIN); bf16* WO = (bf16*)(F.ws + WS_WO); bf16* WOUT = (bf16*)(F.ws + WS_WOUT); unsigned char* WGU = F.ws + WS_WGU; unsigned char* WD = F.ws + WS_WD;
    const float* w_in = inptr(F, IN_W_IN); const float* w_o_a = inptr(F, IN_W_O_A); const float* w_o_b = inptr(F, IN_W_O_B); const float* w_out = inptr(F, IN_W_OUT);
    const float* w_gate = inptr(F, IN_W_GATE); const float* w_up = inptr(F, IN_W_UP); const float* w_down = inptr(F, IN_W_DOWN);
    constexpr int I_IN = 16 * 160, I_OA = 8 * 32, I_OB = 4 * 32, I_OUT = 16 * 32, I_E = 16 * 32, NITEMS = I_IN + I_OA + I_OB + I_OUT + 3 * 16 * I_E;
    for (int it = gw; it < NITEMS; it += NGW) {
        int r = it;
#if GEMM1_FP8
        if (r < I_IN) { const int n0 = 32 * (r % 160);
            const int dr = n0 < 3072 ? n0 : (n0 < 4096 ? 3072 + ((n0 - 3072) >> 7) * 256 + ((n0 - 3072) & 127) : 3072 + ((n0 - 4096) >> 7) * 256 + 128 + ((n0 - 4096) & 127));
            p0_transpose_item_f8(w_in, N_IN, (unsigned char*)WIN, 1024, dr, pg8::F8_W_SCALE, scr, r / 160, r % 160, F.lane); continue; } r -= I_IN;
#else
        if (r < I_IN) { p0_transpose_item(w_in, N_IN, WIN, 1024, 32 * (r % 160), 0, scr, r / 160, r % 160, F.lane); continue; } r -= I_IN;
#endif
        if (r < I_OA) { p0_transpose_item(w_o_a, DM, WO, 768, 32 * (r % 32), 0, scr, r / 32, r % 32, F.lane); continue; } r -= I_OA;
        if (r < I_OB) { p0_transpose_item(w_o_b, DM, WO, 768, 32 * (r % 32), 512, scr, r / 32, r % 32, F.lane); continue; } r -= I_OB;
        if (r < I_OUT) { p0_transpose_item(w_out, DM, WOUT, 1024, 32 * (r % 32), 0, scr, r / 32, r % 32, F.lane); continue; } r -= I_OUT;
        const int which = r / (16 * I_E); r -= which * 16 * I_E; const int e = r / I_E, rr = r % I_E, kb = rr / 32, nb = rr % 32, n0 = 32 * nb;
        if (which == 0) p0_transpose_item_f8(w_gate + (size_t)e * DM * FF, FF, WGU + (size_t)e * 2048 * 1024, 1024, (n0 >> 7) * 256 + (n0 & 127), pg8::F8_W_SCALE, scr, kb, nb, F.lane);
        else if (which == 1) p0_transpose_item_f8(w_up + (size_t)e * DM * FF, FF, WGU + (size_t)e * 2048 * 1024, 1024, (n0 >> 7) * 256 + 128 + (n0 & 127), pg8::F8_W_SCALE, scr, kb, nb, F.lane);
        else p0_transpose_item_f8(w_down + (size_t)e * FF * DM, DM, WD + (size_t)e * 1024 * 1024, 1024, n0, pg8::F8_W_SCALE, scr, kb, nb, F.lane);
    }
    bf16* XN = (bf16*)(F.ws + WS_XN); const float* xin = inptr(F, IN_X); const float* norm1_g = inptr(F, IN_NORM1_G);
    f32x4 gg[4];
#pragma unroll
    for (int j = 0; j < 4; ++j) gg[j] = ((const GAS f32x4*)norm1_g)[F.lane + 64 * j];
    for (int m = gw; m < M; m += NGW) {
        const GAS f32x4* xr = (const GAS f32x4*)(xin + (size_t)m * DM) + F.lane;
        f32x4 v[4]; float s2 = 0.f;
#pragma unroll
        for (int j = 0; j < 4; ++j) { v[j] = xr[64 * j]; s2 += (v[j].x * v[j].x + v[j].y * v[j].y) + (v[j].z * v[j].z + v[j].w * v[j].w); }
        const float rs = 1.0f / sqrtf(wave_sum(s2) * (1.f / DM) + NORM_EPS);
        GAS unsigned long long* o8 = (GAS unsigned long long*)(XN + (size_t)m * DM) + F.lane;
#pragma unroll
#if GEMM1_FP8
        for (int j = 0; j < 4; ++j) { const f32x4 y = v[j] * (rs * pg8::F8_ACT_SCALE) * gg[j]; ((GAS unsigned*)((unsigned char*)XN + (size_t)m * DM) + F.lane)[64 * j] = pg8::pk4_fp8(y.x, y.y, y.z, y.w); }
#else
        for (int j = 0; j < 4; ++j) { const f32x4 y = v[j] * rs * gg[j]; o8[64 * j] = (unsigned long long)pk2(y.x, y.y) | ((unsigned long long)pk2(y.z, y.w) << 32); }
#endif
    }
}
__device__ __forceinline__ void p2_qknorm_rope(Frame& F) {
    const int gw = F.vcu * NWAVES + F.wave, NGW = F.G * NWAVES, lane = F.lane, s = lane & 7;
    bf16* QA = (bf16*)(F.ws + WS_QA); bf16* KVA = (bf16*)(F.ws + WS_KVA); unsigned char* Q8 = F.ws + WS_Q8; unsigned char* K8 = F.ws + WS_K8; unsigned char* VT8 = F.ws + WS_VT8;
    const float* q_norm_g = inptr(F, IN_Q_NORM_G); const float* k_norm_g = inptr(F, IN_K_NORM_G);
    float qg[8], kg[8], invf[8];
#pragma unroll
    for (int i = 0; i < 8; ++i) { qg[i] = q_norm_g[s * 8 + i]; kg[i] = k_norm_g[s * 8 + i]; invf[i] = exp2f(-(float)((s & 1) * 8 + i) * 0.8304820237218406f) * 0.15915494309189535f; }
    const bool first = (s & 2) == 0;
    for (int m = gw; m < M; m += NGW) {
        const int t = m & (SEQ - 1); const float pos = (float)((s < 4) ? (t >> 6) : (t & 63));
        float cs[8], sn[8];
#pragma unroll
        for (int i = 0; i < 8; ++i) { float rev = pos * invf[i]; rev -= rintf(rev); cs[i] = __builtin_amdgcn_cosf(rev); sn[i] = __builtin_amdgcn_sinf(rev); if (first) sn[i] = -sn[i]; }
#pragma unroll
        for (int pass = 0; pass < 2; ++pass) {
            const bool act = (pass == 0) || (lane < 16);
            GAS v4u* p = pass == 0 ? (GAS v4u*)(QA + (size_t)m * 512) + lane : (GAS v4u*)(KVA + (size_t)m * 256) + (lane & 15);
            v4u w = (v4u){0u, 0u, 0u, 0u}; if (act) w = *p;
            float v[8] = {__uint_as_float(w.x << 16), __uint_as_float(w.x & 0xffff0000u), __uint_as_float(w.y << 16), __uint_as_float(w.y & 0xffff0000u),
                          __uint_as_float(w.z << 16), __uint_as_float(w.z & 0xffff0000u), __uint_as_float(w.w << 16), __uint_as_float(w.w & 0xffff0000u)};
            float ss = 0.f;
#pragma unroll
            for (int i = 0; i < 8; ++i) ss += v[i] * v[i];
            ss += __shfl_xor(ss, 1); ss += __shfl_xor(ss, 2); ss += __shfl_xor(ss, 4);
            const float rs = (1.0f / sqrtf(ss * (1.f / 64.f) + NORM_EPS)) * (pass == 0 ? pg8::QSCALE : 1.0f);
            float o[8];
#pragma unroll
            for (int i = 0; i < 8; ++i) { const float y = v[i] * rs * (pass == 0 ? qg[i] : kg[i]); const float pr = __shfl_xor(y, 2); o[i] = y * cs[i] + pr * sn[i]; }
            const unsigned long long w8 = (unsigned long long)pg8::pk4_fp8(o[0], o[1], o[2], o[3]) | ((unsigned long long)pg8::pk4_fp8(o[4], o[5], o[6], o[7]) << 32);
            if (act) { if (pass == 0) *((GAS unsigned long long*)(Q8 + (size_t)m * 512) + lane) = w8; else *((GAS unsigned long long*)(K8 + (size_t)m * 128) + (lane & 15)) = w8; }
        }
    }
    LAS unsigned char* tb = F.lds + RING_OFF + F.wave * 16384;
    for (int T = gw; T < BATCH * 2 * (SEQ / 64); T += NGW) {
        const int b = T >> 8, kvh = (T >> 7) & 1, t0 = (T & 127) * 64;
        const GAS v4u* src = (const GAS v4u*)(KVA + ((size_t)b * SEQ + t0 + lane) * 256 + 128 + kvh * 64);
        v4u rv[8];
#pragma unroll
        for (int i = 0; i < 8; ++i) rv[i] = src[i];
#pragma unroll
        for (int i = 0; i < 8; ++i) {
            const unsigned lo = pg8::pk4_fp8(__uint_as_float(rv[i].x << 16), __uint_as_float(rv[i].x & 0xffff0000u), __uint_as_float(rv[i].y << 16), __uint_as_float(rv[i].y & 0xffff0000u));
            const unsigned hi = pg8::pk4_fp8(__uint_as_float(rv[i].z << 16), __uint_as_float(rv[i].z & 0xffff0000u), __uint_as_float(rv[i].w << 16), __uint_as_float(rv[i].w & 0xffff0000u));
            *(LAS unsigned*)(tb + lane * 68 + i * 8) = lo; *(LAS unsigned*)(tb + lane * 68 + i * 8 + 4) = hi; }
        LDS_WAIT(); asm volatile("" ::: "memory");
        v4u ov[4];
#pragma unroll
        for (int i = 0; i < 4; ++i) { unsigned wv[4];
#pragma unroll
            for (int q = 0; q < 4; ++q) { const int tt = i * 16 + q * 4;
                wv[q] = (unsigned)tb[(tt + 0) * 68 + lane] | ((unsigned)tb[(tt + 1) * 68 + lane] << 8) | ((unsigned)tb[(tt + 2) * 68 + lane] << 16) | ((unsigned)tb[(tt + 3) * 68 + lane] << 24); }
            ov[i] = (v4u){wv[0], wv[1], wv[2], wv[3]}; }
        GAS v4u* dst = (GAS v4u*)(VT8 + ((size_t)(b * 2 + kvh) * 64 + lane) * SEQ + t0);
#pragma unroll
        for (int i = 0; i < 4; ++i) dst[i] = ov[i];
        LDS_WAIT(); asm volatile("" ::: "memory");
    }
}
__device__ __forceinline__ void p6_norm2_router(Frame& F) {
    constexpr int WP = 1028;
    LAS float* Wt = (LAS float*)(F.lds + RING_OFF);
    LAS float* g2s = (LAS float*)(F.lds + RING_OFF + 16 * WP * 4);
    const float* w_router = inptr(F, IN_W_ROUTER); const float* norm2_g = inptr(F, IN_NORM2_G);
    for (int i = F.tid; i < DM * NE; i += NWAVES * 64) Wt[(i & 15) * WP + (i >> 4)] = w_router[i] * norm2_g[i >> 4];
    for (int i = F.tid; i < DM; i += NWAVES * 64) g2s[i] = norm2_g[i];
    __syncthreads();
    const int gw = F.vcu * NWAVES + F.wave, NGW = F.G * NWAVES, lane = F.lane, t = lane & 15, kq = lane >> 4;
    const bf16* XB = (const bf16*)(F.ws + WS_XB); unsigned char* XF8 = F.ws + WS_XN; float* AFF = (float*)(F.ws + WS_AFF);
    const LAS float* wl = Wt + t * WP + 256 * kq; const LAS float* gl = g2s + 256 * kq;
#pragma unroll 1
    for (int T = gw; T < M / 16; T += NGW) {
        const size_t row = (size_t)T * 16 + t;
        const GAS v4u* xp = (const GAS v4u*)(XB + row * DM + 256 * kq);
        f32x4 acc = {0.f, 0.f, 0.f, 0.f}; float ss = 0.f;
        v4u xn[8];
#pragma unroll
        for (int c = 0; c < 8; ++c) xn[c] = xp[c];
#pragma unroll 1
        for (int cb = 0; cb < 4; ++cb) {
            v4u xr[8];
#pragma unroll
            for (int c = 0; c < 8; ++c) xr[c] = xn[c];
            if (cb < 3) {
#pragma unroll
                for (int c = 0; c < 8; ++c) xn[c] = xp[8 * (cb + 1) + c]; }
#pragma unroll
            for (int c = 0; c < 8; ++c) {
                const f32x4 w0 = *(const LAS f32x4*)(wl + 64 * cb + 8 * c), w1 = *(const LAS f32x4*)(wl + 64 * cb + 8 * c + 4);
                const float x0 = __uint_as_float(xr[c].x << 16), x1 = __uint_as_float(xr[c].x & 0xffff0000u), x2 = __uint_as_float(xr[c].y << 16), x3 = __uint_as_float(xr[c].y & 0xffff0000u);
                const float x4 = __uint_as_float(xr[c].z << 16), x5 = __uint_as_float(xr[c].z & 0xffff0000u), x6 = __uint_as_float(xr[c].w << 16), x7 = __uint_as_float(xr[c].w & 0xffff0000u);
                ss += (x0 * x0 + x1 * x1) + (x2 * x2 + x3 * x3) + (x4 * x4 + x5 * x5) + (x6 * x6 + x7 * x7);
                acc = __builtin_amdgcn_mfma_f32_16x16x4f32(x0, w0.x, acc, 0, 0, 0); acc = __builtin_amdgcn_mfma_f32_16x16x4f32(x1, w0.y, acc, 0, 0, 0);
                acc = __builtin_amdgcn_mfma_f32_16x16x4f32(x2, w0.z, acc, 0, 0, 0); acc = __builtin_amdgcn_mfma_f32_16x16x4f32(x3, w0.w, acc, 0, 0, 0);
                acc = __builtin_amdgcn_mfma_f32_16x16x4f32(x4, w1.x, acc, 0, 0, 0); acc = __builtin_amdgcn_mfma_f32_16x16x4f32(x5, w1.y, acc, 0, 0, 0);
                acc = __builtin_amdgcn_mfma_f32_16x16x4f32(x6, w1.z, acc, 0, 0, 0); acc = __builtin_amdgcn_mfma_f32_16x16x4f32(x7, w1.w, acc, 0, 0, 0);
                if (c & 1) asm volatile("" ::: "memory");
            }
        }
        ss += __shfl_xor(ss, 16); ss += __shfl_xor(ss, 32);
        const float rs = 1.0f / sqrtf(ss * (1.f / DM) + NORM_EPS);
#pragma unroll
        for (int r = 0; r < 4; ++r) {
            const float lg = acc[r] * __shfl(rs, 4 * kq + r);
            float mx = lg;
#pragma unroll
            for (int o = 1; o < 16; o <<= 1) mx = fmaxf(mx, __shfl_xor(mx, o));
            const float ex = __expf(lg - mx); float sm = ex;
#pragma unroll
            for (int o = 1; o < 16; o <<= 1) sm += __shfl_xor(sm, o);
            AFF[((size_t)T * 16 + 4 * kq + r) * NE + t] = ex / sm;
        }
        GAS v4u* op = (GAS v4u*)(XF8 + row * DM + 256 * kq); const float sc = rs * pg8::F8_ACT_SCALE;
#pragma unroll
        for (int c = 0; c < 8; ++c) xn[c] = xp[c];
#pragma unroll 1
        for (int cb = 0; cb < 4; ++cb) {
            v4u xr[8];
#pragma unroll
            for (int c = 0; c < 8; ++c) xr[c] = xn[c];
            if (cb < 3) {
#pragma unroll
                for (int c = 0; c < 8; ++c) xn[c] = xp[8 * (cb + 1) + c]; }
#pragma unroll
            for (int c2 = 0; c2 < 4; ++c2) { v4u o;
#pragma unroll
                for (int hh = 0; hh < 2; ++hh) { const int c = 2 * c2 + hh; const f32x4 g0 = *(const LAS f32x4*)(gl + 64 * cb + 8 * c), g1 = *(const LAS f32x4*)(gl + 64 * cb + 8 * c + 4);
                    const unsigned a = pg8::pk4_fp8(__uint_as_float(xr[c].x << 16) * sc * g0.x, __uint_as_float(xr[c].x & 0xffff0000u) * sc * g0.y, __uint_as_float(xr[c].y << 16) * sc * g0.z, __uint_as_float(xr[c].y & 0xffff0000u) * sc * g0.w);
                    const unsigned bq = pg8::pk4_fp8(__uint_as_float(xr[c].z << 16) * sc * g1.x, __uint_as_float(xr[c].z & 0xffff0000u) * sc * g1.y, __uint_as_float(xr[c].w << 16) * sc * g1.z, __uint_as_float(xr[c].w & 0xffff0000u) * sc * g1.w);
                    if (hh == 0) { o.x = a; o.y = bq; } else { o.z = a; o.w = bq; } }
                op[4 * cb + c2] = o; asm volatile("" ::: "memory"); }
        }
    }
    __syncthreads();
}
__device__ __forceinline__ int block_excl_scan(int v, LAS int* sc, int tid, int lane, int wave, int& total) {
    int inc = v;
#pragma unroll
    for (int o = 1; o < 64; o <<= 1) { const int t = __shfl_up(inc, o); if (lane >= o) inc += t; }
    __syncthreads();
    if (lane == 63) sc[wave] = inc;
    __syncthreads();
    int base = 0, tot = 0;
#pragma unroll
    for (int w = 0; w < NWAVES; ++w) { const int t = sc[w]; if (w < wave) base += t; tot += t; }
    total = tot; return base + inc - v;
}
__device__ __forceinline__ void p7_topk(Frame& F) {
    LAS unsigned* hist = (LAS unsigned*)(F.lds + RING_OFF);
    LAS int* sc = (LAS int*)(F.lds + RING_OFF + 1024);
    LAS unsigned* sel = (LAS unsigned*)(F.lds + RING_OFF + 1024 + 64);
    const float* AFF = (const float*)(F.ws + WS_AFF); int* TOPI = (int*)(F.ws + WS_TOPI); float* TOPG = (float*)(F.ws + WS_TOPG); int* TSLOT = (int*)(F.ws + WS_TSLOT);
    const int tid = F.tid, lane = F.lane, wave = F.wave;
    for (int g = blockIdx.x; g < BATCH * NE; g += F.G) {
        const int b = g >> 4, e = g & 15;
        unsigned k[16];
#pragma unroll
        for (int i = 0; i < 16; ++i) k[i] = __float_as_uint(AFF[((size_t)b * SEQ + tid * 16 + i) * NE + e]);
        unsigned prefix = 0u, mask = 0u, remaining = CAP;
#pragma unroll 1
        for (int pass = 3; pass >= 0; --pass) {
            const int shift = pass * 8;
            __syncthreads();
            if (tid < 256) hist[tid] = 0u;
            __syncthreads();
#pragma unroll
            for (int i = 0; i < 16; ++i) if ((k[i] & mask) == prefix) atomicAdd((unsigned*)&hist[(k[i] >> shift) & 255u], 1u);
            __syncthreads();
            if (wave == 0) {
                unsigned c[4]; unsigned tot = 0u;
#pragma unroll
                for (int q = 0; q < 4; ++q) { c[q] = hist[255 - 4 * lane - q]; tot += c[q]; }
                unsigned inc = tot;
#pragma unroll
                for (int o = 1; o < 64; o <<= 1) { const unsigned t = __shfl_up(inc, o); if (lane >= o) inc += t; }
                const unsigned exc = inc - tot;
                if (exc < remaining && remaining <= inc) { unsigned cum = exc, rem = 0u; int bin = 0; bool found = false;
#pragma unroll
                    for (int q = 0; q < 4; ++q) { if (!found && cum + c[q] >= remaining) { bin = 255 - 4 * lane - q; rem = remaining - cum; found = true; } cum += c[q]; }
                    sel[0] = (unsigned)bin; sel[1] = rem; }
            }
            __syncthreads();
            prefix |= sel[0] << shift; mask |= 255u << shift; remaining = sel[1];
        }
        int cgt = 0, ceq = 0;
#pragma unroll
        for (int i = 0; i < 16; ++i) { cgt += (k[i] > prefix) ? 1 : 0; ceq += (k[i] == prefix) ? 1 : 0; }
        int toteq; const int eq0 = block_excl_scan(ceq, sc, tid, lane, wave, toteq);
        int nsel = cgt; { int rk = eq0;
#pragma unroll
            for (int i = 0; i < 16; ++i) if (k[i] == prefix) { if ((unsigned)rk < remaining) ++nsel; ++rk; } }
        int totsel; int pos = block_excl_scan(nsel, sc, tid, lane, wave, totsel);
        int rk = eq0;
#pragma unroll
        for (int i = 0; i < 16; ++i) {
            const int stok = tid * 16 + i; bool take = k[i] > prefix;
            if (k[i] == prefix) { take = (unsigned)rk < remaining; ++rk; }
            int slot = -1;
            if (take) { slot = pos; TOPI[g * CAP + pos] = stok; TOPG[g * CAP + pos] = __uint_as_float(k[i]); ++pos; }
            TSLOT[((size_t)b * SEQ + stok) * NE + e] = slot;
        }
    }
    __syncthreads();
}
__device__ __forceinline__ void p8_gather(Frame& F) {
    const int gw = F.vcu * NWAVES + F.wave, NGW = F.G * NWAVES, lane = F.lane;
    const unsigned char* XF8 = F.ws + WS_XN; unsigned char* XG = F.ws + WS_XG; const int* TOPI = (const int*)(F.ws + WS_TOPI);
    for (int r = gw; r < MR; r += NGW) {
        const int b = r >> 14; const int tok = TOPI[r];
        const GAS v4u* src = (const GAS v4u*)(XF8 + ((size_t)b * SEQ + tok) * DM) + lane; GAS v4u* dst = (GAS v4u*)(XG + (size_t)r * DM) + lane;
        dst[0] = src[0];
    }
}
__device__ __forceinline__ void p11_final(Frame& F, bool poison) {
    const int gw = F.vcu * NWAVES + F.wave, NGW = F.G * NWAVES, lane = F.lane;
    const unsigned char* Y = F.ws + WS_Y; const int* TSLOT = (const int*)(F.ws + WS_TSLOT);
    f32x4 gg[4];
#pragma unroll
    for (int j = 0; j < 4; ++j) gg[j] = ((const GAS f32x4*)inptr(F, IN_NORMF_G))[lane + 64 * j];
    const float qnan = __builtin_nanf("");
    unsigned long long xw[4] = {0ull, 0ull, 0ull, 0ull}; int slotw = -1;
    if (gw < M) { const GAS unsigned long long* xb = (const GAS unsigned long long*)((const bf16*)(F.ws + WS_XB) + (size_t)gw * DM) + lane;
#pragma unroll
        for (int j = 0; j < 4; ++j) xw[j] = xb[64 * j];
        slotw = TSLOT[(size_t)gw * NE + (lane & 15)]; }
    for (int m = gw; m < M; m += NGW) {
        GAS f32x4* xr = (GAS f32x4*)(F.out + (size_t)m * DM) + lane;
        f32x4 v[4];
#pragma unroll
        for (int j = 0; j < 4; ++j) { const unsigned lo = (unsigned)xw[j], hi = (unsigned)(xw[j] >> 32);
            v[j] = (f32x4){__uint_as_float(lo << 16), __uint_as_float(lo & 0xffff0000u), __uint_as_float(hi << 16), __uint_as_float(hi & 0xffff0000u)}; }
        const int b = m >> 13; const int myslot = slotw;
        if (m + NGW < M) { const GAS unsigned long long* xb = (const GAS unsigned long long*)((const bf16*)(F.ws + WS_XB) + (size_t)(m + NGW) * DM) + lane;
#pragma unroll
            for (int j = 0; j < 4; ++j) xw[j] = xb[64 * j];
            slotw = TSLOT[(size_t)(m + NGW) * NE + (lane & 15)]; }
        unsigned msk = (unsigned)(__builtin_amdgcn_ballot_w64(myslot >= 0 && lane < 16) & 0xffffull);
#pragma unroll 1
        while (msk) {
            const int e0 = __builtin_ctz(msk); msk &= msk - 1u; const bool two = msk != 0u; const int e1 = two ? __builtin_ctz(msk) : e0; if (two) msk &= msk - 1u;
            const int s0 = __builtin_amdgcn_readlane(myslot, e0), s1 = __builtin_amdgcn_readlane(myslot, e1);
            const GAS int* y0 = (const GAS int*)(Y + ((size_t)(b * NE + e0) * CAP + s0) * DM) + lane; const GAS int* y1 = (const GAS int*)(Y + ((size_t)(b * NE + e1) * CAP + s1) * DM) + lane;
            int w0[4], w1[4];
#pragma unroll
            for (int j = 0; j < 4; ++j) { w0[j] = y0[64 * j]; w1[j] = y1[64 * j]; }
            typedef float f32x2v __attribute__((ext_vector_type(2)));
#pragma unroll
            for (int j = 0; j < 4; ++j) { const f32x2v lo = __builtin_amdgcn_cvt_pk_f32_fp8(w0[j], false), hi = __builtin_amdgcn_cvt_pk_f32_fp8(w0[j], true);
                v[j].x += lo.x * (1.0f / pg8::Y_SCALE); v[j].y += lo.y * (1.0f / pg8::Y_SCALE); v[j].z += hi.x * (1.0f / pg8::Y_SCALE); v[j].w += hi.y * (1.0f / pg8::Y_SCALE); }
            if (two) {
#pragma unroll
                for (int j = 0; j < 4; ++j) { const f32x2v lo = __builtin_amdgcn_cvt_pk_f32_fp8(w1[j], false), hi = __builtin_amdgcn_cvt_pk_f32_fp8(w1[j], true);
                    v[j].x += lo.x * (1.0f / pg8::Y_SCALE); v[j].y += lo.y * (1.0f / pg8::Y_SCALE); v[j].z += hi.x * (1.0f / pg8::Y_SCALE); v[j].w += hi.y * (1.0f / pg8::Y_SCALE); } }
        }
        float s2 = 0.f;
#pragma unroll
        for (int j = 0; j < 4; ++j) s2 += (v[j].x * v[j].x + v[j].y * v[j].y) + (v[j].z * v[j].z + v[j].w * v[j].w);
        const float rs = 1.0f / sqrtf(wave_sum(s2) * (1.f / DM) + NORM_EPS);
#pragma unroll
        for (int j = 0; j < 4; ++j) { f32x4 o = v[j] * rs * gg[j]; if (poison) o = (f32x4){qnan, qnan, qnan, qnan}; xr[64 * j] = o; }
    }
}

struct Args { const float* in[15]; float* out; unsigned char* ws; int ph_lo, ph_hi; };
__global__ void __launch_bounds__(NWAVES * 64, 2) hyb_fwd(Args args) {
    extern __shared__ __attribute__((aligned(16))) unsigned char lds[];
    Frame F;
    F.lds = (LAS unsigned char*)lds;
    F.MISC = (volatile LAS unsigned*)(F.lds + MISC_OFF);
    F.tid = threadIdx.x; F.lane = F.tid & 63; F.wave = __builtin_amdgcn_readfirstlane(F.tid >> 6);
    F.G = gridDim.x; { const int bx = blockIdx.x; F.vcu = (F.G % 8 == 0) ? (bx % 8) * (F.G / 8) + bx / 8 : bx; }
    F.ws = args.ws; F.ctl = (gu32*)(args.ws + WS_CTL); F.out = args.out;
    for (int u = F.tid; u < (LDS_BYTES - LDSCTL_OFF) / 4; u += NWAVES * 64) ((LAS unsigned*)(F.lds + LDSCTL_OFF))[u] = 0u;
    __syncthreads();
    if (F.tid == 0) { LAS unsigned long long* pt = (LAS unsigned long long*)(F.lds + LDSCTL_OFF + 64);
#pragma unroll
        for (int k = 0; k < 15; ++k) pt[k] = (unsigned long long)args.in[k]; }
    __syncthreads();
    XcdBarrier bar; bar.bar = (unsigned*)(F.ctl + CW_BAR); bar.x = 0; bar.st = nullptr;
    if (N_LAUNCHES == 1) bar = xcd_barrier_post((unsigned*)(F.ctl + CW_BAR), F.MISC + 8);
#define GRID_BAR() do { if (N_LAUNCHES == 1) { xcd_barrier(bar); } } while (0)
    const int lo = args.ph_lo, hi = args.ph_hi;
#ifndef PH_MASK
#define PH_MASK 0xFFF
#endif
#define IN(k) (((PH_MASK >> (k)) & 1) && lo <= (k) && (k) < hi)
#define BOTH(k) (IN(k) && IN((k) + 1))
#ifndef DUP_MASK
#define DUP_MASK 0
#endif
#define REP(k) _Pragma("unroll 1") for (int rep_ = 0; rep_ < (((DUP_MASK >> (k)) & 1) ? 2 : 1); ++rep_)
    unsigned char* ws = args.ws;
    pg8::bf16_t* XN = (pg8::bf16_t*)(ws + WS_XN);

    if (IN(0)) { REP(0) { p0_prologue(F); } if (BOTH(0)) GRID_BAR(); }

    if (IN(1)) {
        pg8::Gemm g{XN, (const pg8::bf16_t*)(ws + WS_WIN), GEMM1_FP8 ? DM / 2 : DM, GEMM1_FP8 ? DM / 2 : DM, GEMM1_FP8 ? DM / 2 : DM, nullptr}; pg8::StaticOrder S; S.init(M, N_IN, F.G, (int)blockIdx.x, GEMM1_WGM);
        pg8::EpiZ E{(pg8::bf16_t*)(ws + WS_QA), (pg8::bf16_t*)(ws + WS_KVA), (pg8::bf16_t*)(ws + WS_QB), (pg8::bf16_t*)(ws + WS_KB), (pg8::bf16_t*)(ws + WS_VB), (pg8::bf16_t*)(ws + WS_G), inptr(F, IN_B_GATES), GEMM1_FP8 ? pg8::F8_DEQ : 1.0f};
        REP(1) { pg8::gemm_phase<pg8::EpiZ, pg8::StaticOrder, true, true, GEMM1_FP8 != 0>(F.lds + RING_OFF, g, S, E); }
        if ((DUP_MASK >> 14) & 1) { pg8::EpiNull EN; pg8::gemm_phase<pg8::EpiNull, pg8::StaticOrder, true, true, GEMM1_FP8 != 0>(F.lds + RING_OFF, g, S, EN); }
        if (BOTH(1)) GRID_BAR();
    }
    if (IN(2)) { p2_qknorm_rope(F); if (BOTH(2)) GRID_BAR(); }

    if (IN(3)) {
        static_assert(attn_body::ATTN_LDS_BYTES <= RING_BYTES, "attention body geometry vs frame");
        const attn_body::AttnTensors AT{(const attn_body::bf16*)(ws + WS_QA), (const attn_body::bf16*)(ws + WS_KVA), (const attn_body::bf16*)(ws + WS_KVA) + 128, (attn_body::bf16*)(ws + WS_OAB)};
        const attn_body::StaticOrder S((int)F.G, F.vcu);
        float cref; { const float* qg = inptr(F, IN_Q_NORM_G); const float* kg = inptr(F, IN_K_NORM_G); float mq = 0.f, mk = 0.f;
            for (int i = 0; i < 64; ++i) { mq = fmaxf(mq, fabsf(qg[i])); mk = fmaxf(mk, fabsf(kg[i])); }
            cref = 8.0f * mq * mk * 1.4426950408889634f * 1.02f + 0.05f; cref = __builtin_bit_cast(float, __builtin_amdgcn_readfirstlane(__builtin_bit_cast(int, cref))); }
#if ATTN_FP8
        { const float cref8 = fmaxf(0.f, cref - 15.5f); attn_body::AttnUnit u;
          REP(12) { if (cref8 == 0.f) { for (int i = 0; S.next(i, u); ++i) attn8::unit<0, true>(u.b, u.h, u.qb, ws + WS_Q8, ws + WS_K8, ws + WS_VT8, (attn_body::bf16*)(ws + WS_OAB), (char*)lds + RING_OFF, 0.f); }
                    else { for (int i = 0; S.next(i, u); ++i) attn8::unit<0, false>(u.b, u.h, u.qb, ws + WS_Q8, ws + WS_K8, ws + WS_VT8, (attn_body::bf16*)(ws + WS_OAB), (char*)lds + RING_OFF, cref8); } } }
#ifdef A8_PROBE_MODE
        { const float cref8 = fmaxf(0.f, cref - 15.5f); attn_body::AttnUnit u; attn_body::bf16* dummyO = (attn_body::bf16*)(ws + WS_QA);
          for (int i = 0; S.next(i, u); ++i) attn8::unit<A8_PROBE_MODE, true>(u.b, u.h, u.qb, ws + WS_Q8, ws + WS_K8, ws + WS_VT8, dummyO, (char*)lds + RING_OFF, cref8); }
#endif
#else
        REP(12) { attn_body::attn_phase<attn_body::StaticOrder>((char*)lds + RING_OFF, AT, S, cref); }
#endif
        __syncthreads();
        REP(13) {
            char* wl = (char*)lds + RING_OFF + F.wave * 16384; float* wsf = (float*)((char*)lds + WSF_OFF) + F.wave * 64;
            int lane2 = F.lane; asm volatile("" : "+v"(lane2));
#pragma unroll 1
            for (int L = F.vcu; L < BATCH * 4 * 16; L += F.G)
                attnb2::b2_unit(lane2, L >> 6, (L >> 4) & 3, L & 15, F.wave, (const attn_body::bf16*)(ws + WS_QB), (const attn_body::bf16*)(ws + WS_KB), (const attn_body::bf16*)(ws + WS_VB), (attn_body::bf16*)(ws + WS_OAB), (float*)(ws + WS_AFF), wl, wsf);
        }
#ifdef B2_PROBE_MODE
        { char* wl = (char*)lds + RING_OFF + F.wave * 16384; float* wsf = (float*)((char*)lds + WSF_OFF) + F.wave * 64; int lane2 = F.lane; asm volatile("" : "+v"(lane2));
          for (int L = F.vcu; L < BATCH * 4 * 16; L += F.G) attnb2::b2_unit<B2_PROBE_MODE>(lane2, L >> 6, (L >> 4) & 3, L & 15, F.wave, (const attn_body::bf16*)(ws + WS_QB), (const attn_body::bf16*)(ws + WS_KB), (const attn_body::bf16*)(ws + WS_VB), (attn_body::bf16*)(ws + WS_QA), (float*)(ws + WS_AFF + 2 * MiB), wl, wsf); }
#endif
        asm volatile("s_waitcnt vmcnt(0) lgkmcnt(0)" ::: "memory");
        __syncthreads();
        if (BOTH(3)) GRID_BAR();
    }
    if (IN(4)) {
        const pg8::bf16_t* OAB = (const pg8::bf16_t*)(ws + WS_OAB); const pg8::bf16_t* WO = (const pg8::bf16_t*)(ws + WS_WO); const pg8::bf16_t* Gt = (const pg8::bf16_t*)(ws + WS_G);
        pg8::StaticOrder S; S.init(M, DM, F.G, (int)blockIdx.x);
        REP(4) { pg8::Gemm g{OAB, WO, 768, 768, 768, nullptr}; pg8::EpiGateHook E{Gt, XN}; pg8::gemm_phase<pg8::EpiGateHook, pg8::StaticOrder, true, true>(F.lds + RING_OFF, g, S, E); }
        if (BOTH(4)) GRID_BAR();
    }
    if (IN(5)) {
        pg8::Gemm g{XN, (const pg8::bf16_t*)(ws + WS_WOUT), DM, DM, DM, nullptr}; pg8::StaticOrder S; S.init(M, DM, F.G, (int)blockIdx.x);
        pg8::EpiResBf16 E{inptr(F, IN_X), (pg8::bf16_t*)(ws + WS_XB)};
        REP(5) { pg8::gemm_phase<pg8::EpiResBf16, pg8::StaticOrder, true, true>(F.lds + RING_OFF, g, S, E); }
        if (BOTH(5)) GRID_BAR();
    }
    if (IN(6)) { REP(6) { p6_norm2_router(F); } if (BOTH(6)) GRID_BAR(); }
    if (IN(7)) { REP(7) { p7_topk(F); } if (BOTH(7)) GRID_BAR(); }
    if (IN(9)) {
        pg8::Gemm g{(const pg8::bf16_t*)(ws + WS_XN), (const pg8::bf16_t*)(ws + WS_WGU), DM / 2, DM / 2, DM / 2, (const int*)(ws + WS_TOPI)}; pg8::MoeOrderGU S{F.G, F.vcu};
        pg8::EpiSwiglu E{ws + WS_ACT};
        pg8::gemm_phase<pg8::EpiSwiglu, pg8::MoeOrderGU, true, true, true, true>(F.lds + RING_OFF, g, S, E);
        if ((DUP_MASK >> 9) & 1) { asm volatile("" ::: "memory"); pg8::gemm_phase<pg8::EpiSwiglu, pg8::MoeOrderGU, true, true, true, true>(F.lds + RING_OFF, g, S, E); }
        if ((DUP_MASK >> 18) & 1) { pg8::EpiSwigluT<false> E2{E.O}; pg8::gemm_phase<pg8::EpiSwigluT<false>, pg8::MoeOrderGU, true, true, true, true>(F.lds + RING_OFF, g, S, E2); }
        if ((DUP_MASK >> 15) & 1) { pg8::EpiNull EN; pg8::gemm_phase<pg8::EpiNull, pg8::MoeOrderGU, true, true, true, true>(F.lds + RING_OFF, g, S, EN); }
        if ((DUP_MASK >> 16) & 1) { pg8::EpiNull EN; pg8::gemm_phase<pg8::EpiNull, pg8::MoeOrderGU, true, true, false, true>(F.lds + RING_OFF, g, S, EN); }
        if (BOTH(9)) GRID_BAR();
    }
    if (IN(10)) {
        pg8::Gemm g{(const pg8::bf16_t*)(ws + WS_ACT), (const pg8::bf16_t*)(ws + WS_WD), FF / 2, FF / 2, FF / 2, nullptr}; pg8::MoeOrderDown S{F.G, F.vcu};
        pg8::EpiDown E{ws + WS_Y, (const float*)(ws + WS_TOPG)};
        pg8::gemm_phase<pg8::EpiDown, pg8::MoeOrderDown, true, true, true>(F.lds + RING_OFF, g, S, E);
        if ((DUP_MASK >> 10) & 1) { asm volatile("" ::: "memory"); pg8::gemm_phase<pg8::EpiDown, pg8::MoeOrderDown, true, true, true>(F.lds + RING_OFF, g, S, E); }
        if (BOTH(10)) GRID_BAR();
    }
    if (IN(11)) {
        bool poison = false;
        if (N_LAUNCHES == 1) poison = __hip_atomic_load((gu32*)((const unsigned*)(F.ctl + CW_BAR) + XB_TMO), RLX_AGENT) != 0u;
        p11_final(F, poison);
    }
#undef IN
#undef BOTH
#undef GRID_BAR
}

extern "C" void kernel_launch(void* const* d_in, const int* in_sizes, int n_in, void* d_out, int out_size, void* d_ws, size_t ws_size, hipStream_t stream) {
    static int grid = 0;
    if (grid == 0) {
        if (n_in != 15 || in_sizes[0] != M * DM || out_size != M * DM || ws_size < WS_END) { fprintf(stderr, "kernel_launch: unexpected shapes / workspace (n_in %d, in0 %d, out %d, ws %zu < %zu); nothing launched\n", n_in, n_in > 0 ? in_sizes[0] : -1, out_size, ws_size, (size_t)WS_END); grid = -1; return; }
        int dev = 0, cus = 0, per_cu = 0;
        if (hipGetDevice(&dev) != hipSuccess || hipDeviceGetAttribute(&cus, hipDeviceAttributeMultiprocessorCount, dev) != hipSuccess) { grid = -1; return; }
        if (hipFuncSetAttribute((const void*)hyb_fwd, hipFuncAttributeMaxDynamicSharedMemorySize, LDS_BYTES) != hipSuccess) { fprintf(stderr, "kernel_launch: hipFuncSetAttribute failed\n"); grid = -1; return; }
        if (hipOccupancyMaxActiveBlocksPerMultiprocessor(&per_cu, (const void*)hyb_fwd, NWAVES * 64, LDS_BYTES) != hipSuccess || per_cu < 1) { fprintf(stderr, "kernel_launch: occupancy query reports %d workgroups per CU\n", per_cu); }
        (void)hipGetLastError();
        grid = cus;
    }
    if (grid < 0) return;
    if (hipMemsetAsync((char*)d_ws + WS_CTL, 0, CTL_ZERO_BYTES, stream) != hipSuccess) return;
    Args a{};
    for (int i = 0; i < 15; ++i) a.in[i] = (const float*)d_in[i];
    a.out = (float*)d_out; a.ws = (unsigned char*)d_ws;
    for (int li = 0; li < N_LAUNCHES; ++li) {
        a.ph_lo = (N_LAUNCHES == 1) ? 0 : li; a.ph_hi = (N_LAUNCHES == 1) ? N_PHASES : li + 1;
        hipLaunchKernelGGL(hyb_fwd, dim3(grid), dim3(NWAVES * 64), LDS_BYTES, stream, a);
        if (hipPeekAtLastError() != hipSuccess) { fprintf(stderr, "kernel_launch: launch %d failed\n", li); break; }
    }
}
```

```cpp
#include <hip/hip_runtime.h>
#include <cstdio>
#include <cstdint>
namespace pg8 {
#define PG8_LAS __attribute__((address_space(3)))
typedef unsigned short bf16_t;
typedef short bf16x8 __attribute__((ext_vector_type(8)));
typedef float f32x4 __attribute__((ext_vector_type(4)));
typedef unsigned u32x4 __attribute__((ext_vector_type(4)));
constexpr int BM = 256, BK = 64, HALF = 128, HTB = HALF * BK * 2  , STAGE_BYTES = 8 * HTB, NXCD = 8, WGM = 8;

__host__ __device__ __forceinline__ int lds_byte(int r, int c) { const int st = (r >> 4) * 2 + (c >> 5), rr = r & 15, cc = c & 31, ob = rr * 64 + cc * 2; return st * 1024 + (ob ^ (((ob >> 9) & 1) << 5)); }
__host__ __device__ __forceinline__ void stage_rc(int b, int& R, int& C) { const int st = b / 1024, sb = b % 1024, swz = sb ^ (((sb >> 9) & 1) << 5); R = (st >> 1) * 16 + swz / 64; C = (st & 1) * 32 + (swz % 64) / 2; }
__host__ __device__ __forceinline__ int perm32(int rho) { const int n = rho >> 4, i = rho & 15; return 8 * (i >> 2) + 4 * n + (i & 3); }

struct Unit { int pm, pn, pb; };
struct Gemm { const bf16_t* A; const bf16_t* Bt; int K, lda, ldb; const int* gidx; };

struct StaticOrder {
    int nM, nN, nwg, G, c, wgm;
    __host__ __device__ void init(int M, int N, int G_, int c_, int wgm_ = WGM) { nM = M / BM; nN = N / BM; nwg = nM * nN; G = G_; c = c_; wgm = wgm_; }
    __host__ __device__ bool next(int i, Unit& u) const {
        const long L = (long)i * G + c; if (L >= nwg) return false;
        int wgid = (int)L; { const int q = nwg / NXCD, r = nwg % NXCD, xcd = wgid % NXCD, off = wgid / NXCD; wgid = (xcd < r ? xcd * (q + 1) : r * (q + 1) + (xcd - r) * q) + off; }
        const int nig = wgm * nN, gid = wgid / nig, fm = gid * wgm, gsz = (nM - fm) < wgm ? (nM - fm) : wgm;
        u.pm = fm + ((wgid % nig) % gsz); u.pn = (wgid % nig) / gsz; u.pb = u.pn; return true;
    }
    __device__ __forceinline__ void a_ready(const Unit&) const {}
    __device__ __forceinline__ void done(const Unit&) const {}
};
struct MoeOrderGU {
    int G, vcu;
    __device__ __forceinline__ bool next(int i, Unit& u) const {
        const int L = i * G + vcu; if (L >= 4096) return false;
        const int rnd = L >> 8, x = (L >> 5) & 7, w = L & 31; const int e = 2 * x + (rnd >> 3), b = rnd & 7, g = b * 16 + e;
        u.pm = g * 4 + (w & 3); u.pn = w >> 2; u.pb = e * 8 + u.pn; return true; }
    __device__ __forceinline__ void a_ready(const Unit&) const {}
    __device__ __forceinline__ void done(const Unit&) const {}
};
struct MoeOrderDown {
    int G, vcu;
    __device__ __forceinline__ bool next(int i, Unit& u) const {
        const int L = i * G + vcu; if (L >= 2048) return false;
        const int rnd = L >> 8, x = (L >> 5) & 7, w = L & 31; const int jj = 2 * rnd + (w >> 4), w16 = w & 15; const int e = 2 * x + (jj >> 3), b = jj & 7, g = b * 16 + e;
        u.pm = g * 4 + (w16 & 3); u.pn = w16 >> 2; u.pb = e * 4 + u.pn; return true; }
    __device__ __forceinline__ void a_ready(const Unit&) const {}
    __device__ __forceinline__ void done(const Unit&) const {}
};

__device__ __forceinline__ unsigned cvt_pk_bf16(float lo, float hi) { unsigned r; asm volatile("v_cvt_pk_bf16_f32 %0, %1, %2" : "=v"(r) : "v"(lo), "v"(hi)); return r; }
__device__ __forceinline__ float bf_lo(unsigned w) { return __uint_as_float(w << 16); }
__device__ __forceinline__ float bf_hi(unsigned w) { return __uint_as_float(w & 0xffff0000u); }
__device__ __forceinline__ float sigmoidf_fast(float v) { return __builtin_amdgcn_rcpf(1.0f + __builtin_amdgcn_exp2f(-1.4426950408889634f * v)); }
constexpr float QSCALE = 0.125f * 1.4426950408889634f;

typedef int i32x8 __attribute__((ext_vector_type(8)));
typedef int i32x4 __attribute__((ext_vector_type(4)));
__device__ __forceinline__ i32x8 cat8(bf16x8 lo, bf16x8 hi) { return __builtin_shufflevector(__builtin_bit_cast(i32x4, lo), __builtin_bit_cast(i32x4, hi), 0, 1, 2, 3, 4, 5, 6, 7); }
__device__ __forceinline__ unsigned pk4_fp8(float a, float b, float c, float d) {
    a = __builtin_amdgcn_fmed3f(a, -448.f, 448.f); b = __builtin_amdgcn_fmed3f(b, -448.f, 448.f); c = __builtin_amdgcn_fmed3f(c, -448.f, 448.f); d = __builtin_amdgcn_fmed3f(d, -448.f, 448.f);
    int w = __builtin_amdgcn_cvt_pk_fp8_f32(a, b, 0, false); w = __builtin_amdgcn_cvt_pk_fp8_f32(c, d, w, true); return (unsigned)w; }
constexpr float Y_SCALE = 64.0f;
constexpr float F8_ACT_SCALE = 8.0f, F8_W_SCALE = 64.0f, F8_DEQ = 1.0f / (F8_ACT_SCALE * F8_W_SCALE);
struct EpiZ {
    static constexpr bool PERM = true, AFTER_DRAIN = false;
    bf16_t *QA, *KVA, *QB, *KB, *VB, *G; const float* bg; float deq;
    __device__ __forceinline__ void operator()(const f32x4 (&acc)[2][2][4][2], const Unit& u, int wr, int wc, int fr, int fq) const {
        const int pn = u.pn; int ldc, colt; float sc = deq; const bool gate = pn >= 12;
        long boff;
        if (pn < 2) { boff = 0; ldc = 512; colt = pn * 256; }
        else if (pn == 2) { boff = KVA - QA; ldc = 256; colt = 0; }
        else if (pn < 6) { boff = QB - QA; ldc = 768; colt = (pn - 3) * 256; sc = QSCALE * deq; }
        else if (pn < 9) { boff = KB - QA; ldc = 768; colt = (pn - 6) * 256; }
        else { boff = VB - QA; ldc = 768; colt = (pn - 9) * 256; }
        bf16_t* base = QA + boff;
        const int row0 = u.pm * BM + wr * 64 + fr, col0 = colt + wc * 32 + 8 * fq;
        if (gate) {
            const int gcol = (pn - 12) * HALF + wc * 32 + 8 * fq; const float k2 = sc * -1.4426950408889634f;
            f32x4 ba[2], bb[2];
#pragma unroll
            for (int n = 0; n < 2; ++n) { ba[n] = *(const f32x4*)(bg + gcol + 4 * n) * (-1.4426950408889634f); bb[n] = *(const f32x4*)(bg + 1024 + gcol + 4 * n) * (-1.4426950408889634f); }
#pragma unroll
            for (int ai = 0; ai < 2; ++ai)
#pragma unroll
                for (int m = 0; m < 4; ++m) { bf16_t* rowp = G + (size_t)(row0 + ai * HALF + m * 16) * 2048 + gcol;
                    f32x4 rr[2], gb[2];
#pragma unroll
                    for (int n = 0; n < 2; ++n) { f32x4 ea = acc[ai][0][m][n] * k2 + ba[n], eb = acc[ai][1][m][n] * k2 + bb[n];
#pragma unroll
                        for (int q = 0; q < 4; ++q) { ea[q] = __builtin_amdgcn_exp2f(ea[q]); eb[q] = __builtin_amdgcn_exp2f(eb[q]); }
                        ea = ea + 1.0f; eb = eb + 1.0f;
#pragma unroll
                        for (int q = 0; q < 4; ++q) { ea[q] = __builtin_amdgcn_rcpf(ea[q]); gb[n][q] = __builtin_amdgcn_rcpf(eb[q]); }
                        rr[n] = ea * eb; }
                    u32x4 w; w.x = cvt_pk_bf16(rr[0][0], rr[0][1]); w.y = cvt_pk_bf16(rr[0][2], rr[0][3]); w.z = cvt_pk_bf16(rr[1][0], rr[1][1]); w.w = cvt_pk_bf16(rr[1][2], rr[1][3]);
                    *(u32x4*)rowp = w;
                    w.x = cvt_pk_bf16(gb[0][0], gb[0][1]); w.y = cvt_pk_bf16(gb[0][2], gb[0][3]); w.z = cvt_pk_bf16(gb[1][0], gb[1][1]); w.w = cvt_pk_bf16(gb[1][2], gb[1][3]);
                    *(u32x4*)(rowp + 1024) = w; }
            return; }
#pragma unroll
        for (int ai = 0; ai < 2; ++ai)
#pragma unroll
            for (int m = 0; m < 4; ++m) { bf16_t* rowp = base + (size_t)(row0 + ai * HALF + m * 16) * ldc + col0;
#pragma unroll
                for (int bj = 0; bj < 2; ++bj) { const f32x4 v0 = acc[ai][bj][m][0] * sc, v1 = acc[ai][bj][m][1] * sc;
                    u32x4 w; w.x = cvt_pk_bf16(v0[0], v0[1]); w.y = cvt_pk_bf16(v0[2], v0[3]); w.z = cvt_pk_bf16(v1[0], v1[1]); w.w = cvt_pk_bf16(v1[2], v1[3]);
                    *(u32x4*)(rowp + bj * HALF) = w; } }
    }
};
struct EpiNull {
    static constexpr bool PERM = true, AFTER_DRAIN = false;
    __device__ __forceinline__ void operator()(const f32x4 (&acc)[2][2][4][2], const Unit&, int, int, int, int) const {
#pragma unroll
        for (int a = 0; a < 2; ++a)
#pragma unroll
            for (int b = 0; b < 2; ++b)
#pragma unroll
                for (int m = 0; m < 4; ++m)
#pragma unroll
                    for (int n = 0; n < 2; ++n) asm volatile("" :: "v"(acc[a][b][m][n]));
    }
};
template <bool ADD> struct EpiGate {
    static constexpr bool PERM = true, AFTER_DRAIN = false;
    const bf16_t* Gt; bf16_t* O;
    __device__ __forceinline__ void operator()(const f32x4 (&acc)[2][2][4][2], const Unit& u, int wr, int wc, int fr, int fq) const {
        const int row0 = u.pm * BM + wr * 64 + fr, col0 = u.pn * BM + wc * 32 + 8 * fq;
#pragma unroll
        for (int ai = 0; ai < 2; ++ai)
#pragma unroll
            for (int m = 0; m < 4; ++m) { const size_t row = (size_t)(row0 + ai * HALF + m * 16);
#pragma unroll
                for (int bj = 0; bj < 2; ++bj) { const u32x4 gw = *(const u32x4*)(Gt + row * 2048 + col0 + bj * HALF); bf16_t* op = O + row * 1024 + col0 + bj * HALF;
                    f32x4 v0 = acc[ai][bj][m][0], v1 = acc[ai][bj][m][1];
                    v0[0] *= bf_lo(gw.x); v0[1] *= bf_hi(gw.x); v0[2] *= bf_lo(gw.y); v0[3] *= bf_hi(gw.y); v1[0] *= bf_lo(gw.z); v1[1] *= bf_hi(gw.z); v1[2] *= bf_lo(gw.w); v1[3] *= bf_hi(gw.w);
                    if (ADD) { const u32x4 t = *(const u32x4*)op; v0[0] += bf_lo(t.x); v0[1] += bf_hi(t.x); v0[2] += bf_lo(t.y); v0[3] += bf_hi(t.y); v1[0] += bf_lo(t.z); v1[1] += bf_hi(t.z); v1[2] += bf_lo(t.w); v1[3] += bf_hi(t.w); }
                    u32x4 w; w.x = cvt_pk_bf16(v0[0], v0[1]); w.y = cvt_pk_bf16(v0[2], v0[3]); w.z = cvt_pk_bf16(v1[0], v1[1]); w.w = cvt_pk_bf16(v1[2], v1[3]);
                    *(u32x4*)op = w; } }
    }
};
struct EpiGateHook {
    static constexpr bool PERM = true, AFTER_DRAIN = false, HAS_MID = true; static constexpr int MID_KT = 8;
    const bf16_t* Gt; bf16_t* O;
    __device__ __forceinline__ void mid(f32x4 (&acc)[2][2][4][2], const Unit& u, int wr, int wc, int fr, int fq) const {
        const int row0 = u.pm * BM + wr * 64 + fr, col0 = u.pn * BM + wc * 32 + 8 * fq;
#pragma unroll
        for (int ai = 0; ai < 2; ++ai)
#pragma unroll
            for (int m = 0; m < 4; ++m) { const size_t row = (size_t)(row0 + ai * HALF + m * 16);
#pragma unroll
                for (int bj = 0; bj < 2; ++bj) { const u32x4 ga = *(const u32x4*)(Gt + row * 2048 + col0 + bj * HALF);
                    f32x4& v0 = acc[ai][bj][m][0]; f32x4& v1 = acc[ai][bj][m][1];
                    v0[0] *= bf_lo(ga.x); v0[1] *= bf_hi(ga.x); v0[2] *= bf_lo(ga.y); v0[3] *= bf_hi(ga.y); v1[0] *= bf_lo(ga.z); v1[1] *= bf_hi(ga.z); v1[2] *= bf_lo(ga.w); v1[3] *= bf_hi(ga.w); }
                if (m & 1) asm volatile("" ::: "memory"); }
    }
    __device__ __forceinline__ void operator()(const f32x4 (&acc)[2][2][4][2], const Unit& u, int wr, int wc, int fr, int fq) const {
        const int row0 = u.pm * BM + wr * 64 + fr, col0 = u.pn * BM + wc * 32 + 8 * fq;
#pragma unroll
        for (int ai = 0; ai < 2; ++ai)
#pragma unroll
            for (int m = 0; m < 4; ++m) { const size_t row = (size_t)(row0 + ai * HALF + m * 16);
#pragma unroll
                for (int bj = 0; bj < 2; ++bj) { const u32x4 gw = *(const u32x4*)(Gt + row * 2048 + 1024 + col0 + bj * HALF); bf16_t* op = O + row * 1024 + col0 + bj * HALF;
                    f32x4 v0 = acc[ai][bj][m][0], v1 = acc[ai][bj][m][1];
                    v0[0] *= bf_lo(gw.x); v0[1] *= bf_hi(gw.x); v0[2] *= bf_lo(gw.y); v0[3] *= bf_hi(gw.y); v1[0] *= bf_lo(gw.z); v1[1] *= bf_hi(gw.z); v1[2] *= bf_lo(gw.w); v1[3] *= bf_hi(gw.w);
                    u32x4 w; w.x = cvt_pk_bf16(v0[0], v0[1]); w.y = cvt_pk_bf16(v0[2], v0[3]); w.z = cvt_pk_bf16(v1[0], v1[1]); w.w = cvt_pk_bf16(v1[2], v1[3]);
                    *(u32x4*)op = w; } }
    }
};
template <class E, class = void> struct epi_has_mid { static constexpr bool value = false; };
template <class E> struct epi_has_mid<E, decltype((void)E::HAS_MID)> { static constexpr bool value = E::HAS_MID; };
struct EpiResF32 {
    static constexpr bool PERM = false, AFTER_DRAIN = false;
    const float* base; float* out;
    __device__ __forceinline__ void operator()(const f32x4 (&acc)[2][2][4][2], const Unit& u, int wr, int wc, int fr, int fq) const {
        const int row0 = u.pm * BM + wr * 64 + fr, col0 = u.pn * BM + wc * 32 + 4 * fq;
#pragma unroll
        for (int ai = 0; ai < 2; ++ai)
#pragma unroll
            for (int m = 0; m < 4; ++m) { const size_t off = (size_t)(row0 + ai * HALF + m * 16) * 1024 + col0;
#pragma unroll
                for (int bj = 0; bj < 2; ++bj)
#pragma unroll
                    for (int n = 0; n < 2; ++n) { const f32x4 bs = *(const f32x4*)(base + off + bj * HALF + n * 16); *(f32x4*)(out + off + bj * HALF + n * 16) = bs + acc[ai][bj][m][n]; }
                if (m & 1) asm volatile("" ::: "memory"); }
    }
};
struct EpiResBf16 {
    static constexpr bool PERM = true, AFTER_DRAIN = false;
    const float* base; bf16_t* out;
    __device__ __forceinline__ void operator()(const f32x4 (&acc)[2][2][4][2], const Unit& u, int wr, int wc, int fr, int fq) const {
        const int row0 = u.pm * BM + wr * 64 + fr, col0 = u.pn * BM + wc * 32 + 8 * fq;
#pragma unroll
        for (int ai = 0; ai < 2; ++ai)
#pragma unroll
            for (int m = 0; m < 4; ++m) { const size_t off = (size_t)(row0 + ai * HALF + m * 16) * 1024 + col0;
#pragma unroll
                for (int bj = 0; bj < 2; ++bj) { const f32x4 x0 = *(const f32x4*)(base + off + bj * HALF), x1 = *(const f32x4*)(base + off + bj * HALF + 4);
                    const f32x4 v0 = acc[ai][bj][m][0] + x0, v1 = acc[ai][bj][m][1] + x1;
                    u32x4 w; w.x = cvt_pk_bf16(v0[0], v0[1]); w.y = cvt_pk_bf16(v0[2], v0[3]); w.z = cvt_pk_bf16(v1[0], v1[1]); w.w = cvt_pk_bf16(v1[2], v1[3]);
                    *(u32x4*)(out + off + bj * HALF) = w; }
                if (m == 3) asm volatile("" ::: "memory"); }
    }
};
template <bool STORE = true> struct EpiSwigluT {
    static constexpr bool PERM = true, AFTER_DRAIN = false;
    unsigned char* O;
    __device__ __forceinline__ void operator()(const f32x4 (&acc)[2][2][4][2], const Unit& u, int wr, int wc, int fr, int fq) const {
        const int row0 = u.pm * BM + wr * 64 + fr, col0 = u.pn * HALF + wc * 32 + 8 * fq;
#pragma unroll
        for (int ai = 0; ai < 2; ++ai)
#pragma unroll
            for (int m = 0; m < 4; ++m) { unsigned char* op = O + (size_t)(row0 + ai * HALF + m * 16) * 1024 + col0;
                typedef float f32x2 __attribute__((ext_vector_type(2)));
                f32x4 h0, h1;
#pragma unroll
                for (int n = 0; n < 2; ++n)
#pragma unroll
                    for (int q = 0; q < 4; q += 2) { const f32x2 gv = {acc[ai][0][m][n][q], acc[ai][0][m][n][q + 1]}, uv = {acc[ai][1][m][n][q], acc[ai][1][m][n][q + 1]};
                        const f32x2 ea = gv * (-1.4426950408889634f * F8_DEQ); f32x2 ex; ex.x = __builtin_amdgcn_exp2f(ea.x); ex.y = __builtin_amdgcn_exp2f(ea.y);
                        const f32x2 dn = ex + 1.0f; f32x2 rc; rc.x = __builtin_amdgcn_rcpf(dn.x); rc.y = __builtin_amdgcn_rcpf(dn.y);
                        const f32x2 hv = (gv * uv) * (rc * (F8_DEQ * F8_DEQ * F8_ACT_SCALE));
                        if (n == 0) { h0[q] = hv.x; h0[q + 1] = hv.y; } else { h1[q] = hv.x; h1[q + 1] = hv.y; } }
                typedef unsigned u32x2 __attribute__((ext_vector_type(2)));
                u32x2 w; w.x = pk4_fp8(h0[0], h0[1], h0[2], h0[3]); w.y = pk4_fp8(h1[0], h1[1], h1[2], h1[3]);
                if (STORE) *(u32x2*)op = w; else asm volatile("" :: "v"(w)); }
    }
};
typedef EpiSwigluT<true> EpiSwiglu;
struct EpiDown {
    static constexpr bool PERM = true, AFTER_DRAIN = false;
    unsigned char* O; const float* gv;
    __device__ __forceinline__ void operator()(const f32x4 (&acc)[2][2][4][2], const Unit& u, int wr, int wc, int fr, int fq) const {
        const int row0 = u.pm * BM + wr * 64 + fr, col0 = u.pn * BM + wc * 32 + 8 * fq;
        typedef unsigned u32x2 __attribute__((ext_vector_type(2)));
#pragma unroll
        for (int ai = 0; ai < 2; ++ai)
#pragma unroll
            for (int m = 0; m < 4; ++m) { const int row = row0 + ai * HALF + m * 16; const float gsc = gv[row] * (F8_DEQ * Y_SCALE); unsigned char* op = O + (size_t)row * 1024 + col0;
#pragma unroll
                for (int bj = 0; bj < 2; ++bj) { const f32x4 v0 = acc[ai][bj][m][0] * gsc, v1 = acc[ai][bj][m][1] * gsc;
                    u32x2 w; w.x = pk4_fp8(v0[0], v0[1], v0[2], v0[3]); w.y = pk4_fp8(v1[0], v1[1], v1[2], v1[3]);
                    *(u32x2*)(op + bj * HALF) = w; } }
    }
};

template <class Epi, class Sched, bool ALIGN_EPI = false, bool SP2 = false, bool FP8 = false, bool GATHER = false>
__device__ __forceinline__ void gemm_phase(PG8_LAS unsigned char* lds, const Gemm g, const Sched& S, const Epi& E) {
    const int tid = threadIdx.x, wid = __builtin_amdgcn_readfirstlane(tid >> 6), lane = tid & 63, wr = wid >> 2, wc = wid & 3, fr = lane & 15, fq = lane >> 4;
    const int K = g.K, nt = K / BK;
    unsigned voffA[2], voffB[2]; int rowA[2], colA2[2];
    static_assert(!GATHER || SP2, "the gathered-A path is written for the SP2 loop only");
#pragma unroll
    for (int i = 0; i < 2; ++i) { int R, C; stage_rc(tid * 16 + i * 8192, R, C); const int Rb = Epi::PERM ? ((R & ~31) + perm32(R & 31)) : R;
        voffA[i] = (unsigned)(R * g.lda + C) * 2u; voffB[i] = (unsigned)(Rb * g.ldb + C) * 2u; rowA[i] = R; colA2[i] = C * 2; }
    const size_t kstep = (size_t)(BK * 2);
    const size_t hstepA = (size_t)HALF * g.lda * 2, hstepB = (size_t)HALF * g.ldb * 2;
    const size_t tstepA = 2 * hstepA, tstepB = 2 * hstepB;
    const unsigned ldsw = (unsigned)wid * 1024u;
    const int aoff = lds_byte(wr * 64 + fr, fq * 8), boff = lds_byte(wc * 32 + fr, fq * 8);
#define PG8_SA(b, h) (((b) * 2 + (h)) * HTB)
#define PG8_SB(b, h) ((4 + (b) * 2 + (h)) * HTB)
#define PG8_STAGE(bufoff, gbase, voff) do { _Pragma("unroll") for (int _i = 0; _i < 2; ++_i) { unsigned vo_ = (voff)[_i]; asm volatile("" : "+v"(vo_));     \
        __builtin_amdgcn_global_load_lds((const unsigned*)((const char*)(gbase) + vo_), (PG8_LAS unsigned*)(lds + (bufoff) + ldsw + _i * 8192), 16, 0, 0); } } while (0)
#define PG8_LDA(dst, b, h) do { if constexpr (FP8) { _Pragma("unroll") for (int m = 0; m < 4; ++m) { const i32x4 lo_ = *(const PG8_LAS i32x4*)(lds + PG8_SA(b, h) + aoff + m * 2048), hi_ = *(const PG8_LAS i32x4*)(lds + PG8_SA(b, h) + aoff + m * 2048 + 1024); dst##8[m] = __builtin_shufflevector(lo_, hi_, 0, 1, 2, 3, 4, 5, 6, 7); } } \
        else { _Pragma("unroll") for (int m = 0; m < 4; ++m) _Pragma("unroll") for (int k = 0; k < 2; ++k) dst[m][k] = *(const PG8_LAS bf16x8*)(lds + PG8_SA(b, h) + aoff + m * 2048 + k * 1024); } } while (0)
#define PG8_LDB(dst, b, h) do { if constexpr (FP8) { _Pragma("unroll") for (int n = 0; n < 2; ++n) { const i32x4 lo_ = *(const PG8_LAS i32x4*)(lds + PG8_SB(b, h) + boff + n * 2048), hi_ = *(const PG8_LAS i32x4*)(lds + PG8_SB(b, h) + boff + n * 2048 + 1024); dst##8[n] = __builtin_shufflevector(lo_, hi_, 0, 1, 2, 3, 4, 5, 6, 7); } } \
        else { _Pragma("unroll") for (int n = 0; n < 2; ++n) _Pragma("unroll") for (int k = 0; k < 2; ++k) dst[n][k] = *(const PG8_LAS bf16x8*)(lds + PG8_SB(b, h) + boff + n * 2048 + k * 1024); } } while (0)
#define PG8_MMA(ai, bj, At, Bt) do { __builtin_amdgcn_s_setprio(1); _Pragma("unroll") for (int m = 0; m < 4; ++m) _Pragma("unroll") for (int n = 0; n < 2; ++n) { \
        if constexpr (FP8) { asm volatile("v_mfma_f32_16x16x128_f8f6f4 %0, %1, %2, %0" : "+v"(acc[ai][bj][m][n]) : "v"(Bt##8[n]), "v"(At##8[m])); }     \
        else { _Pragma("unroll") for (int k = 0; k < 2; ++k) acc[ai][bj][m][n] = __builtin_amdgcn_mfma_f32_16x16x32_bf16(Bt[n][k], At[m][k], acc[ai][bj][m][n], 0, 0, 0); } } \
        __builtin_amdgcn_s_setprio(0); } while (0)
#define PG8_WAIT_V(n) asm volatile("s_waitcnt vmcnt(" #n ")" ::: "memory")
#define PG8_WAIT_L(n) asm volatile("s_waitcnt lgkmcnt(" #n ")" ::: "memory")
#define PG8_BAR __builtin_amdgcn_s_barrier()
#define PG8_SCHED __builtin_amdgcn_sched_barrier(0)
    unsigned gcur[2][2] = {{0u, 0u}, {0u, 0u}}, gnxt[2][2] = {{0u, 0u}, {0u, 0u}}; int graw[2][2] = {{0, 0}, {0, 0}};
#define PG8_GIDX_ISSUE(U) do { _Pragma("unroll") for (int h_ = 0; h_ < 2; ++h_) _Pragma("unroll") for (int i_ = 0; i_ < 2; ++i_) { const unsigned bo_ = (unsigned)((U).pm * BM + h_ * HALF + rowA[i_]) * 4u; \
        asm volatile("global_load_dword %0, %1, %2" : "=v"(graw[h_][i_]) : "v"(bo_), "s"(g.gidx) : "memory"); } } while (0)
#define PG8_GIDX_CONV(dst, U) do { _Pragma("unroll") for (int h_ = 0; h_ < 2; ++h_) _Pragma("unroll") for (int i_ = 0; i_ < 2; ++i_) { asm volatile("" : "+v"(graw[h_][i_])); \
        dst[h_][i_] = (unsigned)(((U).pm >> 6) * 8192 + graw[h_][i_]) * (unsigned)(g.lda * 2) + (unsigned)colA2[i_]; } } while (0)
#define PG8_STAGE_A(bufoff, ptr, h, nx) do { if constexpr (GATHER) { PG8_STAGE(bufoff, ptr, ((nx) ? gsel[h] : gcur[h])); } else { PG8_STAGE(bufoff, (ptr) + ((h) ? hstepA : 0), voffA); } } while (0)
    Unit cur, nxt; int ui = 0;
    if (!S.next(0, cur)) return;
    if constexpr (GATHER) { PG8_GIDX_ISSUE(cur); asm volatile("s_waitcnt vmcnt(0)" ::: "memory"); PG8_GIDX_CONV(gcur, cur); }
    unsigned gsel[2][2] = {{0u, 0u}, {0u, 0u}};
    f32x4 acc[2][2][4][2];
#pragma unroll
    for (int a = 0; a < 2; ++a)
#pragma unroll
        for (int b = 0; b < 2; ++b)
#pragma unroll
            for (int m = 0; m < 4; ++m)
#pragma unroll
                for (int n = 0; n < 2; ++n) acc[a][b][m][n] = (f32x4){0.f, 0.f, 0.f, 0.f};
    bf16x8 At[4][2], B0[2][2], B1[2][2];
    i32x8 At8[4], B08[2], B18[2];
    const char* cA = (const char*)g.A + (GATHER ? (size_t)0 : (size_t)cur.pm * tstepA); const char* cB = (const char*)g.Bt + (size_t)cur.pb * tstepB;
    S.a_ready(cur);
    if constexpr (SP2) {
        PG8_STAGE(PG8_SB(0, 0), cB, voffB); PG8_STAGE(PG8_SB(0, 1), cB + hstepB, voffB); PG8_STAGE_A(PG8_SA(0, 0), cA, 0, false); PG8_STAGE_A(PG8_SA(0, 1), cA, 1, false);
        if (wr == 1) PG8_BAR;
        PG8_WAIT_V(2); PG8_BAR;
        PG8_STAGE(PG8_SB(1, 0), cB + kstep, voffB); PG8_STAGE_A(PG8_SA(1, 0), cA + kstep, 0, false); PG8_STAGE(PG8_SB(1, 1), cB + hstepB + kstep, voffB);
        PG8_WAIT_V(6); PG8_BAR;
    } else {
        PG8_STAGE(PG8_SB(0, 0), cB, voffB); PG8_STAGE(PG8_SA(0, 0), cA, voffA); PG8_STAGE(PG8_SB(0, 1), cB + hstepB, voffB); PG8_STAGE(PG8_SA(0, 1), cA + hstepA, voffA);
        if (wr == 1) PG8_BAR;
        PG8_WAIT_V(4); PG8_BAR;
        PG8_STAGE(PG8_SB(1, 0), cB + kstep, voffB); PG8_STAGE(PG8_SA(1, 0), cA + kstep, voffA); PG8_STAGE(PG8_SB(1, 1), cB + hstepB + kstep, voffB);
        PG8_WAIT_V(6); PG8_BAR;
    }
    for (;;) {
        const bool has_next = S.next(ui + 1, nxt);
        if constexpr (GATHER) { if (has_next) PG8_GIDX_ISSUE(nxt); }
        const char* nA = has_next ? (const char*)g.A + (GATHER ? (size_t)0 : (size_t)nxt.pm * tstepA) : cA; const char* nB = has_next ? (const char*)g.Bt + (size_t)nxt.pb * tstepB : cB;
#pragma unroll 1
        for (int t = 0; t < nt; t += 2) {
            const bool last = (t == nt - 2);
            const char* a1 = cA + (size_t)(t + 1) * kstep;
            const char* a2 = last ? nA : cA + (size_t)(t + 2) * kstep; const char* b2 = last ? nB : cB + (size_t)(t + 2) * kstep;
            const char* a3 = a2 + kstep; const char* b3 = b2 + kstep;
            if (last && has_next) S.a_ready(nxt);
            if constexpr (GATHER) { if (last) { if (has_next) { PG8_GIDX_CONV(gnxt, nxt); } else { _Pragma("unroll") for (int h_ = 0; h_ < 2; ++h_) _Pragma("unroll") for (int i_ = 0; i_ < 2; ++i_) gnxt[h_][i_] = gcur[h_][i_]; } }
                _Pragma("unroll") for (int h_ = 0; h_ < 2; ++h_) _Pragma("unroll") for (int i_ = 0; i_ < 2; ++i_) gsel[h_][i_] = last ? gnxt[h_][i_] : gcur[h_][i_]; }
            if constexpr (SP2) {
            PG8_LDB(B0, 0, 0); PG8_LDB(B1, 0, 1); PG8_SCHED; PG8_LDA(At, 0, 0); PG8_STAGE_A(PG8_SA(1, 1), a1, 1, false);
            PG8_WAIT_V(8); PG8_WAIT_L(0); PG8_BAR; PG8_MMA(0, 0, At, B0); PG8_MMA(0, 1, At, B1); PG8_BAR; PG8_SCHED;
            PG8_LDA(At, 0, 1); PG8_STAGE(PG8_SB(0, 0), b2, voffB); PG8_STAGE(PG8_SB(0, 1), b2 + hstepB, voffB); PG8_STAGE_A(PG8_SA(0, 0), a2, 0, true);
            PG8_WAIT_V(8); PG8_WAIT_L(0); PG8_BAR; PG8_MMA(1, 0, At, B0); PG8_MMA(1, 1, At, B1); PG8_BAR; PG8_SCHED;
            PG8_LDB(B0, 1, 0); PG8_LDB(B1, 1, 1); PG8_SCHED; PG8_LDA(At, 1, 0); PG8_STAGE_A(PG8_SA(0, 1), a2, 1, true);
            PG8_WAIT_V(8); PG8_WAIT_L(0); PG8_BAR; PG8_MMA(0, 0, At, B0); PG8_MMA(0, 1, At, B1); PG8_BAR; PG8_SCHED;
            PG8_LDA(At, 1, 1); PG8_STAGE(PG8_SB(1, 0), b3, voffB); PG8_STAGE(PG8_SB(1, 1), b3 + hstepB, voffB); PG8_STAGE_A(PG8_SA(1, 0), a3, 0, true);
            PG8_WAIT_V(8); PG8_WAIT_L(0); PG8_BAR; PG8_MMA(1, 0, At, B0); PG8_MMA(1, 1, At, B1); PG8_BAR; PG8_SCHED;
            if constexpr (epi_has_mid<Epi>::value) { if (t + 2 == Epi::MID_KT) E.mid(acc, cur, wr, wc, fr, fq); }
            } else {
            PG8_LDB(B0, 0, 0); PG8_SCHED; PG8_LDA(At, 0, 0); PG8_STAGE(PG8_SA(1, 1), a1 + hstepA, voffA);
            PG8_WAIT_L(8); PG8_BAR; PG8_WAIT_L(0); PG8_MMA(0, 0, At, B0); PG8_BAR; PG8_SCHED;
            PG8_LDB(B1, 0, 1); PG8_STAGE(PG8_SB(0, 0), b2, voffB);
            PG8_BAR; PG8_WAIT_L(0); PG8_MMA(0, 1, At, B1); PG8_BAR;
            PG8_LDA(At, 0, 1); PG8_STAGE(PG8_SA(0, 0), a2, voffA);
            PG8_BAR; PG8_WAIT_L(0); PG8_MMA(1, 0, At, B0); PG8_BAR; PG8_SCHED;
            PG8_STAGE(PG8_SB(0, 1), b2 + hstepB, voffB);
            PG8_WAIT_V(6); PG8_BAR; PG8_MMA(1, 1, At, B1); PG8_BAR;
            PG8_LDB(B0, 1, 0); PG8_SCHED; PG8_LDA(At, 1, 0); PG8_STAGE(PG8_SA(0, 1), a2 + hstepA, voffA);
            PG8_WAIT_L(8); PG8_BAR; PG8_WAIT_L(0); PG8_MMA(0, 0, At, B0); PG8_BAR; PG8_SCHED;
            PG8_LDB(B1, 1, 1); PG8_STAGE(PG8_SB(1, 0), b3, voffB);
            PG8_BAR; PG8_WAIT_L(0); PG8_MMA(0, 1, At, B1); PG8_BAR;
            PG8_LDA(At, 1, 1); PG8_STAGE(PG8_SA(1, 0), a3, voffA);
            PG8_BAR; PG8_WAIT_L(0); PG8_MMA(1, 0, At, B0); PG8_BAR; PG8_SCHED;
            PG8_STAGE(PG8_SB(1, 1), b3 + hstepB, voffB);
            PG8_WAIT_V(6); PG8_BAR; PG8_MMA(1, 1, At, B1); PG8_BAR;
            }
        }
        if constexpr (ALIGN_EPI) { if (wr == 0) PG8_BAR; }
        if constexpr (FP8) {
            asm volatile("s_nop 15\n\ts_nop 15" ::: "memory");
#pragma unroll
            for (int a = 0; a < 2; ++a)
#pragma unroll
                for (int b = 0; b < 2; ++b)
#pragma unroll
                    for (int m = 0; m < 4; ++m)
#pragma unroll
                        for (int n = 0; n < 2; ++n) asm volatile("" : "+v"(acc[a][b][m][n]));
        }
        if constexpr (!Epi::AFTER_DRAIN) { E(acc, cur, wr, wc, fr, fq); S.done(cur); }
        if (!has_next) break;
#pragma unroll
        for (int a = 0; a < 2; ++a)
#pragma unroll
            for (int b = 0; b < 2; ++b)
#pragma unroll
                for (int m = 0; m < 4; ++m)
#pragma unroll
                    for (int n = 0; n < 2; ++n) acc[a][b][m][n] = (f32x4){0.f, 0.f, 0.f, 0.f};
        cur = nxt; cA = nA; cB = nB; ++ui;
        if constexpr (GATHER) { _Pragma("unroll") for (int h_ = 0; h_ < 2; ++h_) _Pragma("unroll") for (int i_ = 0; i_ < 2; ++i_) gcur[h_][i_] = gnxt[h_][i_]; }
        if constexpr (ALIGN_EPI) { if (wr == 1) PG8_BAR; }
    }
    PG8_WAIT_V(0);
    if constexpr (!ALIGN_EPI) { if (wr == 0) PG8_BAR; }
    PG8_BAR;
    if constexpr (Epi::AFTER_DRAIN) { E.fused(acc, cur, wr, wc, fr, fq, lds, wid, lane); S.done(cur); }
#undef PG8_SA
#undef PG8_SB
#undef PG8_STAGE
#undef PG8_LDA
#undef PG8_LDB
#undef PG8_MMA
#undef PG8_WAIT_V
#undef PG8_WAIT_L
#undef PG8_BAR
#undef PG8_SCHED
#undef PG8_GIDX_ISSUE
#undef PG8_GIDX_CONV
#undef PG8_STAGE_A
}
}
#include <hip/hip_bf16.h>
#include <cmath>
namespace attn_body {
using bf16=__hip_bfloat16;
using bf16x8=__attribute__((ext_vector_type(8)))short;
using s16x4=__attribute__((ext_vector_type(4)))short;
using f32x16=__attribute__((ext_vector_type(16)))float;
using u32x4=__attribute__((ext_vector_type(4)))unsigned;
constexpr int BATCH=8,NHEAD=8,NKVH=2,SEQ=8192,D=64,QP=512,KVP=256,OP=768;
constexpr int NW=8,QBLK=32,QB=QBLK*NW,KVBLK=64,NQB=SEQ/QB;
constexpr int ATTN_UNIT_ROWS=QB;
__device__ __forceinline__ int crow(int r,int hi){return (r&3)+8*(r>>2)+4*hi;}
#define SBAR() __builtin_amdgcn_sched_barrier(0)
__device__ __forceinline__ void cmask(f32x16&p0,f32x16&p1,int jb,int qrel,int hi){
  const float NEG=-INFINITY; int kb=64*jb+4*hi;
  #pragma unroll
  for(int r=0;r<16;++r){int kv=kb+(r&3)+8*(r>>2); if(kv>qrel)p0[r]=NEG; if(kv+32>qrel)p1[r]=NEG;}
}

constexpr int NSLOT=3, SLOTB=8192;
constexpr int LDS_K=0, LDS_V=NSLOT*SLOTB, LDS_WS=2*NSLOT*SLOTB, LDS_OST=LDS_WS+NW*64*4, LDS_BYTES=LDS_OST+NW*4096;
constexpr float C2=0.125f*1.4426950408889634f;
__device__ __forceinline__ void glds16(const void*gsrc,unsigned lds_dst){unsigned keep;
  asm volatile("s_mov_b32 %0, m0\n\ts_mov_b32 m0, %2\n\ts_nop 0\n\tglobal_load_lds_dwordx4 %1, off\n\ts_mov_b32 m0, %0":"=&s"(keep):"v"(gsrc),"s"(lds_dst):"memory");}
__device__ __forceinline__ float max3f(float a,float b,float c){float r;asm("v_max3_f32 %0, %1, %2, %3":"=v"(r):"v"(a),"v"(b),"v"(c));return r;}
__device__ __forceinline__ float max2f(float a,float b){float r;asm("v_max_f32_e32 %0, %1, %2":"=v"(r):"v"(a),"v"(b));return r;}
__device__ __forceinline__ float fadd_s(float a,float b){float r;asm("v_add_f32_e32 %0, %1, %2":"=v"(r):"v"(a),"v"(b));return r;}
__device__ __forceinline__ float fsub_s(float a,float b){float r;asm("v_sub_f32_e32 %0, %1, %2":"=v"(r):"v"(a),"v"(b));return r;}
typedef float f32x2_t __attribute__((ext_vector_type(2))); typedef __bf16 bf16x2_t __attribute__((ext_vector_type(2)));
__device__ __forceinline__ unsigned cvtpk_s(float lo,float hi){f32x2_t v={lo,hi};bf16x2_t b=__builtin_convertvector(v,bf16x2_t);return __builtin_bit_cast(unsigned,b);}
#define WAIT_BAR(N) asm volatile("s_waitcnt vmcnt(" #N ") lgkmcnt(0)\n\ts_barrier":::"memory")

__device__ __forceinline__ void qkt(f32x16&p0,f32x16&p1,const char*Kslot,const bf16x8*qr,const f32x16&negm,int r32,int hi){
  const char*kb=Kslot+hi*1024+r32*16;
  #pragma unroll
  for(int d0=0;d0<4;++d0){
    const bf16x8 b0=*reinterpret_cast<const bf16x8*>(kb+d0*2048);
    const bf16x8 b1=*reinterpret_cast<const bf16x8*>(kb+d0*2048+512);
    if(d0==0){p0=__builtin_amdgcn_mfma_f32_32x32x16_bf16(b0,qr[0],negm,0,0,0);p1=__builtin_amdgcn_mfma_f32_32x32x16_bf16(b1,qr[0],negm,0,0,0);}
    else{p0=__builtin_amdgcn_mfma_f32_32x32x16_bf16(b0,qr[d0],p0,0,0,0);p1=__builtin_amdgcn_mfma_f32_32x32x16_bf16(b1,qr[d0],p1,0,0,0);}}
}
typedef __attribute__((address_space(3))) const char* lds_cptr;
typedef short v4i16_t __attribute__((ext_vector_type(4)));
__device__ __forceinline__ void kload8(bf16x8*kf,lds_cptr kp){
  kf[0]=*(const __attribute__((address_space(3))) bf16x8*)(kp);      kf[1]=*(const __attribute__((address_space(3))) bf16x8*)(kp+512);
  kf[2]=*(const __attribute__((address_space(3))) bf16x8*)(kp+2048); kf[3]=*(const __attribute__((address_space(3))) bf16x8*)(kp+2560);
  kf[4]=*(const __attribute__((address_space(3))) bf16x8*)(kp+4096); kf[5]=*(const __attribute__((address_space(3))) bf16x8*)(kp+4608);
  kf[6]=*(const __attribute__((address_space(3))) bf16x8*)(kp+6144); kf[7]=*(const __attribute__((address_space(3))) bf16x8*)(kp+6656);
}
__device__ __forceinline__ void kload2(bf16x8*kf,lds_cptr kp,int j){ kf[2*j]=*(const __attribute__((address_space(3))) bf16x8*)(kp+j*2048); kf[2*j+1]=*(const __attribute__((address_space(3))) bf16x8*)(kp+j*2048+512); }
__device__ __forceinline__ s16x4 vtr(lds_cptr p){ return __builtin_bit_cast(s16x4,__builtin_amdgcn_ds_read_tr16_b64_v4i16((__attribute__((address_space(3))) v4i16_t*)p)); }
__device__ __forceinline__ float rowmax(const f32x16&p0,const f32x16&p1){
  float a=max3f(p0[0],p0[1],p1[0]),b=max3f(p0[2],p0[3],p1[1]);a=max3f(a,p1[2],p1[3]);
  #pragma unroll
  for(int r=4;r<16;r+=4){a=max3f(a,p0[r],p0[r+1]);b=max3f(b,p0[r+2],p0[r+3]);a=max3f(a,p1[r],p1[r+1]);b=max3f(b,p1[r+2],p1[r+3]);}
  const float m=max2f(a,b);
  auto rr=__builtin_amdgcn_permlane32_swap(__float_as_uint(m),__float_as_uint(m),false,false);
  return max2f(__uint_as_float(rr[0]),__uint_as_float(rr[1]));
}
__device__ __forceinline__ void pv(f32x16*o,int vb,bf16x8 pa0,bf16x8 pa1,bf16x8 pa2,bf16x8 pa3){
  #pragma unroll
  for(int d0=0;d0<2;++d0){s16x4 lo[4],hi[4];
    #pragma unroll
    for(int ks=0;ks<4;++ks){
      asm volatile("ds_read_b64_tr_b16 %0,%1 offset:%c2":"=&v"(lo[ks]):"v"(vb),"i"(d0*4096+ks*1024):"memory");
      asm volatile("ds_read_b64_tr_b16 %0,%1 offset:%c2":"=&v"(hi[ks]):"v"(vb),"i"(d0*4096+ks*1024+512):"memory");}
    asm volatile("s_waitcnt lgkmcnt(0)":::"memory");SBAR();
    #define PK(k) (bf16x8){lo[k][0],lo[k][1],lo[k][2],lo[k][3],hi[k][0],hi[k][1],hi[k][2],hi[k][3]}
    o[d0]=__builtin_amdgcn_mfma_f32_32x32x16_bf16(pa0,PK(0),o[d0],0,0,0);
    o[d0]=__builtin_amdgcn_mfma_f32_32x32x16_bf16(pa1,PK(1),o[d0],0,0,0);
    o[d0]=__builtin_amdgcn_mfma_f32_32x32x16_bf16(pa2,PK(2),o[d0],0,0,0);
    o[d0]=__builtin_amdgcn_mfma_f32_32x32x16_bf16(pa3,PK(3),o[d0],0,0,0);
    #undef PK
  }
}

#ifndef ATTN_STORE16
#define ATTN_STORE16(p,v) (*(u32x4*)(p)=(v))
#endif
template<int THRL,bool FIXREF> __device__ __forceinline__ void attn_unit(int b,int h,int qb,const bf16*Q,const bf16*__restrict__ K,const bf16*__restrict__ V,bf16*O,char*shm,float cref){
  const int tid=threadIdx.x,lane=tid&63,r32=lane&31,hi=lane>>5; const int wid=__builtin_amdgcn_readfirstlane(tid>>6);
  const long rowbase=(long)b*SEQ; const int q0=qb*QB;
  const bf16*Qw=Q+(rowbase+q0+wid*QBLK)*QP+h*D;
  const bf16*Kh=K+rowbase*KVP+(h>>2)*D,*Vh=V+rowbase*KVP+(h>>2)*D;
  const unsigned lds0=(unsigned)(uintptr_t)shm;
  float*wsf=(float*)(shm+LDS_WS)+wid*64;
  const bf16*ksrc=Kh+(long)lane*KVP+wid*8;
  const bf16*vsrc=Vh+(long)(16*(wid&3)+(lane>>2))*KVP+(wid>>2)*32+(lane&3)*8;
  const unsigned kdst=lds0+LDS_K+wid*1024, vdst=lds0+LDS_V+wid*1024;
  #define DMA_K(t,slot) glds16(ksrc+(long)(t)*KVBLK*KVP,(unsigned)__builtin_amdgcn_readfirstlane(kdst+(slot)))
  #define DMA_V(t,slot) glds16(vsrc+(long)(t)*KVBLK*KVP,(unsigned)__builtin_amdgcn_readfirstlane(vdst+(slot)))
  const int vb0=(int)(lds0+LDS_V)+((lane>>4)&1)*32+(lane&3)*8+(4*hi+((lane&15)>>2))*64;
  const char*Kbase=shm+LDS_K; bf16x8 kf[8];
  const lds_cptr shm3=(lds_cptr)shm; const lds_cptr kp0=shm3+LDS_K+hi*1024+r32*16; const lds_cptr vp0=shm3+LDS_V+((lane>>4)&1)*32+(lane&3)*8+(4*hi+((lane&15)>>2))*64;
  const int NT=SEQ/KVBLK;
  DMA_K(0,0);DMA_V(0,0);DMA_K(1,SLOTB);
  bf16x8 qr[4];
  #pragma unroll
  for(int d0=0;d0<4;++d0)qr[d0]=*reinterpret_cast<const bf16x8*>(&Qw[(long)r32*QP+d0*16+hi*8]);
  float mhat=0.f,l_reg=0.f;f32x16 o[2];o[0]=f32x16{};o[1]=f32x16{};f32x16 negm=f32x16{};
  if constexpr(FIXREF){ _Pragma("unroll") for(int r=0;r<16;++r)negm[r]=-cref; }
  asm volatile("":"+v"(negm));
    #define CMASK(P0,P1,t) do{}while(0)
  bool resc=false;
  #define START(P0,P1) do{ resc=false; if constexpr(!FIXREF) \
    { const float rm=rowmax(P0,P1); const float dl=rm; mhat=fadd_s(mhat,dl); \
      _Pragma("unroll") for(int r=0;r<16;++r){P0[r]=fsub_s(P0[r],dl);P1[r]=fsub_s(P1[r],dl);} \
      _Pragma("unroll") for(int r=0;r<16;++r)negm[r]=-mhat; asm volatile("":"+v"(negm)); } \
    _Pragma("unroll") for(int r=0;r<16;++r)P0[r]=__builtin_amdgcn_exp2f(P0[r]); }while(0)
  #define RESC() do{ if(resc){ asm volatile("s_waitcnt lgkmcnt(0)":::"memory"); \
      _Pragma("unroll") for(int d_=0;d_<2;++d_) _Pragma("unroll") for(int r=0;r<16;++r)o[d_][r]*=wsf[crow(r,hi)]; } }while(0)
  f32x16 pA0,pA1,pB0,pB1;
  int sl_prev=0,sl_cur=0,sl_next=SLOTB;
  #define ROT() do{sl_prev=sl_cur;sl_cur=sl_next;sl_next=(sl_next==(NSLOT-1)*SLOTB)?0:sl_next+SLOTB;}while(0)
  DMA_K(2,2*SLOTB);
  WAIT_BAR(3);
  qkt(pA0,pA1,Kbase,qr,negm,r32,hi);asm volatile("s_nop 15\n\ts_nop 7":"+v"(pA0),"+v"(pA1));CMASK(pA0,pA1,0);
  START(pA0,pA1);
  _Pragma("unroll") for(int r=0;r<16;++r)pA1[r]=__builtin_amdgcn_exp2f(pA1[r]);
  WAIT_BAR(0);
  DMA_K(3,0);DMA_V(1,SLOTB);
  ROT();
  kload8(kf,kp0+sl_cur);
  WAIT_BAR(2);
  s16x4 vlo[8],vhi[8]; u32x4 pw0,pw1,pw2,pw3;
  #define PKW(P,B) cvtpk_s(P[B],P[B+1])
  #define PAF(k) __builtin_bit_cast(bf16x8,pw##k)
  #define VFR(i) (bf16x8){vlo[i][0],vlo[i][1],vlo[i][2],vlo[i][3],vhi[i][0],vhi[i][1],vhi[i][2],vhi[i][3]}
  #define PIN(x) asm volatile("":"+v"(x))
  #define MX3(a,b,c) __builtin_fmaxf(__builtin_fmaxf((a),(b)),(c))
  #define GAPA(MF,A0,A1,A2,A3,W0,W1,PW) do{ MF; sacc+=A0; sacc+=A1; sacc+=A2; sacc+=A3; PIN(sacc); W0; W1; PIN(PW); SBAR(); }while(0)
  #define EX(v) __builtin_amdgcn_exp2f(v)
  #define GAPB(MF,X,B) do{ MF; X[B]=EX(X[B]); X[B+1]=EX(X[B+1]); X[B+2]=EX(X[B+2]); X[B+3]=EX(X[B+3]); PIN(X); SBAR(); }while(0)
  #define VRD(i) do{ vlo[i]=vtr(vp_+(((i)>>2)*4096+((i)&3)*1024)); vhi[i]=vtr(vp_+(((i)>>2)*4096+((i)&3)*1024+512)); }while(0)
  #define KRD(G,j) do{ if(G){ kload2(kf,kp0+sl_next,j); SBAR(); } }while(0)
  #define STEP(C0,C1,P0,P1,t,GK,GV,GL) do{ SBAR(); \
    const lds_cptr vp_=vp0+sl_prev; \
    VRD(0); SBAR(); float sacc=(P0[0]+P0[1]); \
    GAPA(C0=__builtin_amdgcn_mfma_f32_32x32x16_bf16(kf[0],qr[0],negm,0,0,0), P0[2],P0[3],P0[4],P0[5],     pw0[0]=PKW(P0,0), pw0[1]=PKW(P0,2), pw0); \
    VRD(4); SBAR(); GAPA(C1=__builtin_amdgcn_mfma_f32_32x32x16_bf16(kf[1],qr[0],negm,0,0,0), P0[6],P0[7],P0[8],P0[9],     pw0[2]=PKW(P0,4), pw0[3]=PKW(P0,6), pw0); \
    VRD(1); SBAR(); GAPA(C0=__builtin_amdgcn_mfma_f32_32x32x16_bf16(kf[2],qr[1],C0,0,0,0),   P0[10],P0[11],P0[12],P0[13], pw1[0]=PKW(P0,8), pw1[1]=PKW(P0,10), pw1); \
    VRD(5); SBAR(); GAPA(C1=__builtin_amdgcn_mfma_f32_32x32x16_bf16(kf[3],qr[1],C1,0,0,0),   P0[14],P0[15],P1[0],P1[1],   pw1[2]=PKW(P0,12),pw1[3]=PKW(P0,14), pw1); \
    VRD(2); SBAR(); GAPA(C0=__builtin_amdgcn_mfma_f32_32x32x16_bf16(kf[4],qr[2],C0,0,0,0),   P1[2],P1[3],P1[4],P1[5],     pw2[0]=PKW(P1,0), pw2[1]=PKW(P1,2), pw2); \
    VRD(6); SBAR(); GAPA(C1=__builtin_amdgcn_mfma_f32_32x32x16_bf16(kf[5],qr[2],C1,0,0,0),   P1[6],P1[7],P1[8],P1[9],     pw2[2]=PKW(P1,4), pw2[3]=PKW(P1,6), pw2); \
    VRD(3); SBAR(); GAPA(C0=__builtin_amdgcn_mfma_f32_32x32x16_bf16(kf[6],qr[3],C0,0,0,0),   P1[10],P1[11],P1[12],P1[13], pw3[0]=PKW(P1,8), pw3[1]=PKW(P1,10), pw3); \
    VRD(7); SBAR(); GAPA(C1=__builtin_amdgcn_mfma_f32_32x32x16_bf16(kf[7],qr[3],C1,0,0,0),   P1[14],P1[15],0.f,0.f,       pw3[2]=PKW(P1,12),pw3[3]=PKW(P1,14), pw3); \
    l_reg+=sacc; \
    if(GK){DMA_K((t)+3,sl_cur);} if(GV){DMA_V((t)+1,sl_next);} \
    CMASK(C0,C1,t); \
    if constexpr(!FIXREF){ float a=MX3(C0[0],C0[1],C1[0]),b=MX3(C0[2],C0[3],C1[1]); a=MX3(a,C1[2],C1[3]); \
      _Pragma("unroll") for(int r=4;r<16;r+=4){a=MX3(a,C0[r],C0[r+1]);b=MX3(b,C0[r+2],C0[r+3]);a=MX3(a,C1[r],C1[r+1]);b=MX3(b,C1[r+2],C1[r+3]);} \
      float rm=__builtin_fmaxf(a,b); { auto rr=__builtin_amdgcn_permlane32_swap(__float_as_uint(rm),__float_as_uint(rm),false,false); rm=__builtin_fmaxf(__uint_as_float(rr[0]),__uint_as_float(rr[1])); } \
      resc=false; \
      if(__builtin_expect(__any(rm>(float)THRL),0)){ const float dl=__builtin_fmaxf(rm,0.f); mhat+=dl; \
        _Pragma("unroll") for(int r=0;r<16;++r){C0[r]-=dl;C1[r]-=dl;} \
        _Pragma("unroll") for(int r=0;r<16;++r)negm[r]=-mhat; asm volatile("":"+v"(negm)); \
        const float f=__builtin_amdgcn_exp2f(-dl); l_reg*=f; if(hi==0)wsf[r32]=f; resc=true; } } \
    SBAR(); \
    GAPB(o[0]=__builtin_amdgcn_mfma_f32_32x32x16_bf16(PAF(0),VFR(0),o[0],0,0,0), C0,0); \
    GAPB(o[1]=__builtin_amdgcn_mfma_f32_32x32x16_bf16(PAF(0),VFR(4),o[1],0,0,0), C0,4); \
    KRD(GL,0); GAPB(o[0]=__builtin_amdgcn_mfma_f32_32x32x16_bf16(PAF(1),VFR(1),o[0],0,0,0), C0,8); \
    KRD(GL,1); GAPB(o[1]=__builtin_amdgcn_mfma_f32_32x32x16_bf16(PAF(1),VFR(5),o[1],0,0,0), C0,12); \
    KRD(GL,2); GAPB(o[0]=__builtin_amdgcn_mfma_f32_32x32x16_bf16(PAF(2),VFR(2),o[0],0,0,0), C1,0); \
    KRD(GL,3); GAPB(o[1]=__builtin_amdgcn_mfma_f32_32x32x16_bf16(PAF(2),VFR(6),o[1],0,0,0), C1,4); \
    GAPB(o[0]=__builtin_amdgcn_mfma_f32_32x32x16_bf16(PAF(3),VFR(3),o[0],0,0,0), C1,8); \
    GAPB(o[1]=__builtin_amdgcn_mfma_f32_32x32x16_bf16(PAF(3),VFR(7),o[1],0,0,0), C1,12); \
    }while(0)
  int t=1;
  #undef CMASK
  #define CMASK(P0,P1,t) do{}while(0)
  for(;t+5<NT;t+=2){
    STEP(pB0,pB1,pA0,pA1,t,true,true,true);     WAIT_BAR(2); RESC(); ROT();
    STEP(pA0,pA1,pB0,pB1,t+1,true,true,true);   WAIT_BAR(2); RESC(); ROT();
  }
  #undef CMASK
  #define CMASK(P0,P1,t) do{}while(0)
  #define ENDW(tt) do{ if((tt)+3<NT){WAIT_BAR(2);} else if((tt)+2<NT){WAIT_BAR(1);} else {WAIT_BAR(0);} }while(0)
  for(;t+1<NT;t+=2){
    STEP(pB0,pB1,pA0,pA1,t,(t+3<NT),(t+1<NT),(t+1<NT));       ENDW(t);   RESC(); ROT();
    STEP(pA0,pA1,pB0,pB1,t+1,(t+4<NT),(t+2<NT),(t+2<NT));     ENDW(t+1); RESC(); ROT();
  }
  STEP(pB0,pB1,pA0,pA1,NT-1,false,false,false); RESC();
  { float sacc=pB0[0]+pB0[1]; _Pragma("unroll") for(int r=2;r<16;++r)sacc+=pB0[r]; _Pragma("unroll") for(int r=0;r<16;++r)sacc+=pB1[r]; l_reg+=sacc;
    pw0=(u32x4){PKW(pB0,0),PKW(pB0,2),PKW(pB0,4),PKW(pB0,6)};pw1=(u32x4){PKW(pB0,8),PKW(pB0,10),PKW(pB0,12),PKW(pB0,14)};pw2=(u32x4){PKW(pB1,0),PKW(pB1,2),PKW(pB1,4),PKW(pB1,6)};pw3=(u32x4){PKW(pB1,8),PKW(pB1,10),PKW(pB1,12),PKW(pB1,14)};
    SBAR(); pv(o,vb0+sl_cur,PAF(0),PAF(1),PAF(2),PAF(3)); }
  #undef PKW
  #undef PAF
  #undef VFR
  #undef PIN
  #undef MX3
  #undef GAPA
  #undef GAPB
  #undef EX
  #undef VRD
  #undef KRD
  #undef STEP
  #undef ENDW
  {auto rr=__builtin_amdgcn_permlane32_swap(__float_as_uint(l_reg),__float_as_uint(l_reg),false,false);l_reg=__uint_as_float(rr[0])+__uint_as_float(rr[1]);}
  if(hi==0)wsf[32+r32]=l_reg;asm volatile("s_waitcnt lgkmcnt(0)":::"memory");
  float rli[16];
  #pragma unroll
  for(int r=0;r<16;++r)rli[r]=__builtin_amdgcn_rcpf(wsf[32+crow(r,hi)]);
  bf16*Ow=O+(rowbase+q0+wid*QBLK)*OP+h*D;
  { bf16*stg=(bf16*)(shm+LDS_OST)+wid*2048;
    #pragma unroll
    for(int r=0;r<16;++r){const int orow=crow(r,hi);
      #pragma unroll
      for(int d0=0;d0<2;++d0)stg[orow*64+d0*32+r32]=__float2bfloat16(o[d0][r]*rli[r]);}
    asm volatile("s_waitcnt lgkmcnt(0)":::"memory");
    #pragma unroll
    for(int i=0;i<4;++i){const int row=i*8+(lane>>3),ch=lane&7; const u32x4 v=*(const u32x4*)(stg+row*64+ch*8); ATTN_STORE16(Ow+(long)row*OP+ch*8,v);} }
  asm volatile("s_waitcnt lgkmcnt(0)\n\ts_barrier":::"memory");
  #undef DMA_K
  #undef DMA_V
  #undef CMASK
  #undef START
  #undef RESC
  #undef ROT
}
constexpr int ATTN_LDS_BYTES=LDS_BYTES;
struct AttnTensors { const bf16* Q; const bf16* K; const bf16* V; bf16* O; };
struct AttnUnit { int b; int h; int qb; };
struct StaticOrder {
  int vcu, G;
  __device__ __forceinline__ StaticOrder(int grid,int vcu_):vcu(vcu_),G(grid){}
  __device__ __forceinline__ bool next(int i,AttnUnit&u)const{ const int L=i*G+vcu; if(L>=BATCH*NHEAD*NQB)return false;
    const int rnd=L>>8, x=(L>>5)&7, w=L&31; const int pair=x*2+(rnd>>2); const int uu=(rnd&3)*32+w;
    u.b=pair>>1; u.h=(pair&1)*4+(uu>>5); u.qb=uu&31; return true; }
};
template<class Sched,int THRL=8> __device__ __forceinline__ void attn_phase(char*lds,const AttnTensors&T,const Sched&S,float cref){
  AttnUnit u;
  for(int i=0;S.next(i,u);++i){ attn_unit<THRL,true>(u.b,u.h,u.qb,T.Q,T.K,T.V,T.O,lds,cref); }
}
#undef SBAR
#undef WAIT_BAR
}
namespace attnb {
using attn_body::bf16; using attn_body::bf16x8; using attn_body::s16x4; using attn_body::f32x16; using attn_body::u32x4; using attn_body::lds_cptr;
using attn_body::crow; using attn_body::glds16; using attn_body::cvtpk_s; using attn_body::kload8;
constexpr int SEQ = 8192, PB = 768, OP = 768, OCOL = 512;
#define ATB_MX3(a,b,c) __builtin_fmaxf(__builtin_fmaxf((a),(b)),(c))
__device__ __forceinline__ void pvb(f32x16*o,int vb,bf16x8 pa0,bf16x8 pa1,bf16x8 pa2,bf16x8 pa3){
  #pragma unroll
  for(int d0=0;d0<2;++d0){s16x4 lo[4],hi[4];
    #pragma unroll
    for(int ks=0;ks<4;++ks){
      asm volatile("ds_read_b64_tr_b16 %0,%1 offset:%c2":"=&v"(lo[ks]):"v"(vb),"i"(d0*4096+ks*1024):"memory");
      asm volatile("ds_read_b64_tr_b16 %0,%1 offset:%c2":"=&v"(hi[ks]):"v"(vb),"i"(d0*4096+ks*1024+512):"memory");}
    asm volatile("s_waitcnt lgkmcnt(0)":::"memory");__builtin_amdgcn_sched_barrier(0);
    #define ATB_PK(k) (bf16x8){lo[k][0],lo[k][1],lo[k][2],lo[k][3],hi[k][0],hi[k][1],hi[k][2],hi[k][3]}
    o[d0]=__builtin_amdgcn_mfma_f32_32x32x16_bf16(pa0,ATB_PK(0),o[d0],0,0,0);
    o[d0]=__builtin_amdgcn_mfma_f32_32x32x16_bf16(pa1,ATB_PK(1),o[d0],0,0,0);
    o[d0]=__builtin_amdgcn_mfma_f32_32x32x16_bf16(pa2,ATB_PK(2),o[d0],0,0,0);
    o[d0]=__builtin_amdgcn_mfma_f32_32x32x16_bf16(pa3,ATB_PK(3),o[d0],0,0,0);
    #undef ATB_PK
  }
}
__device__ __forceinline__ void attnb_job(int b,int j,int tt,const bf16*Qb,const bf16*__restrict__ Kb,const bf16*__restrict__ Vb,bf16*O,char*wl,float*wsf){
  const int lane=threadIdx.x&63,r32=lane&31,hi=lane>>5;
  const long rowbase=(long)b*SEQ; const int T0=(tt>>4)*512+(tt&15);
  const unsigned lds0=(unsigned)__builtin_amdgcn_readfirstlane((int)(unsigned)(uintptr_t)wl);
  const lds_cptr kp0=(lds_cptr)wl+hi*1024+r32*16;
  const int vb0=(int)(lds0+8192u)+((lane>>4)&1)*32+(lane&3)*8+(4*hi+((lane&15)>>2))*64;
  float m_run=-INFINITY,l_run=0.f; f32x16 o[2]; o[0]=f32x16{}; o[1]=f32x16{};
  #pragma unroll 1
  for(int g=0;g<3;++g){
    const int sh=2*g,d=1<<sh,stride=16>>sh,ntile=(g==0)?10:((g==1)?4:3),hq=g*4+j;
    const float slope2=exp2f(-8.0f*(float)(hq+1)/12.0f)*(float)d*1.4426950408889634f;
    const int rc=T0&(d-1),s0=T0>>sh,sk0=s0-64,smax=(SEQ>>sh)-1,sq=s0+stride*r32;
    const bf16*Qw=Qb+(rowbase+T0+16*r32)*PB+hq*64;
    bf16x8 qr[4];
    #pragma unroll
    for(int d0=0;d0<4;++d0)qr[d0]=*reinterpret_cast<const bf16x8*>(Qw+d0*16+hi*8);
    const float lo_f=(float)max(-64,-sq),hi_f=(float)min(64,smax-sq);
    const bf16*Kg=Kb+(rowbase+rc)*PB+hq*64; const bf16*Vg=Vb+(rowbase+rc)*PB+hq*64+(lane&3)*8;
    #define ATB_DMAK(tau) do{ int s_=sk0+64*(tau)+lane; s_=min(max(s_,0),smax); const bf16*src_=Kg+(long)(d*s_)*PB; \
        _Pragma("unroll") for(int c_=0;c_<8;++c_)glds16(src_+c_*8,lds0+c_*1024u); }while(0)
    #define ATB_DMAV(tau) do{ _Pragma("unroll") for(int kg_=0;kg_<4;++kg_){ int s_=sk0+64*(tau)+16*kg_+(lane>>2); s_=min(max(s_,0),smax); const bf16*src_=Vg+(long)(d*s_)*PB; \
        glds16(src_,lds0+8192u+kg_*1024u); glds16(src_+32,lds0+8192u+(4+kg_)*1024u);} }while(0)
    ATB_DMAK(0); ATB_DMAV(0);
    #pragma unroll 1
    for(int tau=0;tau<ntile;++tau){
      asm volatile("s_waitcnt vmcnt(8)":::"memory");
      bf16x8 kf[8]; kload8(kf,kp0);
      asm volatile("s_waitcnt lgkmcnt(0)":::"memory");
      const bool more=(tau+1<ntile);
      if(more){ATB_DMAK(tau+1);}
      f32x16 p0=f32x16{},p1=f32x16{};
      #pragma unroll
      for(int d0=0;d0<4;++d0){ p0=__builtin_amdgcn_mfma_f32_32x32x16_bf16(kf[2*d0],qr[d0],p0,0,0,0); p1=__builtin_amdgcn_mfma_f32_32x32x16_bf16(kf[2*d0+1],qr[d0],p1,0,0,0); }
      const float basef=(float)(64*tau-64-stride*r32+4*hi);
      #pragma unroll
      for(int r=0;r<16;++r){ const float c0=basef+(float)((r&3)+8*(r>>2)),c1=c0+32.0f;
        p0[r]=(c0>=lo_f&&c0<=hi_f)?__builtin_fmaf(-slope2,__builtin_fabsf(c0),p0[r]):-INFINITY;
        p1[r]=(c1>=lo_f&&c1<=hi_f)?__builtin_fmaf(-slope2,__builtin_fabsf(c1),p1[r]):-INFINITY; }
      float rm;
      { float a=ATB_MX3(p0[0],p0[1],p1[0]),bb=ATB_MX3(p0[2],p0[3],p1[1]); a=ATB_MX3(a,p1[2],p1[3]);
        #pragma unroll
        for(int r=4;r<16;r+=4){a=ATB_MX3(a,p0[r],p0[r+1]);bb=ATB_MX3(bb,p0[r+2],p0[r+3]);a=ATB_MX3(a,p1[r],p1[r+1]);bb=ATB_MX3(bb,p1[r+2],p1[r+3]);}
        rm=__builtin_fmaxf(a,bb); auto rr=__builtin_amdgcn_permlane32_swap(__float_as_uint(rm),__float_as_uint(rm),false,false); rm=__builtin_fmaxf(__uint_as_float(rr[0]),__uint_as_float(rr[1])); }
      const float m_new=__builtin_fmaxf(m_run,rm); const float m_safe=(m_new==-INFINITY)?0.0f:m_new;
      const float alpha=__builtin_amdgcn_exp2f(m_run-m_safe);
      float sum=0.f;
      #pragma unroll
      for(int r=0;r<16;++r){ p0[r]=__builtin_amdgcn_exp2f(p0[r]-m_safe); p1[r]=__builtin_amdgcn_exp2f(p1[r]-m_safe); sum+=p0[r]+p1[r]; }
      l_run=l_run*alpha+sum; m_run=m_new;
      if(hi==0)wsf[r32]=alpha;
      asm volatile("s_waitcnt lgkmcnt(0)":::"memory");
      #pragma unroll
      for(int r=0;r<16;++r){ const float f=wsf[crow(r,hi)]; o[0][r]*=f; o[1][r]*=f; }
      u32x4 pw0,pw1,pw2,pw3;
      pw0=(u32x4){cvtpk_s(p0[0],p0[1]),cvtpk_s(p0[2],p0[3]),cvtpk_s(p0[4],p0[5]),cvtpk_s(p0[6],p0[7])};
      pw1=(u32x4){cvtpk_s(p0[8],p0[9]),cvtpk_s(p0[10],p0[11]),cvtpk_s(p0[12],p0[13]),cvtpk_s(p0[14],p0[15])};
      pw2=(u32x4){cvtpk_s(p1[0],p1[1]),cvtpk_s(p1[2],p1[3]),cvtpk_s(p1[4],p1[5]),cvtpk_s(p1[6],p1[7])};
      pw3=(u32x4){cvtpk_s(p1[8],p1[9]),cvtpk_s(p1[10],p1[11]),cvtpk_s(p1[12],p1[13]),cvtpk_s(p1[14],p1[15])};
      if(more){asm volatile("s_waitcnt vmcnt(8)":::"memory");}else{asm volatile("s_waitcnt vmcnt(0)":::"memory");}
      pvb(o,vb0,__builtin_bit_cast(bf16x8,pw0),__builtin_bit_cast(bf16x8,pw1),__builtin_bit_cast(bf16x8,pw2),__builtin_bit_cast(bf16x8,pw3));
      if(more){ATB_DMAV(tau+1);}
    }
    #undef ATB_DMAK
    #undef ATB_DMAV
  }
  {auto rr=__builtin_amdgcn_permlane32_swap(__float_as_uint(l_run),__float_as_uint(l_run),false,false);l_run=__uint_as_float(rr[0])+__uint_as_float(rr[1]);}
  if(hi==0)wsf[32+r32]=l_run;
  asm volatile("s_waitcnt lgkmcnt(0)":::"memory");
  float rli[16];
  #pragma unroll
  for(int r=0;r<16;++r)rli[r]=__builtin_amdgcn_rcpf(wsf[32+crow(r,hi)]);
  { bf16*stg=(bf16*)wl;
    #pragma unroll
    for(int r=0;r<16;++r){const int orow=crow(r,hi);
      #pragma unroll
      for(int d0=0;d0<2;++d0)stg[orow*64+d0*32+r32]=__float2bfloat16(o[d0][r]*rli[r]);}
    asm volatile("s_waitcnt lgkmcnt(0)":::"memory");
    bf16*Ow=O+(rowbase+T0)*OP+OCOL+j*64;
    #pragma unroll
    for(int i=0;i<4;++i){const int row=i*8+(lane>>3),ch=lane&7; const u32x4 v=*(const u32x4*)(stg+row*64+ch*8); *(u32x4*)(Ow+(long)(16*row)*OP+ch*8)=v;} }
  asm volatile("s_waitcnt lgkmcnt(0)":::"memory");
}
#undef ATB_MX3
}
namespace attn8 {
using attn_body::bf16; using attn_body::f32x16; using attn_body::u32x4; using attn_body::crow; using attn_body::glds16;
typedef int i32x4 __attribute__((ext_vector_type(4)));
typedef int i32x8 __attribute__((ext_vector_type(8)));
constexpr int SEQ=8192,QP=512,KP=128,OP=768,NW=8,QBLK=32,QB=256,KVBLK=64,NT=SEQ/KVBLK;
constexpr int SLOT=4096,NSLOT=8,LDS_K=0,LDS_V=NSLOT*SLOT,LDS_WS=2*NSLOT*SLOT,LDS_OST=LDS_WS+NW*256,LDS_BYTES=LDS_OST+NW*4096;
typedef __attribute__((address_space(3))) const char* lds_cptr;
__device__ __forceinline__ i32x8 frag2(lds_cptr a,lds_cptr b){ const i32x4 lo=*(const __attribute__((address_space(3))) i32x4*)a, hi=*(const __attribute__((address_space(3))) i32x4*)b; return __builtin_shufflevector(lo,hi,0,1,2,3,4,5,6,7); }
__device__ __forceinline__ int pk4_bf8(float a,float b,float c,float d){ int w=__builtin_amdgcn_cvt_pk_bf8_f32(a,b,0,false); return __builtin_amdgcn_cvt_pk_bf8_f32(c,d,w,true); }
__device__ __forceinline__ int pk4_e5m2(float a,float b,float c,float d){
  const unsigned h0=__builtin_bit_cast(unsigned,__builtin_amdgcn_cvt_pkrtz(a,b)), h1=__builtin_bit_cast(unsigned,__builtin_amdgcn_cvt_pkrtz(c,d));
  return (int)__builtin_amdgcn_perm(h1,h0,0x07050301u); }
template<int MODE=0,bool ZC=false> __device__ __forceinline__ void unit(int b,int h,int qb,const unsigned char*Q8,const unsigned char*K8,const unsigned char*VT8,bf16*O,char*shm,float cref){
  const int tid=threadIdx.x,lane=tid&63,r32=lane&31,hi=lane>>5; const int wid=__builtin_amdgcn_readfirstlane(tid>>6);
  const long rowbase=(long)b*SEQ; const int q0=qb*QB,kvh=h>>2;
  const unsigned lds0=(unsigned)(uintptr_t)shm;
  const unsigned char*src0; long sstep; unsigned dst0;
  if(wid<4){ const int rho=lane,key=32*(rho>>5)+16*((rho>>2)&1)+(rho&3)+4*((rho&31)>>3); src0=K8+(rowbase+key)*KP+kvh*64+wid*16; sstep=(long)KVBLK*KP; dst0=lds0+LDS_K+wid*1024; }
  else { src0=VT8+((long)(b*2+kvh)*64+lane)*SEQ+(wid-4)*16; sstep=KVBLK; dst0=lds0+LDS_V+(wid-4)*1024; }
  #define A8_DMA(t,slot) glds16(src0+(long)(t)*sstep,(unsigned)__builtin_amdgcn_readfirstlane(dst0+(slot)*SLOT))
  A8_DMA(0,0); A8_DMA(1,1); A8_DMA(2,2); A8_DMA(3,3);
  const unsigned char*qp=Q8+(rowbase+q0+wid*QBLK+r32)*QP+h*64+hi*32;
  i32x8 qr=__builtin_shufflevector(*(const i32x4*)qp,*(const i32x4*)(qp+16),0,1,2,3,4,5,6,7);
  asm volatile("":"+v"(qr));
  f32x16 negm=f32x16{}; if(!ZC){ _Pragma("unroll") for(int r=0;r<16;++r)negm[r]=-cref; }
  f32x16 o0=f32x16{},o1=f32x16{},ol=f32x16{};
  i32x8 ones; _Pragma("unroll") for(int r=0;r<8;++r)ones[r]=0x38383838; asm volatile("":"+v"(ones));
  const lds_cptr kp=(lds_cptr)shm+LDS_K+(2*hi)*1024+r32*16, vp=(lds_cptr)shm+LDS_V+hi*1024+r32*16;
  #define A8_MF(a,bq,c,fa) __builtin_amdgcn_mfma_scale_f32_32x32x64_f8f6f4(a,bq,c,fa,0,0,0,0,0)
  f32x16 pA0,pA1,pB0,pB1; i32x8 paA,paB; _Pragma("unroll") for(int r=0;r<8;++r){paA[r]=0;paB[r]=0;}
  asm volatile("s_waitcnt vmcnt(3) lgkmcnt(0)\n\ts_barrier":::"memory");
  { const i32x8 kf0=frag2(kp,kp+1024),kf1=frag2(kp+512,kp+1024+512); pA0=A8_MF(kf0,qr,negm,0); pA1=A8_MF(kf1,qr,negm,0); }
  int s_k=1,s_v=NSLOT-1,s_d=4;
  #define A8_ROT(x) x=((x)==NSLOT-1)?0:(x)+1
  #define A8_STEP(PC0,PC1,PN0,PN1,PAO,PAN,HAVE_NEXT,DO_PV) do{ \
    const lds_cptr ks_=kp+s_k*SLOT, vs_=vp+s_v*SLOT; \
    if(HAVE_NEXT){ const i32x8 kf0_=frag2(ks_,ks_+1024),kf1_=frag2(ks_+512,ks_+1024+512); if(!(MODE&4)){ PN0=A8_MF(kf0_,qr,negm,0); PN1=A8_MF(kf1_,qr,negm,0); } else { PN0=negm; PN1=negm; asm volatile(""::"v"(kf0_),"v"(kf1_)); } } \
    if(DO_PV){ const i32x8 vf0_=frag2(vs_,vs_+2048),vf1_=frag2(vs_+512,vs_+2048+512); if(!(MODE&8)){ o0=A8_MF(PAO,vf0_,o0,1); o1=A8_MF(PAO,vf1_,o1,1); ol=A8_MF(PAO,ones,ol,1); } else { asm volatile(""::"v"(vf0_),"v"(vf1_),"v"(PAO)); } } \
    if(!(MODE&1)){ _Pragma("unroll") for(int r_=0;r_<16;++r_){ PC0[r_]=__builtin_amdgcn_exp2f(PC0[r_]); PC1[r_]=__builtin_amdgcn_exp2f(PC1[r_]); } } \
    if(!(MODE&2)){ PAN[0]=pk4_e5m2(PC0[0],PC0[1],PC0[2],PC0[3]); PAN[1]=pk4_e5m2(PC0[4],PC0[5],PC0[6],PC0[7]); PAN[2]=pk4_e5m2(PC0[8],PC0[9],PC0[10],PC0[11]); PAN[3]=pk4_e5m2(PC0[12],PC0[13],PC0[14],PC0[15]); \
      PAN[4]=pk4_e5m2(PC1[0],PC1[1],PC1[2],PC1[3]); PAN[5]=pk4_e5m2(PC1[4],PC1[5],PC1[6],PC1[7]); PAN[6]=pk4_e5m2(PC1[8],PC1[9],PC1[10],PC1[11]); PAN[7]=pk4_e5m2(PC1[12],PC1[13],PC1[14],PC1[15]); } else { asm volatile(""::"v"(PC0),"v"(PC1)); } \
    _Pragma("unroll") for(int g_=0;g_<5;++g_){ __builtin_amdgcn_sched_group_barrier(0x008,1,0); __builtin_amdgcn_sched_group_barrier(0x002,12,0); } \
    A8_ROT(s_k); A8_ROT(s_v); }while(0)
  #define A8_TOP(t) do{ if((t)+3<NT){ asm volatile("s_waitcnt vmcnt(1) lgkmcnt(0)\n\ts_barrier":::"memory"); } else { asm volatile("s_waitcnt vmcnt(0) lgkmcnt(0)\n\ts_barrier":::"memory"); } \
    if((t)+5<NT){ A8_DMA((t)+4,s_d); A8_DMA((t)+5,s_d+1); } s_d=(s_d==NSLOT-2)?0:s_d+2; }while(0)
  A8_TOP(0); A8_STEP(pA0,pA1,pB0,pB1,paB,paA,true,false);
             A8_STEP(pB0,pB1,pA0,pA1,paA,paB,true,true);
  #pragma unroll 1
  for(int t=2;t<NT;t+=2){
    A8_TOP(t); A8_STEP(pA0,pA1,pB0,pB1,paB,paA,true,true);
               A8_STEP(pB0,pB1,pA0,pA1,paA,paB,(t+2<NT),true);
  }
  { const lds_cptr vs_=vp+s_v*SLOT; const i32x8 vf0_=frag2(vs_,vs_+2048),vf1_=frag2(vs_+512,vs_+2048+512); if(!(MODE&8)){ o0=A8_MF(paB,vf0_,o0,1); o1=A8_MF(paB,vf1_,o1,1); ol=A8_MF(paB,ones,ol,1); } }
  #undef A8_DMA
  #undef A8_MF
  #undef A8_ROT
  #undef A8_STEP
  #undef A8_TOP
  float rli[16];
  #pragma unroll
  for(int r=0;r<16;++r)rli[r]=__builtin_amdgcn_rcpf(ol[r]);
  bf16*Ow=O+(rowbase+q0+wid*QBLK)*OP+h*64;
  { bf16*stg=(bf16*)(shm+LDS_OST)+wid*2048;
    #pragma unroll
    for(int r=0;r<16;++r){const int orow=crow(r,hi); stg[orow*64+r32]=__float2bfloat16(o0[r]*rli[r]); stg[orow*64+32+r32]=__float2bfloat16(o1[r]*rli[r]);}
    asm volatile("s_waitcnt lgkmcnt(0)":::"memory");
    #pragma unroll
    for(int i=0;i<4;++i){const int row=i*8+(lane>>3),ch=lane&7; const u32x4 v=*(const u32x4*)(stg+row*64+ch*8); *(u32x4*)(Ow+(long)row*OP+ch*8)=v;} }
  asm volatile("s_waitcnt lgkmcnt(0)\n\ts_barrier":::"memory");
}
constexpr int ATTN8_LDS_BYTES=LDS_BYTES;
}
namespace attnb2 {
using attn_body::bf16; using attn_body::bf16x8; using attn_body::s16x4; using attn_body::f32x16; using attn_body::u32x4;
using attn_body::crow; using attn_body::glds16; using attn_body::cvtpk_s; using attnb::pvb;
constexpr int SEQ = 8192, PB = 768, OP = 768, OCOL = 512;
#define AB2_MX3(a,b,c) __builtin_fmaxf(__builtin_fmaxf((a),(b)),(c))
__device__ __forceinline__ void pvb2(f32x16*o,int vb,bf16x8 pa0,bf16x8 pa1,bf16x8 pa2,bf16x8 pa3){
  #pragma unroll
  for(int d0=0;d0<2;++d0){s16x4 lo[4],hi[4];
    #pragma unroll
    for(int ks=0;ks<4;++ks){
      asm volatile("ds_read_b64_tr_b16 %0,%1 offset:%c2":"=&v"(lo[ks]):"v"(vb),"i"(d0*64+ks*2048):"memory");
      asm volatile("ds_read_b64_tr_b16 %0,%1 offset:%c2":"=&v"(hi[ks]):"v"(vb),"i"(d0*64+ks*2048+1024):"memory");}
    asm volatile("s_waitcnt lgkmcnt(0)":::"memory");__builtin_amdgcn_sched_barrier(0);
    #define AB2_PK(k) (bf16x8){lo[k][0],lo[k][1],lo[k][2],lo[k][3],hi[k][0],hi[k][1],hi[k][2],hi[k][3]}
    o[d0]=__builtin_amdgcn_mfma_f32_32x32x16_bf16(pa0,AB2_PK(0),o[d0],0,0,0);
    o[d0]=__builtin_amdgcn_mfma_f32_32x32x16_bf16(pa1,AB2_PK(1),o[d0],0,0,0);
    o[d0]=__builtin_amdgcn_mfma_f32_32x32x16_bf16(pa2,AB2_PK(2),o[d0],0,0,0);
    o[d0]=__builtin_amdgcn_mfma_f32_32x32x16_bf16(pa3,AB2_PK(3),o[d0],0,0,0);
    #undef AB2_PK
  }
}
__device__ __forceinline__ void gload16(bf16x8&dst,const void*p){asm volatile("global_load_dwordx4 %0, %1, off":"=v"(dst):"v"(p):"memory");}
#define AB2_PIN8(N,kf) asm volatile("s_waitcnt vmcnt(" #N ")":"+v"(kf[0]),"+v"(kf[1]),"+v"(kf[2]),"+v"(kf[3]),"+v"(kf[4]),"+v"(kf[5]),"+v"(kf[6]),"+v"(kf[7])::"memory")
#define AB2_WAITV(N) asm volatile("s_waitcnt vmcnt(" #N ")":::"memory")
template<int BM=0> __device__ __forceinline__ void b2_tile(int lane_in,int b,int j,int g,int k,int c,const bf16*Qb,const bf16*__restrict__ Kb,const bf16*__restrict__ Vb,bf16*O,float*LSE,char*wl,float*wsf){
  int lane=lane_in; asm volatile("":"+v"(lane));
  const int r32=lane&31,hi=lane>>5;
  const int sh=2*g,d=1<<sh,Lg=SEQ>>sh,hq=g*4+j;
  int rc,sfirst; if(g==2){rc=k;sfirst=32*c;} else if(g==1){rc=k&3;sfirst=128*c+32*(k>>2);} else {rc=0;sfirst=512*c+32*k;}
  const float slope2=exp2f(-8.0f*(float)(hq+1)/12.0f)*(float)d*1.4426950408889634f;
  const long rowbase=(long)b*SEQ+rc;
  const int sq=sfirst+r32; const float lo_f=(float)max(-64,-sq),hi_f=(float)min(64,Lg-1-sq);
  const unsigned slot0=(unsigned)__builtin_amdgcn_readfirstlane((int)(unsigned)(uintptr_t)wl),slot1=slot0+8192u;
  const int vb0=(int)slot0+((lane>>4)&1)*32+(lane&3)*8+(4*hi+((lane&15)>>2))*128,vb1=vb0+8192;
  const bool mrg=(g!=2);
  bf16x8 qr[4],kfA[8];
  { const bf16*Qp=Qb+(rowbase+(long)d*sq)*PB+hq*64+hi*8;
    #pragma unroll
    for(int d0=0;d0<4;++d0)gload16(qr[d0],Qp+d0*16); }
  #define AB2_KLOAD(kf,tau) do{ const bf16*k0_=Kb+(rowbase+(long)d*min(max(sfirst-64+64*(tau)+r32,0),Lg-1))*PB+hq*64+hi*8; const bf16*k1_=Kb+(rowbase+(long)d*min(max(sfirst-32+64*(tau)+r32,0),Lg-1))*PB+hq*64+hi*8; \
      if(!(BM&2)){ _Pragma("unroll") for(int d0=0;d0<4;++d0){ gload16(kf[2*d0],k0_+16*d0); gload16(kf[2*d0+1],k1_+16*d0);} } else { _Pragma("unroll") for(int i_=0;i_<8;++i_){ asm volatile("s_nop 0":"=v"(kf[i_])); } } }while(0)
  #define AB2_VDMA(tau,slot) do{ _Pragma("unroll") for(int i_=0;i_<8;++i_){ const int s_=min(max(sfirst-64+64*(tau)+8*i_+(lane>>3),0),Lg-1); const bf16*src_=Vb+(rowbase+(long)d*s_)*PB+hq*64+(lane&7)*8; \
      if(!(BM&4)) glds16(src_,(slot)+i_*1024u);} }while(0)
  AB2_KLOAD(kfA,1); AB2_VDMA(1,slot0); AB2_VDMA(0,slot1);
  float m_run=0.f,l_run=0.f; f32x16 o[2]; o[0]=f32x16{}; o[1]=f32x16{};
  u32x4 pw0,pw1,pw2,pw3; f32x16 p0,p1;
  #define AB2_QK(kf) do{ p0=f32x16{}; p1=f32x16{}; _Pragma("unroll") for(int d0=0;d0<4;++d0){ p0=__builtin_amdgcn_mfma_f32_32x32x16_bf16(kf[2*d0],qr[d0],p0,0,0,0); p1=__builtin_amdgcn_mfma_f32_32x32x16_bf16(kf[2*d0+1],qr[d0],p1,0,0,0); } }while(0)
  #define AB2_SOFTMAX(tau,FIRST) do{ if(BM&1){ m_run=0.f; l_run=1.f; } else { float basef=(float)(64*(tau)-64-r32+4*hi); asm volatile("":"+v"(basef));     \
      _Pragma("unroll") for(int r=0;r<16;++r){ const float c0=basef+(float)((r&3)+8*(r>>2)),c1=c0+32.0f; \
        p0[r]=(c0>=lo_f&&c0<=hi_f)?__builtin_fmaf(-slope2,__builtin_fabsf(c0),p0[r]):-INFINITY; p1[r]=(c1>=lo_f&&c1<=hi_f)?__builtin_fmaf(-slope2,__builtin_fabsf(c1),p1[r]):-INFINITY; } \
      float rm; { float a=AB2_MX3(p0[0],p0[1],p1[0]),bb=AB2_MX3(p0[2],p0[3],p1[1]); a=AB2_MX3(a,p1[2],p1[3]); \
        _Pragma("unroll") for(int r=4;r<16;r+=4){a=AB2_MX3(a,p0[r],p0[r+1]);bb=AB2_MX3(bb,p0[r+2],p0[r+3]);a=AB2_MX3(a,p1[r],p1[r+1]);bb=AB2_MX3(bb,p1[r+2],p1[r+3]);} \
        rm=__builtin_fmaxf(a,bb); auto rr=__builtin_amdgcn_permlane32_swap(__float_as_uint(rm),__float_as_uint(rm),false,false); rm=__builtin_fmaxf(__uint_as_float(rr[0]),__uint_as_float(rr[1])); } \
      const float m_new=(FIRST)?rm:__builtin_fmaxf(m_run,rm); float sum=0.f; \
      _Pragma("unroll") for(int r=0;r<16;++r){ p0[r]=__builtin_amdgcn_exp2f(p0[r]-m_new); p1[r]=__builtin_amdgcn_exp2f(p1[r]-m_new); sum+=p0[r]+p1[r]; } \
      if(FIRST){ l_run=sum; } else { const float alpha=__builtin_amdgcn_exp2f(m_run-m_new); l_run=l_run*alpha+sum; \
        if(!__all(m_new==m_run)){ if(hi==0)wsf[r32]=alpha; asm volatile("s_waitcnt lgkmcnt(0)":::"memory");     \
        _Pragma("unroll") for(int r=0;r<16;++r){ const float f=wsf[crow(r,hi)]; o[0][r]*=f; o[1][r]*=f; } } } \
      m_run=m_new; \
      } \
      pw0=(u32x4){cvtpk_s(p0[0],p0[1]),cvtpk_s(p0[2],p0[3]),cvtpk_s(p0[4],p0[5]),cvtpk_s(p0[6],p0[7])}; pw1=(u32x4){cvtpk_s(p0[8],p0[9]),cvtpk_s(p0[10],p0[11]),cvtpk_s(p0[12],p0[13]),cvtpk_s(p0[14],p0[15])}; \
      pw2=(u32x4){cvtpk_s(p1[0],p1[1]),cvtpk_s(p1[2],p1[3]),cvtpk_s(p1[4],p1[5]),cvtpk_s(p1[6],p1[7])}; pw3=(u32x4){cvtpk_s(p1[8],p1[9]),cvtpk_s(p1[10],p1[11]),cvtpk_s(p1[12],p1[13]),cvtpk_s(p1[14],p1[15])}; }while(0)
  #define AB2_PV(vb) if(!(BM&4)) pvb2(o,vb,__builtin_bit_cast(bf16x8,pw0),__builtin_bit_cast(bf16x8,pw1),__builtin_bit_cast(bf16x8,pw2),__builtin_bit_cast(bf16x8,pw3))
  asm volatile("s_waitcnt vmcnt(16)":"+v"(qr[0]),"+v"(qr[1]),"+v"(qr[2]),"+v"(qr[3])::"memory");
  AB2_PIN8(16,kfA);
  AB2_QK(kfA);
  asm volatile("s_nop 7":"+v"(p0),"+v"(p1));
  AB2_KLOAD(kfA,0);
  AB2_SOFTMAX(1,true);
  AB2_WAITV(16); AB2_PV(vb0);
  AB2_VDMA(2,slot0);
  AB2_PIN8(8,kfA);
  AB2_QK(kfA);
  asm volatile("s_nop 7":"+v"(p0),"+v"(p1));
  AB2_KLOAD(kfA,2);
  AB2_SOFTMAX(0,false);
  AB2_PV(vb1);
  const long rowO=(long)b*SEQ+rc+(long)d*sfirst;
  int lse_old_bits=0;
  {
    #pragma unroll
    for(int i=0;i<4;++i){ const bf16*src_=O+(rowO+(long)d*(i*8+(lane>>3)))*OP+OCOL+j*64+(lane&7)*8; glds16(src_,slot1+i*1024u); }
    const float*lp=LSE+(rowO+(long)d*r32)*4+j; asm volatile("global_load_dword %0, %1, off":"=v"(lse_old_bits):"v"(lp):"memory"); }
  AB2_PIN8(5,kfA);
  AB2_QK(kfA); AB2_SOFTMAX(2,false);
  AB2_PV(vb0);
  {auto rr=__builtin_amdgcn_permlane32_swap(__float_as_uint(l_run),__float_as_uint(l_run),false,false);l_run=__uint_as_float(rr[0])+__uint_as_float(rr[1]);}
  const float lse_g=m_run+__builtin_amdgcn_logf(l_run);
  float w_old=0.f,w_new=__builtin_amdgcn_rcpf(l_run),lse_new=lse_g;
  asm volatile("s_waitcnt vmcnt(0)":"+v"(lse_old_bits)::"memory");
  if(mrg){ const float lse_old=__int_as_float(lse_old_bits);
    const float mx=__builtin_fmaxf(lse_old,lse_g); const float eo=__builtin_amdgcn_exp2f(lse_old-mx),eg=__builtin_amdgcn_exp2f(lse_g-mx); const float inv=__builtin_amdgcn_rcpf(eo+eg);
    lse_new=mx+__builtin_amdgcn_logf(eo+eg); w_old=eo*inv; w_new=eg*inv*__builtin_amdgcn_rcpf(l_run); }
  if(hi==0){wsf[r32]=w_old;wsf[32+r32]=w_new;}
  asm volatile("s_waitcnt lgkmcnt(0)":::"memory");
  { const unsigned short*oldp=(const unsigned short*)(wl+8192); bf16*stg=(bf16*)wl;
    #pragma unroll
    for(int r=0;r<16;++r){ const int orow=crow(r,hi); const float fo=wsf[orow],fn=wsf[32+orow];
      #pragma unroll
      for(int d0=0;d0<2;++d0){ float v=o[d0][r]*fn; if(mrg)v=__builtin_fmaf(__uint_as_float((unsigned)oldp[orow*64+d0*32+r32]<<16),fo,v); stg[orow*64+d0*32+r32]=__float2bfloat16(v); } }
    asm volatile("s_waitcnt lgkmcnt(0)":::"memory");
    #pragma unroll
    for(int i=0;i<4;++i){const int row=i*8+(lane>>3),ch=lane&7; const u32x4 v=*(const u32x4*)(stg+row*64+ch*8); *(u32x4*)(O+(rowO+(long)d*row)*OP+OCOL+j*64+ch*8)=v;}
    if(g!=0&&hi==0)LSE[(rowO+(long)d*r32)*4+j]=lse_new; }
  asm volatile("s_waitcnt lgkmcnt(0)":::"memory");
  #undef AB2_KLOAD
  #undef AB2_VDMA
  #undef AB2_QK
  #undef AB2_SOFTMAX
  #undef AB2_PV
}
template<int BM=0> __device__ __forceinline__ void b2_unit(int lane,int b,int j,int c,int wave,const bf16*Qb,const bf16*Kb,const bf16*Vb,bf16*O,float*LSE,char*wl,float*wsf){
  #pragma unroll 1
  for(int g=2;g>=0;--g){
    #pragma unroll 1
    for(int kk=0;kk<2;++kk)b2_tile<BM>(lane,b,j,g,2*wave+kk,c,Qb,Kb,Vb,O,LSE,wl,wsf);
    asm volatile("s_waitcnt vmcnt(0)":::"memory");
    __syncthreads();
  }
}
#undef AB2_MX3
#undef AB2_PIN8
#undef AB2_WAITV
}
#ifndef ATTN_FP8
#define ATTN_FP8 1
#endif
#ifndef GEMM1_WGM
#define GEMM1_WGM 8
#endif
#ifndef GEMM1_FP8
#define GEMM1_FP8 1
#endif
constexpr int NWAVES = 8;
#ifndef MK_N_LAUNCHES
#define MK_N_LAUNCHES 1
#endif
constexpr int N_PHASES = 12;
constexpr int N_LAUNCHES = MK_N_LAUNCHES;

constexpr int BATCH = 8, SEQ = 8192, DM = 1024, M = BATCH * SEQ;
constexpr int N_IN = 5120, NE = 16, FF = 1024, CAP = 1024, MR = BATCH * NE * CAP;
constexpr float NORM_EPS = 1e-6f;

constexpr size_t MiB = 1u << 20;
constexpr size_t WS_CTL = 0, CTL_ZERO_BYTES = 1 * MiB;
constexpr size_t WS_AFF = 1 * MiB;
constexpr size_t WS_TOPI = 5 * MiB, WS_TOPG = WS_TOPI + 512 * 1024;
constexpr size_t WS_TSLOT = 6 * MiB;
constexpr size_t WS_WIN = 10 * MiB;
constexpr size_t WS_WO = 20 * MiB;
constexpr size_t WS_WOUT = 22 * MiB;
constexpr size_t WS_WGU = 24 * MiB;
constexpr size_t WS_WD = 88 * MiB;
constexpr size_t WS_XN = 120 * MiB;
constexpr size_t WS_QA = 248 * MiB, WS_KVA = 312 * MiB, WS_QB = 344 * MiB, WS_KB = 440 * MiB, WS_VB = 536 * MiB, WS_G = 632 * MiB;
constexpr size_t WS_Q8 = WS_XN, WS_K8 = WS_XN + 32 * MiB, WS_VT8 = WS_XN + 40 * MiB;
constexpr size_t WS_OAB = 888 * MiB;
constexpr size_t WS_XB = 440 * MiB;
constexpr size_t WS_XG = 248 * MiB, WS_ACT = 632 * MiB, WS_Y = 760 * MiB;
constexpr size_t WS_END = 1016 * MiB;
static_assert(WS_WD + 32 * MiB <= WS_XN && WS_XN + 128 * MiB <= WS_QA && WS_G + 256 * MiB <= WS_OAB && WS_OAB + 96 * MiB <= WS_END && WS_Y + 256 * MiB <= WS_END, "d_ws map");
constexpr int CW_BAR = 4096;

constexpr int RING_OFF = 0, RING_BYTES = 131072;
constexpr int WSF_OFF = RING_BYTES;
constexpr int LDSCTL_OFF = RING_BYTES + 2048, MISC_OFF = LDSCTL_OFF + 320;
constexpr int LDS_BYTES = 147456;
static_assert(MISC_OFF + 128 <= LDS_BYTES, "LDS map");

#define GAS __attribute__((address_space(1)))
#define LAS __attribute__((address_space(3)))
typedef unsigned short bf16;
typedef unsigned v4u __attribute__((ext_vector_type(4)));
typedef float f32x4 __attribute__((ext_vector_type(4)));
typedef short bf16x8 __attribute__((ext_vector_type(8)));
typedef GAS unsigned gu32;
typedef GAS unsigned long long gu64;
#define RLX_AGENT __ATOMIC_RELAXED, __HIP_MEMORY_SCOPE_AGENT
#define LDS_WAIT() asm volatile("s_waitcnt lgkmcnt(0)" ::: "memory")
#define VM_WAIT() asm volatile("s_waitcnt vmcnt(0)" ::: "memory")
__device__ __forceinline__ unsigned long long rt() { return __builtin_amdgcn_s_memrealtime(); }
__device__ __forceinline__ unsigned f2bf(float f) { unsigned u = __builtin_bit_cast(unsigned, f); return (u + 0x7fffu + ((u >> 16) & 1u)) >> 16; }
__device__ __forceinline__ unsigned pk2(float lo, float hi) { return f2bf(lo) | (f2bf(hi) << 16); }

#define XB_TMO      128
#define XB_XCNT(j)  (256  + 64 * (j))
#define XB_XSUB(j)  (1280 + 64 * (j))
#define XB_XGEN(j)  (2304 + 64 * (j))
#define XB_TOP      3328
#define XB_TOPGEN   3392
#define XCD_BAR_WORDS 3456
#define XB_SPIN_CAP (1u << 18)

__device__ __forceinline__ unsigned xb_ld(unsigned* p)              { return __hip_atomic_load(p, __ATOMIC_RELAXED, __HIP_MEMORY_SCOPE_AGENT); }
__device__ __forceinline__ unsigned xb_add(unsigned* p, unsigned v) { return __hip_atomic_fetch_add(p, v, __ATOMIC_RELAXED, __HIP_MEMORY_SCOPE_AGENT); }
__device__ __forceinline__ unsigned xb_xcc_id() { return (unsigned)__builtin_amdgcn_s_getreg((3 << 11) | 20) & 0xFu; }
#define XB_SPIN(cond, bar) do { unsigned _sp = 0; while (cond) { __builtin_amdgcn_s_sleep(1); \
    if ((++_sp & 255u) == 0u) { if (xb_ld(&(bar)[XB_TMO])) break; if (_sp > XB_SPIN_CAP) { atomicAdd(&(bar)[XB_TMO], 1u); break; } } } } while (0)

struct XcdBarrier {
    unsigned* bar; unsigned x;
    volatile LAS unsigned* st;
};

__device__ __forceinline__ XcdBarrier xcd_barrier_post(unsigned* bar, volatile LAS unsigned* st) {
    XcdBarrier b; b.bar = bar; b.x = xb_xcc_id(); b.st = st;
    if (threadIdx.x == 0) (void)xb_add(&bar[XB_XCNT(b.x)], 1u);
    return b;
}
__device__ __forceinline__ void xcd_barrier_complete(unsigned* bar, unsigned x, unsigned& nloc, unsigned& nx) {
    const unsigned G = gridDim.x * gridDim.y * gridDim.z;
    unsigned sum, cnt, mine, sp = 0u;
    for (;;) {
        sum = 0u; cnt = 0u; mine = 0u;
#pragma unroll
        for (unsigned j = 0; j < 16; ++j) { const unsigned c = xb_ld(&bar[XB_XCNT(j)]); sum += c; cnt += (c > 0u) ? 1u : 0u; mine = (j == x) ? c : mine; }
        if (sum == G) break;
        __builtin_amdgcn_s_sleep(1);
        if ((++sp & 255u) == 0u) { if (xb_ld(&bar[XB_TMO])) break; if (sp > XB_SPIN_CAP) { atomicAdd(&bar[XB_TMO], 1u); break; } }
    }
    nloc = mine > 0u ? mine : 1u; nx = cnt > 0u ? cnt : 1u;
}

__device__ __forceinline__ void xcd_barrier(const XcdBarrier& b) {
    asm volatile("s_waitcnt vmcnt(0)" ::: "memory");
    __syncthreads();
    if (threadIdx.x == 0) {
        unsigned* bar = b.bar;
        __builtin_amdgcn_s_waitcnt(0);
        unsigned nloc = b.st[0], nx = b.st[1];
        if (nloc == 0u) { xcd_barrier_complete(bar, b.x, nloc, nx); b.st[0] = nloc; b.st[1] = nx; }
        const unsigned old = xb_add(&bar[XB_XSUB(b.x)], 1u);
        const unsigned gen = old / nloc;
        if (old + 1u == (gen + 1u) * nloc) {
            __builtin_amdgcn_fence(__ATOMIC_RELEASE, "agent");
            asm volatile("s_waitcnt vmcnt(0)" ::: "memory");
            const unsigned og = xb_add(&bar[XB_TOP], 1u);
            const unsigned tg = og / nx;
            if (og + 1u == (tg + 1u) * nx) xb_add(&bar[XB_TOPGEN], 1u);
            else XB_SPIN(xb_ld(&bar[XB_TOPGEN]) == tg, bar);
            __builtin_amdgcn_fence(__ATOMIC_ACQUIRE, "agent");
            xb_add(&bar[XB_XGEN(b.x)], 1u);
            asm volatile("s_waitcnt vmcnt(0)" ::: "memory");
        } else {
            XB_SPIN(xb_ld(&bar[XB_XGEN(b.x)]) == gen, bar);
            __builtin_amdgcn_fence(__ATOMIC_ACQUIRE, "agent");
            asm volatile("s_waitcnt vmcnt(0)" ::: "memory");
        }
    }
    __syncthreads();
}

struct Frame {
    LAS unsigned char* lds;
    volatile LAS unsigned* MISC;
    gu32* ctl;
    int tid, lane, wave;
    int vcu, G;
    float* out; unsigned char* ws;
};
enum InIdx { IN_X = 0, IN_NORM1_G, IN_W_IN, IN_B_GATES, IN_Q_NORM_G, IN_K_NORM_G, IN_W_O_A, IN_W_O_B, IN_W_OUT, IN_NORM2_G, IN_W_ROUTER, IN_W_GATE, IN_W_UP, IN_W_DOWN, IN_NORMF_G };
__device__ __forceinline__ const float* inptr(const Frame& F, int k) {
    volatile LAS unsigned* pt = (volatile LAS unsigned*)(F.lds + LDSCTL_OFF + 64);
    const unsigned lo = pt[2 * k], hi = pt[2 * k + 1];
    const GAS float* gp = (const GAS float*)(((unsigned long long)(unsigned)__builtin_amdgcn_readfirstlane((int)hi) << 32) | (unsigned)__builtin_amdgcn_readfirstlane((int)lo));
    return (const float*)gp;
}

template <int CTRL> __device__ __forceinline__ float dpp_f(float v) { return __builtin_bit_cast(float, __builtin_amdgcn_update_dpp(0, __builtin_bit_cast(int, v), CTRL, 0xf, 0xf, true)); }
constexpr int DPP_X1 = 0xB1, DPP_X2 = 0x4E, DPP_M8 = 0x141, DPP_M16 = 0x140;
__device__ __forceinline__ float swap16_sum(float v) { float a = v, b = v; asm volatile("s_nop 1\n\tv_permlane16_swap_b32 %0, %1" : "+v"(a), "+v"(b)); return a + b; }
__device__ __forceinline__ float swap32_sum(float v) { float a = v, b = v; asm volatile("s_nop 1\n\tv_permlane32_swap_b32 %0, %1" : "+v"(a), "+v"(b)); return a + b; }
__device__ __forceinline__ float sum16(float v) { v += dpp_f<DPP_X1>(v); v += dpp_f<DPP_X2>(v); v += dpp_f<DPP_M8>(v); v += dpp_f<DPP_M16>(v); return v; }
__device__ __forceinline__ float max16(float v) { v = fmaxf(v, dpp_f<DPP_X1>(v)); v = fmaxf(v, dpp_f<DPP_X2>(v)); v = fmaxf(v, dpp_f<DPP_M8>(v)); v = fmaxf(v, dpp_f<DPP_M16>(v)); return v; }
__device__ __forceinline__ float wave_sum(float v) { return swap32_sum(swap16_sum(sum16(v))); }
__device__ __forceinline__ void p0_transpose_item(const float* W, int N, bf16* WT, int ldk, int drow0, int dcol0, LAS float* scr, int kb, int nb, int lane) {
    const int k0 = 64 * kb, n0 = 32 * nb;
#pragma unroll 8
    for (int i = 0; i < 32; ++i) { const int kk = 2 * i + (lane >> 5); scr[kk * 33 + (lane & 31)] = W[(size_t)(k0 + kk) * N + n0 + (lane & 31)]; }
    LDS_WAIT(); asm volatile("" ::: "memory");
    const int c = lane & 7;
#pragma unroll
    for (int j = 0; j < 4; ++j) { const int n = (lane >> 3) + 8 * j; const LAS float* s = scr + (8 * c) * 33 + n;
        v4u o; o.x = pk2(s[0 * 33], s[1 * 33]); o.y = pk2(s[2 * 33], s[3 * 33]); o.z = pk2(s[4 * 33], s[5 * 33]); o.w = pk2(s[6 * 33], s[7 * 33]);
        *(GAS v4u*)(WT + (size_t)(drow0 + n) * ldk + dcol0 + k0 + 8 * c) = o; }
    LDS_WAIT(); asm volatile("" ::: "memory");
}
__device__ __forceinline__ void p0_transpose_item_f8(const float* W, int N, unsigned char* WT, int ldk, int drow0, float wscale, LAS float* scr, int kb, int nb, int lane) {
    const int k0 = 64 * kb, n0 = 32 * nb;
#pragma unroll 8
    for (int i = 0; i < 32; ++i) { const int kk = 2 * i + (lane >> 5); scr[kk * 33 + (lane & 31)] = W[(size_t)(k0 + kk) * N + n0 + (lane & 31)]; }
    LDS_WAIT(); asm volatile("" ::: "memory");
    const int c = lane & 7;
#pragma unroll
    for (int j = 0; j < 4; ++j) { const int n = (lane >> 3) + 8 * j; const LAS float* s = scr + (8 * c) * 33 + n;
        const unsigned lo = pg8::pk4_fp8(s[0 * 33] * wscale, s[1 * 33] * wscale, s[2 * 33] * wscale, s[3 * 33] * wscale), hi = pg8::pk4_fp8(s[4 * 33] * wscale, s[5 * 33] * wscale, s[6 * 33] * wscale, s[7 * 33] * wscale);
        *(GAS unsigned long long*)(WT + (size_t)(drow0 + n) * ldk + k0 + 8 * c) = (unsigned long long)lo | ((unsigned long long)hi << 32); }
    LDS_WAIT(); asm volatile("" ::: "memory");
}
__device__ __forceinline__ void p0_prologue(Frame& F) {
    LAS float* scr = (LAS float*)(F.lds + RING_OFF + F.wave * 16384);
    const int gw = F.vcu * NWAVES + F.wave, NGW = F.G * NWAVES;
    bf16* WIN = (bf16*)(F.ws + WS_WIN); bf16* WO = (bf16*)(F.ws + WS_WO); bf16* WOUT = (bf16*)(F.ws + WS_WOUT); unsigned char* WGU = F.ws + WS_WGU; unsigned char* WD = F.ws + WS_WD;
    const float* w_in = inptr(F, IN_W_IN); const float* w_o_a = inptr(F, IN_W_O_A); const float* w_o_b = inptr(F, IN_W_O_B); const float* w_out = inptr(F, IN_W_OUT);
    const float* w_gate = inptr(F, IN_W_GATE); const float* w_up = inptr(F, IN_W_UP); const float* w_down = inptr(F, IN_W_DOWN);
    constexpr int I_IN = 16 * 160, I_OA = 8 * 32, I_OB = 4 * 32, I_OUT = 16 * 32, I_E = 16 * 32, NITEMS = I_IN + I_OA + I_OB + I_OUT + 3 * 16 * I_E;
    for (int it = gw; it < NITEMS; it += NGW) {
        int r = it;
#if GEMM1_FP8
        if (r < I_IN) { const int n0 = 32 * (r % 160);
            const int dr = n0 < 3072 ? n0 : (n0 < 4096 ? 3072 + ((n0 - 3072) >> 7) * 256 + ((n0 - 3072) & 127) : 3072 + ((n0 - 4096) >> 7) * 256 + 128 + ((n0 - 4096) & 127));
            p0_transpose_item_f8(w_in, N_IN, (unsigned char*)WIN, 1024, dr, pg8::F8_W_SCALE, scr, r / 160, r % 160, F.lane); continue; } r -= I_IN;
#else
        if (r < I_IN) { p0_transpose_item(w_in, N_IN, WIN, 1024, 32 * (r % 160), 0, scr, r / 160, r % 160, F.lane); continue; } r -= I_IN;
#endif
        if (r < I_OA) { p0_transpose_item(w_o_a, DM, WO, 768, 32 * (r % 32), 0, scr, r / 32, r % 32, F.lane); continue; } r -= I_OA;
        if (r < I_OB) { p0_transpose_item(w_o_b, DM, WO, 768, 32 * (r % 32), 512, scr, r / 32, r % 32, F.lane); continue; } r -= I_OB;
        if (r < I_OUT) { p0_transpose_item(w_out, DM, WOUT, 1024, 32 * (r % 32), 0, scr, r / 32, r % 32, F.lane); continue; } r -= I_OUT;
        const int which = r / (16 * I_E); r -= which * 16 * I_E; const int e = r / I_E, rr = r % I_E, kb = rr / 32, nb = rr % 32, n0 = 32 * nb;
        if (which == 0) p0_transpose_item_f8(w_gate + (size_t)e * DM * FF, FF, WGU + (size_t)e * 2048 * 1024, 1024, (n0 >> 7) * 256 + (n0 & 127), pg8::F8_W_SCALE, scr, kb, nb, F.lane);
        else if (which == 1) p0_transpose_item_f8(w_up + (size_t)e * DM * FF, FF, WGU + (size_t)e * 2048 * 1024, 1024, (n0 >> 7) * 256 + 128 + (n0 & 127), pg8::F8_W_SCALE, scr, kb, nb, F.lane);
        else p0_transpose_item_f8(w_down + (size_t)e * FF * DM, DM, WD + (size_t)e * 1024 * 1024, 1024, n0, pg8::F8_W_SCALE, scr, kb, nb, F.lane);
    }
    bf16* XN = (bf16*)(F.ws + WS_XN); const float* xin = inptr(F, IN_X); const float* norm1_g = inptr(F, IN_NORM1_G);
    f32x4 gg[4];
#pragma unroll
    for (int j = 0; j < 4; ++j) gg[j] = ((const GAS f32x4*)norm1_g)[F.lane + 64 * j];
    for (int m = gw; m < M; m += NGW) {
        const GAS f32x4* xr = (const GAS f32x4*)(xin + (size_t)m * DM) + F.lane;
        f32x4 v[4]; float s2 = 0.f;
#pragma unroll
        for (int j = 0; j < 4; ++j) { v[j] = xr[64 * j]; s2 += (v[j].x * v[j].x + v[j].y * v[j].y) + (v[j].z * v[j].z + v[j].w * v[j].w); }
        const float rs = 1.0f / sqrtf(wave_sum(s2) * (1.f / DM) + NORM_EPS);
        GAS unsigned long long* o8 = (GAS unsigned long long*)(XN + (size_t)m * DM) + F.lane;
#pragma unroll
#if GEMM1_FP8
        for (int j = 0; j < 4; ++j) { const f32x4 y = v[j] * (rs * pg8::F8_ACT_SCALE) * gg[j]; ((GAS unsigned*)((unsigned char*)XN + (size_t)m * DM) + F.lane)[64 * j] = pg8::pk4_fp8(y.x, y.y, y.z, y.w); }
#else
        for (int j = 0; j < 4; ++j) { const f32x4 y = v[j] * rs * gg[j]; o8[64 * j] = (unsigned long long)pk2(y.x, y.y) | ((unsigned long long)pk2(y.z, y.w) << 32); }
#endif
    }
}
__device__ __forceinline__ void p2_qknorm_rope(Frame& F) {
    const int gw = F.vcu * NWAVES + F.wave, NGW = F.G * NWAVES, lane = F.lane, s = lane & 7;
    bf16* QA = (bf16*)(F.ws + WS_QA); bf16* KVA = (bf16*)(F.ws + WS_KVA); unsigned char* Q8 = F.ws + WS_Q8; unsigned char* K8 = F.ws + WS_K8; unsigned char* VT8 = F.ws + WS_VT8;
    const float* q_norm_g = inptr(F, IN_Q_NORM_G); const float* k_norm_g = inptr(F, IN_K_NORM_G);
    float qg[8], kg[8], invf[8];
#pragma unroll
    for (int i = 0; i < 8; ++i) { qg[i] = q_norm_g[s * 8 + i]; kg[i] = k_norm_g[s * 8 + i]; invf[i] = exp2f(-(float)((s & 1) * 8 + i) * 0.8304820237218406f) * 0.15915494309189535f; }
    const bool first = (s & 2) == 0;
    for (int m = gw; m < M; m += NGW) {
        const int t = m & (SEQ - 1); const float pos = (float)((s < 4) ? (t >> 6) : (t & 63));
        float cs[8], sn[8];
#pragma unroll
        for (int i = 0; i < 8; ++i) { float rev = pos * invf[i]; rev -= rintf(rev); cs[i] = __builtin_amdgcn_cosf(rev); sn[i] = __builtin_amdgcn_sinf(rev); if (first) sn[i] = -sn[i]; }
#pragma unroll
        for (int pass = 0; pass < 2; ++pass) {
            const bool act = (pass == 0) || (lane < 16);
            GAS v4u* p = pass == 0 ? (GAS v4u*)(QA + (size_t)m * 512) + lane : (GAS v4u*)(KVA + (size_t)m * 256) + (lane & 15);
            v4u w = (v4u){0u, 0u, 0u, 0u}; if (act) w = *p;
            float v[8] = {__uint_as_float(w.x << 16), __uint_as_float(w.x & 0xffff0000u), __uint_as_float(w.y << 16), __uint_as_float(w.y & 0xffff0000u),
                          __uint_as_float(w.z << 16), __uint_as_float(w.z & 0xffff0000u), __uint_as_float(w.w << 16), __uint_as_float(w.w & 0xffff0000u)};
            float ss = 0.f;
#pragma unroll
            for (int i = 0; i < 8; ++i) ss += v[i] * v[i];
            ss += dpp_f<DPP_X1>(ss); ss += dpp_f<DPP_X2>(ss); ss += dpp_f<DPP_M8>(ss);
            const float rs = (1.0f / sqrtf(ss * (1.f / 64.f) + NORM_EPS)) * (pass == 0 ? pg8::QSCALE : 1.0f);
            float o[8];
#pragma unroll
            for (int i = 0; i < 8; ++i) { const float y = v[i] * rs * (pass == 0 ? qg[i] : kg[i]); const float pr = dpp_f<DPP_X2>(y); o[i] = y * cs[i] + pr * sn[i]; }
            const unsigned long long w8 = (unsigned long long)pg8::pk4_fp8(o[0], o[1], o[2], o[3]) | ((unsigned long long)pg8::pk4_fp8(o[4], o[5], o[6], o[7]) << 32);
            if (act) { if (pass == 0) *((GAS unsigned long long*)(Q8 + (size_t)m * 512) + lane) = w8; else *((GAS unsigned long long*)(K8 + (size_t)m * 128) + (lane & 15)) = w8; }
        }
    }
    LAS unsigned char* tb = F.lds + RING_OFF + F.wave * 16384;
    for (int T = gw; T < BATCH * 2 * (SEQ / 64); T += NGW) {
        const int b = T >> 8, kvh = (T >> 7) & 1, t0 = (T & 127) * 64;
        const GAS v4u* src = (const GAS v4u*)(KVA + ((size_t)b * SEQ + t0 + lane) * 256 + 128 + kvh * 64);
        v4u rv[8];
#pragma unroll
        for (int i = 0; i < 8; ++i) rv[i] = src[i];
#pragma unroll
        for (int i = 0; i < 8; ++i) {
            const unsigned lo = pg8::pk4_fp8(__uint_as_float(rv[i].x << 16), __uint_as_float(rv[i].x & 0xffff0000u), __uint_as_float(rv[i].y << 16), __uint_as_float(rv[i].y & 0xffff0000u));
            const unsigned hi = pg8::pk4_fp8(__uint_as_float(rv[i].z << 16), __uint_as_float(rv[i].z & 0xffff0000u), __uint_as_float(rv[i].w << 16), __uint_as_float(rv[i].w & 0xffff0000u));
            *(LAS unsigned*)(tb + lane * 68 + i * 8) = lo; *(LAS unsigned*)(tb + lane * 68 + i * 8 + 4) = hi; }
        LDS_WAIT(); asm volatile("" ::: "memory");
        v4u ov[4];
#pragma unroll
        for (int i = 0; i < 4; ++i) { unsigned wv[4];
#pragma unroll
            for (int q = 0; q < 4; ++q) { const int tt = i * 16 + q * 4;
                wv[q] = (unsigned)tb[(tt + 0) * 68 + lane] | ((unsigned)tb[(tt + 1) * 68 + lane] << 8) | ((unsigned)tb[(tt + 2) * 68 + lane] << 16) | ((unsigned)tb[(tt + 3) * 68 + lane] << 24); }
            ov[i] = (v4u){wv[0], wv[1], wv[2], wv[3]}; }
        GAS v4u* dst = (GAS v4u*)(VT8 + ((size_t)(b * 2 + kvh) * 64 + lane) * SEQ + t0);
#pragma unroll
        for (int i = 0; i < 4; ++i) dst[i] = ov[i];
        LDS_WAIT(); asm volatile("" ::: "memory");
    }
}
__device__ __forceinline__ void p6_norm2_router(Frame& F) {
    constexpr int WP = 1028;
    LAS float* Wt = (LAS float*)(F.lds + RING_OFF);
    LAS float* g2s = (LAS float*)(F.lds + RING_OFF + 16 * WP * 4);
    const float* w_router = inptr(F, IN_W_ROUTER); const float* norm2_g = inptr(F, IN_NORM2_G);
    for (int i = F.tid; i < DM * NE; i += NWAVES * 64) Wt[(i & 15) * WP + (i >> 4)] = w_router[i] * norm2_g[i >> 4];
    for (int i = F.tid; i < DM; i += NWAVES * 64) g2s[i] = norm2_g[i];
    __syncthreads();
    const int gw = F.vcu * NWAVES + F.wave, NGW = F.G * NWAVES, lane = F.lane, t = lane & 15, kq = lane >> 4;
    const bf16* XB = (const bf16*)(F.ws + WS_XB); unsigned char* XF8 = F.ws + WS_XN; float* AFF = (float*)(F.ws + WS_AFF);
    const LAS float* wl = Wt + t * WP + 256 * kq; const LAS float* gl = g2s + 256 * kq;
#pragma unroll 1
    for (int T = gw; T < M / 16; T += NGW) {
        const size_t row = (size_t)T * 16 + t;
        const GAS v4u* xp = (const GAS v4u*)(XB + row * DM + 256 * kq);
        f32x4 acc = {0.f, 0.f, 0.f, 0.f}; float ss = 0.f;
        v4u xn[8];
#pragma unroll
        for (int c = 0; c < 8; ++c) xn[c] = xp[c];
#pragma unroll 1
        for (int cb = 0; cb < 4; ++cb) {
            v4u xr[8];
#pragma unroll
            for (int c = 0; c < 8; ++c) xr[c] = xn[c];
            if (cb < 3) {
#pragma unroll
                for (int c = 0; c < 8; ++c) xn[c] = xp[8 * (cb + 1) + c]; }
#pragma unroll
            for (int c = 0; c < 8; ++c) {
                const f32x4 w0 = *(const LAS f32x4*)(wl + 64 * cb + 8 * c), w1 = *(const LAS f32x4*)(wl + 64 * cb + 8 * c + 4);
                const float x0 = __uint_as_float(xr[c].x << 16), x1 = __uint_as_float(xr[c].x & 0xffff0000u), x2 = __uint_as_float(xr[c].y << 16), x3 = __uint_as_float(xr[c].y & 0xffff0000u);
                const float x4 = __uint_as_float(xr[c].z << 16), x5 = __uint_as_float(xr[c].z & 0xffff0000u), x6 = __uint_as_float(xr[c].w << 16), x7 = __uint_as_float(xr[c].w & 0xffff0000u);
                ss += (x0 * x0 + x1 * x1) + (x2 * x2 + x3 * x3) + (x4 * x4 + x5 * x5) + (x6 * x6 + x7 * x7);
                acc = __builtin_amdgcn_mfma_f32_16x16x4f32(x0, w0.x, acc, 0, 0, 0); acc = __builtin_amdgcn_mfma_f32_16x16x4f32(x1, w0.y, acc, 0, 0, 0);
                acc = __builtin_amdgcn_mfma_f32_16x16x4f32(x2, w0.z, acc, 0, 0, 0); acc = __builtin_amdgcn_mfma_f32_16x16x4f32(x3, w0.w, acc, 0, 0, 0);
                acc = __builtin_amdgcn_mfma_f32_16x16x4f32(x4, w1.x, acc, 0, 0, 0); acc = __builtin_amdgcn_mfma_f32_16x16x4f32(x5, w1.y, acc, 0, 0, 0);
                acc = __builtin_amdgcn_mfma_f32_16x16x4f32(x6, w1.z, acc, 0, 0, 0); acc = __builtin_amdgcn_mfma_f32_16x16x4f32(x7, w1.w, acc, 0, 0, 0);
                if (c & 1) asm volatile("" ::: "memory");
            }
        }
        ss = swap32_sum(swap16_sum(ss));
        const float rs = 1.0f / sqrtf(ss * (1.f / DM) + NORM_EPS);
#pragma unroll
        for (int r = 0; r < 4; ++r) {
            const float lg = acc[r] * __shfl(rs, 4 * kq + r);
            const float mx = max16(lg);
            const float ex = __expf(lg - mx); const float sm = sum16(ex);
            AFF[((size_t)T * 16 + 4 * kq + r) * NE + t] = ex / sm;
        }
        GAS v4u* op = (GAS v4u*)(XF8 + row * DM + 256 * kq); const float sc = rs * pg8::F8_ACT_SCALE;
#pragma unroll
        for (int c = 0; c < 8; ++c) xn[c] = xp[c];
#pragma unroll 1
        for (int cb = 0; cb < 4; ++cb) {
            v4u xr[8];
#pragma unroll
            for (int c = 0; c < 8; ++c) xr[c] = xn[c];
            if (cb < 3) {
#pragma unroll
                for (int c = 0; c < 8; ++c) xn[c] = xp[8 * (cb + 1) + c]; }
#pragma unroll
            for (int c2 = 0; c2 < 4; ++c2) { v4u o;
#pragma unroll
                for (int hh = 0; hh < 2; ++hh) { const int c = 2 * c2 + hh; const f32x4 g0 = *(const LAS f32x4*)(gl + 64 * cb + 8 * c), g1 = *(const LAS f32x4*)(gl + 64 * cb + 8 * c + 4);
                    const unsigned a = pg8::pk4_fp8(__uint_as_float(xr[c].x << 16) * sc * g0.x, __uint_as_float(xr[c].x & 0xffff0000u) * sc * g0.y, __uint_as_float(xr[c].y << 16) * sc * g0.z, __uint_as_float(xr[c].y & 0xffff0000u) * sc * g0.w);
                    const unsigned bq = pg8::pk4_fp8(__uint_as_float(xr[c].z << 16) * sc * g1.x, __uint_as_float(xr[c].z & 0xffff0000u) * sc * g1.y, __uint_as_float(xr[c].w << 16) * sc * g1.z, __uint_as_float(xr[c].w & 0xffff0000u) * sc * g1.w);
                    if (hh == 0) { o.x = a; o.y = bq; } else { o.z = a; o.w = bq; } }
                op[4 * cb + c2] = o; asm volatile("" ::: "memory"); }
        }
    }
    __syncthreads();
}
__device__ __forceinline__ int block_excl_scan(int v, LAS int* sc, int tid, int lane, int wave, int& total) {
    int inc = v;
#pragma unroll
    for (int o = 1; o < 64; o <<= 1) { const int t = __shfl_up(inc, o); if (lane >= o) inc += t; }
    __syncthreads();
    if (lane == 63) sc[wave] = inc;
    __syncthreads();
    int base = 0, tot = 0;
#pragma unroll
    for (int w = 0; w < NWAVES; ++w) { const int t = sc[w]; if (w < wave) base += t; tot += t; }
    total = tot; return base + inc - v;
}
__device__ __forceinline__ void p7_topk(Frame& F) {
    LAS unsigned* hist = (LAS unsigned*)(F.lds + RING_OFF);
    LAS int* sc = (LAS int*)(F.lds + RING_OFF + 1024);
    LAS unsigned* sel = (LAS unsigned*)(F.lds + RING_OFF + 1024 + 64);
    const float* AFF = (const float*)(F.ws + WS_AFF); int* TOPI = (int*)(F.ws + WS_TOPI); float* TOPG = (float*)(F.ws + WS_TOPG); int* TSLOT = (int*)(F.ws + WS_TSLOT);
    const int tid = F.tid, lane = F.lane, wave = F.wave;
    for (int g = blockIdx.x; g < BATCH * NE; g += F.G) {
        const int b = g >> 4, e = g & 15;
        unsigned k[16];
#pragma unroll
        for (int i = 0; i < 16; ++i) k[i] = __float_as_uint(AFF[((size_t)b * SEQ + tid * 16 + i) * NE + e]);
        unsigned prefix = 0u, mask = 0u, remaining = CAP;
#pragma unroll 1
        for (int pass = 3; pass >= 0; --pass) {
            const int shift = pass * 8;
            __syncthreads();
            if (tid < 256) hist[tid] = 0u;
            __syncthreads();
#pragma unroll
            for (int i = 0; i < 16; ++i) if ((k[i] & mask) == prefix) atomicAdd((unsigned*)&hist[(k[i] >> shift) & 255u], 1u);
            __syncthreads();
            if (wave == 0) {
                unsigned c[4]; unsigned tot = 0u;
#pragma unroll
                for (int q = 0; q < 4; ++q) { c[q] = hist[255 - 4 * lane - q]; tot += c[q]; }
                unsigned inc = tot;
#pragma unroll
                for (int o = 1; o < 64; o <<= 1) { const unsigned t = __shfl_up(inc, o); if (lane >= o) inc += t; }
                const unsigned exc = inc - tot;
                if (exc < remaining && remaining <= inc) { unsigned cum = exc, rem = 0u; int bin = 0; bool found = false;
#pragma unroll
                    for (int q = 0; q < 4; ++q) { if (!found && cum + c[q] >= remaining) { bin = 255 - 4 * lane - q; rem = remaining - cum; found = true; } cum += c[q]; }
                    sel[0] = (unsigned)bin; sel[1] = rem; }
            }
            __syncthreads();
            prefix |= sel[0] << shift; mask |= 255u << shift; remaining = sel[1];
        }
        int cgt = 0, ceq = 0;
#pragma unroll
        for (int i = 0; i < 16; ++i) { cgt += (k[i] > prefix) ? 1 : 0; ceq += (k[i] == prefix) ? 1 : 0; }
        int toteq; const int eq0 = block_excl_scan(ceq, sc, tid, lane, wave, toteq);
        int nsel = cgt; { int rk = eq0;
#pragma unroll
            for (int i = 0; i < 16; ++i) if (k[i] == prefix) { if ((unsigned)rk < remaining) ++nsel; ++rk; } }
        int totsel; int pos = block_excl_scan(nsel, sc, tid, lane, wave, totsel);
        int rk = eq0;
#pragma unroll
        for (int i = 0; i < 16; ++i) {
            const int stok = tid * 16 + i; bool take = k[i] > prefix;
            if (k[i] == prefix) { take = (unsigned)rk < remaining; ++rk; }
            int slot = -1;
            if (take) { slot = pos; TOPI[g * CAP + pos] = stok; TOPG[g * CAP + pos] = __uint_as_float(k[i]); ++pos; }
            TSLOT[((size_t)b * SEQ + stok) * NE + e] = slot;
        }
    }
    __syncthreads();
}
__device__ __forceinline__ void p8_gather(Frame& F) {
    const int gw = F.vcu * NWAVES + F.wave, NGW = F.G * NWAVES, lane = F.lane;
    const unsigned char* XF8 = F.ws + WS_XN; unsigned char* XG = F.ws + WS_XG; const int* TOPI = (const int*)(F.ws + WS_TOPI);
    for (int r = gw; r < MR; r += NGW) {
        const int b = r >> 14; const int tok = TOPI[r];
        const GAS v4u* src = (const GAS v4u*)(XF8 + ((size_t)b * SEQ + tok) * DM) + lane; GAS v4u* dst = (GAS v4u*)(XG + (size_t)r * DM) + lane;
        dst[0] = src[0];
    }
}
__device__ __forceinline__ void p11_final(Frame& F, bool poison) {
    const int gw = F.vcu * NWAVES + F.wave, NGW = F.G * NWAVES, lane = F.lane;
    const unsigned char* Y = F.ws + WS_Y; const int* TSLOT = (const int*)(F.ws + WS_TSLOT);
    f32x4 gg[4];
#pragma unroll
    for (int j = 0; j < 4; ++j) gg[j] = ((const GAS f32x4*)inptr(F, IN_NORMF_G))[lane + 64 * j];
    const float qnan = __builtin_nanf("");
    unsigned long long xw[4] = {0ull, 0ull, 0ull, 0ull}; int slotw = -1;
    if (gw < M) { const GAS unsigned long long* xb = (const GAS unsigned long long*)((const bf16*)(F.ws + WS_XB) + (size_t)gw * DM) + lane;
#pragma unroll
        for (int j = 0; j < 4; ++j) xw[j] = xb[64 * j];
        slotw = TSLOT[(size_t)gw * NE + (lane & 15)]; }
    for (int m = gw; m < M; m += NGW) {
        GAS f32x4* xr = (GAS f32x4*)(F.out + (size_t)m * DM) + lane;
        f32x4 v[4];
#pragma unroll
        for (int j = 0; j < 4; ++j) { const unsigned lo = (unsigned)xw[j], hi = (unsigned)(xw[j] >> 32);
            v[j] = (f32x4){__uint_as_float(lo << 16), __uint_as_float(lo & 0xffff0000u), __uint_as_float(hi << 16), __uint_as_float(hi & 0xffff0000u)}; }
        const int b = m >> 13; const int myslot = slotw;
        if (m + NGW < M) { const GAS unsigned long long* xb = (const GAS unsigned long long*)((const bf16*)(F.ws + WS_XB) + (size_t)(m + NGW) * DM) + lane;
#pragma unroll
            for (int j = 0; j < 4; ++j) xw[j] = xb[64 * j];
            slotw = TSLOT[(size_t)(m + NGW) * NE + (lane & 15)]; }
        unsigned msk = (unsigned)(__builtin_amdgcn_ballot_w64(myslot >= 0 && lane < 16) & 0xffffull);
#pragma unroll 1
        while (msk) {
            const int e0 = __builtin_ctz(msk); msk &= msk - 1u; const bool two = msk != 0u; const int e1 = two ? __builtin_ctz(msk) : e0; if (two) msk &= msk - 1u;
            const int s0 = __builtin_amdgcn_readlane(myslot, e0), s1 = __builtin_amdgcn_readlane(myslot, e1);
            const GAS int* y0 = (const GAS int*)(Y + ((size_t)(b * NE + e0) * CAP + s0) * DM) + lane; const GAS int* y1 = (const GAS int*)(Y + ((size_t)(b * NE + e1) * CAP + s1) * DM) + lane;
            int w0[4], w1[4];
#pragma unroll
            for (int j = 0; j < 4; ++j) { w0[j] = y0[64 * j]; w1[j] = y1[64 * j]; }
            typedef float f32x2v __attribute__((ext_vector_type(2)));
#pragma unroll
            for (int j = 0; j < 4; ++j) { const f32x2v lo = __builtin_amdgcn_cvt_pk_f32_fp8(w0[j], false), hi = __builtin_amdgcn_cvt_pk_f32_fp8(w0[j], true);
                v[j].x += lo.x * (1.0f / pg8::Y_SCALE); v[j].y += lo.y * (1.0f / pg8::Y_SCALE); v[j].z += hi.x * (1.0f / pg8::Y_SCALE); v[j].w += hi.y * (1.0f / pg8::Y_SCALE); }
            if (two) {
#pragma unroll
                for (int j = 0; j < 4; ++j) { const f32x2v lo = __builtin_amdgcn_cvt_pk_f32_fp8(w1[j], false), hi = __builtin_amdgcn_cvt_pk_f32_fp8(w1[j], true);
                    v[j].x += lo.x * (1.0f / pg8::Y_SCALE); v[j].y += lo.y * (1.0f / pg8::Y_SCALE); v[j].z += hi.x * (1.0f / pg8::Y_SCALE); v[j].w += hi.y * (1.0f / pg8::Y_SCALE); } }
        }
        float s2 = 0.f;
#pragma unroll
        for (int j = 0; j < 4; ++j) s2 += (v[j].x * v[j].x + v[j].y * v[j].y) + (v[j].z * v[j].z + v[j].w * v[j].w);
        const float rs = 1.0f / sqrtf(wave_sum(s2) * (1.f / DM) + NORM_EPS);
#pragma unroll
        for (int j = 0; j < 4; ++j) { f32x4 o = v[j] * rs * gg[j]; if (poison) o = (f32x4){qnan, qnan, qnan, qnan}; xr[64 * j] = o; }
    }
}

struct Args { const float* in[15]; float* out; unsigned char* ws; int ph_lo, ph_hi; };
__global__ void __launch_bounds__(NWAVES * 64, 2) hyb_fwd(Args args) {
    extern __shared__ __attribute__((aligned(16))) unsigned char lds[];
    Frame F;
    F.lds = (LAS unsigned char*)lds;
    F.MISC = (volatile LAS unsigned*)(F.lds + MISC_OFF);
    F.tid = threadIdx.x; F.lane = F.tid & 63; F.wave = __builtin_amdgcn_readfirstlane(F.tid >> 6);
    F.G = gridDim.x; { const int bx = blockIdx.x; F.vcu = (F.G % 8 == 0) ? (bx % 8) * (F.G / 8) + bx / 8 : bx; }
    F.ws = args.ws; F.ctl = (gu32*)(args.ws + WS_CTL); F.out = args.out;
    for (int u = F.tid; u < (LDS_BYTES - LDSCTL_OFF) / 4; u += NWAVES * 64) ((LAS unsigned*)(F.lds + LDSCTL_OFF))[u] = 0u;
    __syncthreads();
    if (F.tid == 0) { LAS unsigned long long* pt = (LAS unsigned long long*)(F.lds + LDSCTL_OFF + 64);
#pragma unroll
        for (int k = 0; k < 15; ++k) pt[k] = (unsigned long long)args.in[k]; }
    __syncthreads();
    XcdBarrier bar; bar.bar = (unsigned*)(F.ctl + CW_BAR); bar.x = 0; bar.st = nullptr;
    if (N_LAUNCHES == 1) bar = xcd_barrier_post((unsigned*)(F.ctl + CW_BAR), F.MISC + 8);
#define GRID_BAR() do { if (N_LAUNCHES == 1) { xcd_barrier(bar); } } while (0)
    const int lo = args.ph_lo, hi = args.ph_hi;
#ifndef PH_MASK
#define PH_MASK 0xFFF
#endif
#define IN(k) (((PH_MASK >> (k)) & 1) && lo <= (k) && (k) < hi)
#define BOTH(k) (IN(k) && IN((k) + 1))
#ifndef DUP_MASK
#define DUP_MASK 0
#endif
#define REP(k) _Pragma("unroll 1") for (int rep_ = 0; rep_ < (((DUP_MASK >> (k)) & 1) ? 2 : 1); ++rep_)
    unsigned char* ws = args.ws;
    pg8::bf16_t* XN = (pg8::bf16_t*)(ws + WS_XN);

    if (IN(0)) { REP(0) { p0_prologue(F); } if (BOTH(0)) GRID_BAR(); }

    if (IN(1)) {
        pg8::Gemm g{XN, (const pg8::bf16_t*)(ws + WS_WIN), GEMM1_FP8 ? DM / 2 : DM, GEMM1_FP8 ? DM / 2 : DM, GEMM1_FP8 ? DM / 2 : DM, nullptr}; pg8::StaticOrder S; S.init(M, N_IN, F.G, (int)blockIdx.x, GEMM1_WGM);
        pg8::EpiZ E{(pg8::bf16_t*)(ws + WS_QA), (pg8::bf16_t*)(ws + WS_KVA), (pg8::bf16_t*)(ws + WS_QB), (pg8::bf16_t*)(ws + WS_KB), (pg8::bf16_t*)(ws + WS_VB), (pg8::bf16_t*)(ws + WS_G), inptr(F, IN_B_GATES), GEMM1_FP8 ? pg8::F8_DEQ : 1.0f};
        REP(1) { pg8::gemm_phase<pg8::EpiZ, pg8::StaticOrder, true, true, GEMM1_FP8 != 0>(F.lds + RING_OFF, g, S, E); }
        if ((DUP_MASK >> 14) & 1) { pg8::EpiNull EN; pg8::gemm_phase<pg8::EpiNull, pg8::StaticOrder, true, true, GEMM1_FP8 != 0>(F.lds + RING_OFF, g, S, EN); }
        if (BOTH(1)) GRID_BAR();
    }
    if (IN(2)) { p2_qknorm_rope(F); if (BOTH(2)) GRID_BAR(); }

    if (IN(3)) {
        static_assert(attn_body::ATTN_LDS_BYTES <= RING_BYTES, "attention body geometry vs frame");
        const attn_body::AttnTensors AT{(const attn_body::bf16*)(ws + WS_QA), (const attn_body::bf16*)(ws + WS_KVA), (const attn_body::bf16*)(ws + WS_KVA) + 128, (attn_body::bf16*)(ws + WS_OAB)};
        const attn_body::StaticOrder S((int)F.G, F.vcu);
        float cref; { const float* qg = inptr(F, IN_Q_NORM_G); const float* kg = inptr(F, IN_K_NORM_G); float mq = 0.f, mk = 0.f;
            for (int i = 0; i < 64; ++i) { mq = fmaxf(mq, fabsf(qg[i])); mk = fmaxf(mk, fabsf(kg[i])); }
            cref = 8.0f * mq * mk * 1.4426950408889634f * 1.02f + 0.05f; cref = __builtin_bit_cast(float, __builtin_amdgcn_readfirstlane(__builtin_bit_cast(int, cref))); }
#if ATTN_FP8
        { const float cref8 = fmaxf(0.f, cref - 15.5f); attn_body::AttnUnit u;
          REP(12) { if (cref8 == 0.f) { for (int i = 0; S.next(i, u); ++i) attn8::unit<0, true>(u.b, u.h, u.qb, ws + WS_Q8, ws + WS_K8, ws + WS_VT8, (attn_body::bf16*)(ws + WS_OAB), (char*)lds + RING_OFF, 0.f); }
                    else { for (int i = 0; S.next(i, u); ++i) attn8::unit<0, false>(u.b, u.h, u.qb, ws + WS_Q8, ws + WS_K8, ws + WS_VT8, (attn_body::bf16*)(ws + WS_OAB), (char*)lds + RING_OFF, cref8); } } }
#ifdef A8_PROBE_MODE
        { const float cref8 = fmaxf(0.f, cref - 15.5f); attn_body::AttnUnit u; attn_body::bf16* dummyO = (attn_body::bf16*)(ws + WS_QA);
          for (int i = 0; S.next(i, u); ++i) attn8::unit<A8_PROBE_MODE, true>(u.b, u.h, u.qb, ws + WS_Q8, ws + WS_K8, ws + WS_VT8, dummyO, (char*)lds + RING_OFF, cref8); }
#endif
#else
        REP(12) { attn_body::attn_phase<attn_body::StaticOrder>((char*)lds + RING_OFF, AT, S, cref); }
#endif
        __syncthreads();
        REP(13) {
            char* wl = (char*)lds + RING_OFF + F.wave * 16384; float* wsf = (float*)((char*)lds + WSF_OFF) + F.wave * 64;
            int lane2 = F.lane; asm volatile("" : "+v"(lane2));
#pragma unroll 1
            for (int L = F.vcu; L < BATCH * 4 * 16; L += F.G)
                attnb2::b2_unit(lane2, L >> 6, (L >> 4) & 3, L & 15, F.wave, (const attn_body::bf16*)(ws + WS_QB), (const attn_body::bf16*)(ws + WS_KB), (const attn_body::bf16*)(ws + WS_VB), (attn_body::bf16*)(ws + WS_OAB), (float*)(ws + WS_AFF), wl, wsf);
        }
#ifdef B2_PROBE_MODE
        { char* wl = (char*)lds + RING_OFF + F.wave * 16384; float* wsf = (float*)((char*)lds + WSF_OFF) + F.wave * 64; int lane2 = F.lane; asm volatile("" : "+v"(lane2));
          for (int L = F.vcu; L < BATCH * 4 * 16; L += F.G) attnb2::b2_unit<B2_PROBE_MODE>(lane2, L >> 6, (L >> 4) & 3, L & 15, F.wave, (const attn_body::bf16*)(ws + WS_QB), (const attn_body::bf16*)(ws + WS_KB), (const attn_body::bf16*)(ws + WS_VB), (attn_body::bf16*)(ws + WS_QA), (float*)(ws + WS_AFF + 2 * MiB), wl, wsf); }
#endif
        asm volatile("s_waitcnt vmcnt(0) lgkmcnt(0)" ::: "memory");
        __syncthreads();
        if (BOTH(3)) GRID_BAR();
    }
    if (IN(4)) {
        const pg8::bf16_t* OAB = (const pg8::bf16_t*)(ws + WS_OAB); const pg8::bf16_t* WO = (const pg8::bf16_t*)(ws + WS_WO); const pg8::bf16_t* Gt = (const pg8::bf16_t*)(ws + WS_G);
        pg8::StaticOrder S; S.init(M, DM, F.G, (int)blockIdx.x);
        REP(4) { pg8::Gemm g{OAB, WO, 768, 768, 768, nullptr}; pg8::EpiGateHook E{Gt, XN}; pg8::gemm_phase<pg8::EpiGateHook, pg8::StaticOrder, true, true>(F.lds + RING_OFF, g, S, E); }
        if (BOTH(4)) GRID_BAR();
    }
    if (IN(5)) {
        pg8::Gemm g{XN, (const pg8::bf16_t*)(ws + WS_WOUT), DM, DM, DM, nullptr}; pg8::StaticOrder S; S.init(M, DM, F.G, (int)blockIdx.x);
        pg8::EpiResBf16 E{inptr(F, IN_X), (pg8::bf16_t*)(ws + WS_XB)};
        REP(5) { pg8::gemm_phase<pg8::EpiResBf16, pg8::StaticOrder, true, true>(F.lds + RING_OFF, g, S, E); }
        if (BOTH(5)) GRID_BAR();
    }
    if (IN(6)) { REP(6) { p6_norm2_router(F); } if (BOTH(6)) GRID_BAR(); }
    if (IN(7)) { REP(7) { p7_topk(F); } if (BOTH(7)) GRID_BAR(); }
    if (IN(9)) {
        pg8::Gemm g{(const pg8::bf16_t*)(ws + WS_XN), (const pg8::bf16_t*)(ws + WS_WGU), DM / 2, DM / 2, DM / 2, (const int*)(ws + WS_TOPI)}; pg8::MoeOrderGU S{F.G, F.vcu};
        pg8::EpiSwiglu E{ws + WS_ACT};
        pg8::gemm_phase<pg8::EpiSwiglu, pg8::MoeOrderGU, true, true, true, true>(F.lds + RING_OFF, g, S, E);
        if ((DUP_MASK >> 9) & 1) { asm volatile("" ::: "memory"); pg8::gemm_phase<pg8::EpiSwiglu, pg8::MoeOrderGU, true, true, true, true>(F.lds + RING_OFF, g, S, E); }
        if ((DUP_MASK >> 18) & 1) { pg8::EpiSwigluT<false> E2{E.O}; pg8::gemm_phase<pg8::EpiSwigluT<false>, pg8::MoeOrderGU, true, true, true, true>(F.lds + RING_OFF, g, S, E2); }
        if ((DUP_MASK >> 15) & 1) { pg8::EpiNull EN; pg8::gemm_phase<pg8::EpiNull, pg8::MoeOrderGU, true, true, true, true>(F.lds + RING_OFF, g, S, EN); }
        if ((DUP_MASK >> 16) & 1) { pg8::EpiNull EN; pg8::gemm_phase<pg8::EpiNull, pg8::MoeOrderGU, true, true, false, true>(F.lds + RING_OFF, g, S, EN); }
        if (BOTH(9)) GRID_BAR();
    }
    if (IN(10)) {
        pg8::Gemm g{(const pg8::bf16_t*)(ws + WS_ACT), (const pg8::bf16_t*)(ws + WS_WD), FF / 2, FF / 2, FF / 2, nullptr}; pg8::MoeOrderDown S{F.G, F.vcu};
        pg8::EpiDown E{ws + WS_Y, (const float*)(ws + WS_TOPG)};
        pg8::gemm_phase<pg8::EpiDown, pg8::MoeOrderDown, true, true, true>(F.lds + RING_OFF, g, S, E);
        if ((DUP_MASK >> 10) & 1) { asm volatile("" ::: "memory"); pg8::gemm_phase<pg8::EpiDown, pg8::MoeOrderDown, true, true, true>(F.lds + RING_OFF, g, S, E); }
        if (BOTH(10)) GRID_BAR();
    }
    if (IN(11)) {
        bool poison = false;
        if (N_LAUNCHES == 1) poison = __hip_atomic_load((gu32*)((const unsigned*)(F.ctl + CW_BAR) + XB_TMO), RLX_AGENT) != 0u;
        p11_final(F, poison);
    }
#undef IN
#undef BOTH
#undef GRID_BAR
}

extern "C" void kernel_launch(void* const* d_in, const int* in_sizes, int n_in, void* d_out, int out_size, void* d_ws, size_t ws_size, hipStream_t stream) {
    static int grid = 0;
    if (grid == 0) {
        if (n_in != 15 || in_sizes[0] != M * DM || out_size != M * DM || ws_size < WS_END) { fprintf(stderr, "kernel_launch: unexpected shapes / workspace (n_in %d, in0 %d, out %d, ws %zu < %zu); nothing launched\n", n_in, n_in > 0 ? in_sizes[0] : -1, out_size, ws_size, (size_t)WS_END); grid = -1; return; }
        int dev = 0, cus = 0, per_cu = 0;
        if (hipGetDevice(&dev) != hipSuccess || hipDeviceGetAttribute(&cus, hipDeviceAttributeMultiprocessorCount, dev) != hipSuccess) { grid = -1; return; }
        if (hipFuncSetAttribute((const void*)hyb_fwd, hipFuncAttributeMaxDynamicSharedMemorySize, LDS_BYTES) != hipSuccess) { fprintf(stderr, "kernel_launch: hipFuncSetAttribute failed\n"); grid = -1; return; }
        if (hipOccupancyMaxActiveBlocksPerMultiprocessor(&per_cu, (const void*)hyb_fwd, NWAVES * 64, LDS_BYTES) != hipSuccess || per_cu < 1) { fprintf(stderr, "kernel_launch: occupancy query reports %d workgroups per CU\n", per_cu); }
        (void)hipGetLastError();
        grid = cus;
    }
    if (grid < 0) return;
    if (hipMemsetAsync((char*)d_ws + WS_CTL, 0, CTL_ZERO_BYTES, stream) != hipSuccess) return;
    Args a{};
    for (int i = 0; i < 15; ++i) a.in[i] = (const float*)d_in[i];
    a.out = (float*)d_out; a.ws = (unsigned char*)d_ws;
    for (int li = 0; li < N_LAUNCHES; ++li) {
        a.ph_lo = (N_LAUNCHES == 1) ? 0 : li; a.ph_hi = (N_LAUNCHES == 1) ? N_PHASES : li + 1;
        hipLaunchKernelGGL(hyb_fwd, dim3(grid), dim3(NWAVES * 64), LDS_BYTES, stream, a);
        if (hipPeekAtLastError() != hipSuccess) { fprintf(stderr, "kernel_launch: launch %d failed\n", li); break; }
    }
}
```

```cpp
#include <hip/hip_runtime.h>
#include <cstdio>
#include <cstdint>
namespace pg8 {
#define PG8_LAS __attribute__((address_space(3)))
typedef unsigned short bf16_t;
typedef short bf16x8 __attribute__((ext_vector_type(8)));
typedef float f32x4 __attribute__((ext_vector_type(4)));
typedef unsigned u32x4 __attribute__((ext_vector_type(4)));
constexpr int BM = 256, BK = 64, HALF = 128, HTB = HALF * BK * 2  , STAGE_BYTES = 8 * HTB, NXCD = 8, WGM = 8;

__host__ __device__ __forceinline__ int lds_byte(int r, int c) { const int st = (r >> 4) * 2 + (c >> 5), rr = r & 15, cc = c & 31, ob = rr * 64 + cc * 2; return st * 1024 + (ob ^ (((ob >> 9) & 1) << 5)); }
__host__ __device__ __forceinline__ void stage_rc(int b, int& R, int& C) { const int st = b / 1024, sb = b % 1024, swz = sb ^ (((sb >> 9) & 1) << 5); R = (st >> 1) * 16 + swz / 64; C = (st & 1) * 32 + (swz % 64) / 2; }
__host__ __device__ __forceinline__ int perm32(int rho) { const int n = rho >> 4, i = rho & 15; return 8 * (i >> 2) + 4 * n + (i & 3); }

struct Unit { int pm, pn, pb; };
struct Gemm { const bf16_t* A; const bf16_t* Bt; int K, lda, ldb; const int* gidx; };

struct StaticOrder {
    int nM, nN, nwg, G, c, wgm;
    __host__ __device__ void init(int M, int N, int G_, int c_, int wgm_ = WGM) { nM = M / BM; nN = N / BM; nwg = nM * nN; G = G_; c = c_; wgm = wgm_; }
    __host__ __device__ bool next(int i, Unit& u) const {
        const long L = (long)i * G + c; if (L >= nwg) return false;
        int wgid = (int)L; { const int q = nwg / NXCD, r = nwg % NXCD, xcd = wgid % NXCD, off = wgid / NXCD; wgid = (xcd < r ? xcd * (q + 1) : r * (q + 1) + (xcd - r) * q) + off; }
        const int nig = wgm * nN, gid = wgid / nig, fm = gid * wgm, gsz = (nM - fm) < wgm ? (nM - fm) : wgm;
        u.pm = fm + ((wgid % nig) % gsz); u.pn = (wgid % nig) / gsz; u.pb = u.pn; return true;
    }
    __device__ __forceinline__ void a_ready(const Unit&) const {}
    __device__ __forceinline__ void done(const Unit&) const {}
};
struct MoeOrderGU {
    int G, vcu;
    __device__ __forceinline__ bool next(int i, Unit& u) const {
        const int L = i * G + vcu; if (L >= 4096) return false;
        const int rnd = L >> 8, x = (L >> 5) & 7, w = L & 31; const int e = 2 * x + (rnd >> 3), b = rnd & 7, g = b * 16 + e;
        u.pm = g * 4 + (w & 3); u.pn = w >> 2; u.pb = e * 8 + u.pn; return true; }
    __device__ __forceinline__ void a_ready(const Unit&) const {}
    __device__ __forceinline__ void done(const Unit&) const {}
};
struct MoeOrderDown {
    int G, vcu;
    __device__ __forceinline__ bool next(int i, Unit& u) const {
        const int L = i * G + vcu; if (L >= 2048) return false;
        const int rnd = L >> 8, x = (L >> 5) & 7, w = L & 31; const int jj = 2 * rnd + (w >> 4), w16 = w & 15; const int e = 2 * x + (jj >> 3), b = jj & 7, g = b * 16 + e;
        u.pm = g * 4 + (w16 & 3); u.pn = w16 >> 2; u.pb = e * 4 + u.pn; return true; }
    __device__ __forceinline__ void a_ready(const Unit&) const {}
    __device__ __forceinline__ void done(const Unit&) const {}
};

__device__ __forceinline__ unsigned cvt_pk_bf16(float lo, float hi) { unsigned r; asm volatile("v_cvt_pk_bf16_f32 %0, %1, %2" : "=v"(r) : "v"(lo), "v"(hi)); return r; }
__device__ __forceinline__ float bf_lo(unsigned w) { return __uint_as_float(w << 16); }
__device__ __forceinline__ float bf_hi(unsigned w) { return __uint_as_float(w & 0xffff0000u); }
__device__ __forceinline__ float sigmoidf_fast(float v) { return __builtin_amdgcn_rcpf(1.0f + __builtin_amdgcn_exp2f(-1.4426950408889634f * v)); }
constexpr float QSCALE = 0.125f * 1.4426950408889634f;

typedef int i32x8 __attribute__((ext_vector_type(8)));
typedef int i32x4 __attribute__((ext_vector_type(4)));
__device__ __forceinline__ i32x8 cat8(bf16x8 lo, bf16x8 hi) { return __builtin_shufflevector(__builtin_bit_cast(i32x4, lo), __builtin_bit_cast(i32x4, hi), 0, 1, 2, 3, 4, 5, 6, 7); }
__device__ __forceinline__ unsigned pk4_fp8(float a, float b, float c, float d) {
    a = __builtin_amdgcn_fmed3f(a, -448.f, 448.f); b = __builtin_amdgcn_fmed3f(b, -448.f, 448.f); c = __builtin_amdgcn_fmed3f(c, -448.f, 448.f); d = __builtin_amdgcn_fmed3f(d, -448.f, 448.f);
    int w = __builtin_amdgcn_cvt_pk_fp8_f32(a, b, 0, false); w = __builtin_amdgcn_cvt_pk_fp8_f32(c, d, w, true); return (unsigned)w; }
constexpr float Y_SCALE = 64.0f;
constexpr float F8_ACT_SCALE = 8.0f, F8_W_SCALE = 64.0f, F8_DEQ = 1.0f / (F8_ACT_SCALE * F8_W_SCALE);
struct EpiZ {
    static constexpr bool PERM = true, AFTER_DRAIN = false;
    bf16_t *QA, *KVA, *QB, *KB, *VB, *G; const float* bg; float deq;
    __device__ __forceinline__ void operator()(const f32x4 (&acc)[2][2][4][2], const Unit& u, int wr, int wc, int fr, int fq) const {
        const int pn = u.pn; int ldc, colt; float sc = deq; const bool gate = pn >= 12;
        long boff;
        if (pn < 2) { boff = 0; ldc = 512; colt = pn * 256; }
        else if (pn == 2) { boff = KVA - QA; ldc = 256; colt = 0; }
        else if (pn < 6) { boff = QB - QA; ldc = 768; colt = (pn - 3) * 256; sc = QSCALE * deq; }
        else if (pn < 9) { boff = KB - QA; ldc = 768; colt = (pn - 6) * 256; }
        else { boff = VB - QA; ldc = 768; colt = (pn - 9) * 256; }
        bf16_t* base = QA + boff;
        const int row0 = u.pm * BM + wr * 64 + fr, col0 = colt + wc * 32 + 8 * fq;
        if (gate) {
            const int gcol = (pn - 12) * HALF + wc * 32 + 8 * fq; const float k2 = sc * -1.4426950408889634f;
            f32x4 ba[2], bb[2];
#pragma unroll
            for (int n = 0; n < 2; ++n) { ba[n] = *(const f32x4*)(bg + gcol + 4 * n) * (-1.4426950408889634f); bb[n] = *(const f32x4*)(bg + 1024 + gcol + 4 * n) * (-1.4426950408889634f); }
#pragma unroll
            for (int ai = 0; ai < 2; ++ai)
#pragma unroll
                for (int m = 0; m < 4; ++m) { bf16_t* rowp = G + (size_t)(row0 + ai * HALF + m * 16) * 2048 + gcol;
                    f32x4 rr[2], gb[2];
#pragma unroll
                    for (int n = 0; n < 2; ++n) { f32x4 ea = acc[ai][0][m][n] * k2 + ba[n], eb = acc[ai][1][m][n] * k2 + bb[n];
#pragma unroll
                        for (int q = 0; q < 4; ++q) { ea[q] = __builtin_amdgcn_exp2f(ea[q]); eb[q] = __builtin_amdgcn_exp2f(eb[q]); }
                        ea = ea + 1.0f; eb = eb + 1.0f;
#pragma unroll
                        for (int q = 0; q < 4; ++q) { ea[q] = __builtin_amdgcn_rcpf(ea[q]); gb[n][q] = __builtin_amdgcn_rcpf(eb[q]); }
                        rr[n] = ea * eb; }
                    u32x4 w; w.x = cvt_pk_bf16(rr[0][0], rr[0][1]); w.y = cvt_pk_bf16(rr[0][2], rr[0][3]); w.z = cvt_pk_bf16(rr[1][0], rr[1][1]); w.w = cvt_pk_bf16(rr[1][2], rr[1][3]);
                    *(u32x4*)rowp = w;
                    unsigned b0 = 0u, b1 = 0u;
#pragma unroll
                    for (int q = 0; q < 4; ++q) { b0 = __builtin_amdgcn_cvt_pk_u8_f32(fmaxf(gb[0][q] * 255.0f, 1.0f), q, b0); b1 = __builtin_amdgcn_cvt_pk_u8_f32(fmaxf(gb[1][q] * 255.0f, 1.0f), q, b1); }
                    typedef unsigned u32x2_ __attribute__((ext_vector_type(2)));
                    *(u32x2_*)((unsigned char*)rowp + 2048 - gcol) = (u32x2_){b0, b1}; }
            return; }
#pragma unroll
        for (int ai = 0; ai < 2; ++ai)
#pragma unroll
            for (int m = 0; m < 4; ++m) { bf16_t* rowp = base + (size_t)(row0 + ai * HALF + m * 16) * ldc + col0;
#pragma unroll
                for (int bj = 0; bj < 2; ++bj) { const f32x4 v0 = acc[ai][bj][m][0] * sc, v1 = acc[ai][bj][m][1] * sc;
                    u32x4 w; w.x = cvt_pk_bf16(v0[0], v0[1]); w.y = cvt_pk_bf16(v0[2], v0[3]); w.z = cvt_pk_bf16(v1[0], v1[1]); w.w = cvt_pk_bf16(v1[2], v1[3]);
                    *(u32x4*)(rowp + bj * HALF) = w; } }
    }
};
struct EpiNull {
    static constexpr bool PERM = true, AFTER_DRAIN = false;
    __device__ __forceinline__ void operator()(const f32x4 (&acc)[2][2][4][2], const Unit&, int, int, int, int) const {
#pragma unroll
        for (int a = 0; a < 2; ++a)
#pragma unroll
            for (int b = 0; b < 2; ++b)
#pragma unroll
                for (int m = 0; m < 4; ++m)
#pragma unroll
                    for (int n = 0; n < 2; ++n) asm volatile("" :: "v"(acc[a][b][m][n]));
    }
};
template <bool ADD> struct EpiGate {
    static constexpr bool PERM = true, AFTER_DRAIN = false;
    const bf16_t* Gt; bf16_t* O;
    __device__ __forceinline__ void operator()(const f32x4 (&acc)[2][2][4][2], const Unit& u, int wr, int wc, int fr, int fq) const {
        const int row0 = u.pm * BM + wr * 64 + fr, col0 = u.pn * BM + wc * 32 + 8 * fq;
#pragma unroll
        for (int ai = 0; ai < 2; ++ai)
#pragma unroll
            for (int m = 0; m < 4; ++m) { const size_t row = (size_t)(row0 + ai * HALF + m * 16);
#pragma unroll
                for (int bj = 0; bj < 2; ++bj) { const u32x4 gw = *(const u32x4*)(Gt + row * 2048 + col0 + bj * HALF); bf16_t* op = O + row * 1024 + col0 + bj * HALF;
                    f32x4 v0 = acc[ai][bj][m][0], v1 = acc[ai][bj][m][1];
                    v0[0] *= bf_lo(gw.x); v0[1] *= bf_hi(gw.x); v0[2] *= bf_lo(gw.y); v0[3] *= bf_hi(gw.y); v1[0] *= bf_lo(gw.z); v1[1] *= bf_hi(gw.z); v1[2] *= bf_lo(gw.w); v1[3] *= bf_hi(gw.w);
                    if (ADD) { const u32x4 t = *(const u32x4*)op; v0[0] += bf_lo(t.x); v0[1] += bf_hi(t.x); v0[2] += bf_lo(t.y); v0[3] += bf_hi(t.y); v1[0] += bf_lo(t.z); v1[1] += bf_hi(t.z); v1[2] += bf_lo(t.w); v1[3] += bf_hi(t.w); }
                    u32x4 w; w.x = cvt_pk_bf16(v0[0], v0[1]); w.y = cvt_pk_bf16(v0[2], v0[3]); w.z = cvt_pk_bf16(v1[0], v1[1]); w.w = cvt_pk_bf16(v1[2], v1[3]);
                    *(u32x4*)op = w; } }
    }
};
struct EpiGateHook {
    static constexpr bool PERM = true, AFTER_DRAIN = false, HAS_MID = true; static constexpr int MID_KT = 8;
    const bf16_t* Gt; bf16_t* O;
    __device__ __forceinline__ void mid(f32x4 (&acc)[2][2][4][2], const Unit& u, int wr, int wc, int fr, int fq) const {
        const int row0 = u.pm * BM + wr * 64 + fr, col0 = u.pn * BM + wc * 32 + 8 * fq;
#pragma unroll
        for (int ai = 0; ai < 2; ++ai)
#pragma unroll
            for (int m = 0; m < 4; ++m) { const size_t row = (size_t)(row0 + ai * HALF + m * 16);
#pragma unroll
                for (int bj = 0; bj < 2; ++bj) { const u32x4 ga = *(const u32x4*)(Gt + row * 2048 + col0 + bj * HALF);
                    f32x4& v0 = acc[ai][bj][m][0]; f32x4& v1 = acc[ai][bj][m][1];
                    v0[0] *= bf_lo(ga.x); v0[1] *= bf_hi(ga.x); v0[2] *= bf_lo(ga.y); v0[3] *= bf_hi(ga.y); v1[0] *= bf_lo(ga.z); v1[1] *= bf_hi(ga.z); v1[2] *= bf_lo(ga.w); v1[3] *= bf_hi(ga.w); }
                if (m & 1) asm volatile("" ::: "memory"); }
    }
    __device__ __forceinline__ void operator()(const f32x4 (&acc)[2][2][4][2], const Unit& u, int wr, int wc, int fr, int fq) const {
        int row0 = u.pm * BM + wr * 64 + fr; const int col0 = u.pn * BM + wc * 32 + 8 * fq;
        asm volatile("" : "+v"(row0));
#pragma unroll
        for (int ai = 0; ai < 2; ++ai)
#pragma unroll
            for (int m = 0; m < 4; ++m) { const size_t row = (size_t)(row0 + ai * HALF + m * 16);
#pragma unroll
                for (int bj = 0; bj < 2; ++bj) { typedef unsigned u32x2_ __attribute__((ext_vector_type(2)));
                    const u32x2_ gw = *(const u32x2_*)((const unsigned char*)(Gt + row * 2048 + 1024) + col0 + bj * HALF); bf16_t* op = O + row * 1024 + col0 + bj * HALF;
                    f32x4 v0 = acc[ai][bj][m][0] * (1.0f / 255.0f), v1 = acc[ai][bj][m][1] * (1.0f / 255.0f);
                    v0[0] *= (float)((gw.x >> 0) & 0xffu); v0[1] *= (float)((gw.x >> 8) & 0xffu); v0[2] *= (float)((gw.x >> 16) & 0xffu); v0[3] *= (float)((gw.x >> 24) & 0xffu);
                    v1[0] *= (float)((gw.y >> 0) & 0xffu); v1[1] *= (float)((gw.y >> 8) & 0xffu); v1[2] *= (float)((gw.y >> 16) & 0xffu); v1[3] *= (float)((gw.y >> 24) & 0xffu);
                    u32x4 w; w.x = cvt_pk_bf16(v0[0], v0[1]); w.y = cvt_pk_bf16(v0[2], v0[3]); w.z = cvt_pk_bf16(v1[0], v1[1]); w.w = cvt_pk_bf16(v1[2], v1[3]);
                    *(u32x4*)op = w; } }
    }
};
template <class E, class = void> struct epi_has_mid { static constexpr bool value = false; };
template <class E> struct epi_has_mid<E, decltype((void)E::HAS_MID)> { static constexpr bool value = E::HAS_MID; };
struct EpiResF32 {
    static constexpr bool PERM = false, AFTER_DRAIN = false;
    const float* base; float* out;
    __device__ __forceinline__ void operator()(const f32x4 (&acc)[2][2][4][2], const Unit& u, int wr, int wc, int fr, int fq) const {
        const int row0 = u.pm * BM + wr * 64 + fr, col0 = u.pn * BM + wc * 32 + 4 * fq;
#pragma unroll
        for (int ai = 0; ai < 2; ++ai)
#pragma unroll
            for (int m = 0; m < 4; ++m) { const size_t off = (size_t)(row0 + ai * HALF + m * 16) * 1024 + col0;
#pragma unroll
                for (int bj = 0; bj < 2; ++bj)
#pragma unroll
                    for (int n = 0; n < 2; ++n) { const f32x4 bs = *(const f32x4*)(base + off + bj * HALF + n * 16); *(f32x4*)(out + off + bj * HALF + n * 16) = bs + acc[ai][bj][m][n]; }
                if (m & 1) asm volatile("" ::: "memory"); }
    }
};
struct EpiResBf16 {
    static constexpr bool PERM = true, AFTER_DRAIN = false;
    const float* base; bf16_t* out;
    __device__ __forceinline__ void operator()(const f32x4 (&acc)[2][2][4][2], const Unit& u, int wr, int wc, int fr, int fq) const {
        const int row0 = u.pm * BM + wr * 64 + fr, col0 = u.pn * BM + wc * 32 + 8 * fq;
#pragma unroll
        for (int ai = 0; ai < 2; ++ai)
#pragma unroll
            for (int m = 0; m < 4; ++m) { const size_t off = (size_t)(row0 + ai * HALF + m * 16) * 1024 + col0;
#pragma unroll
                for (int bj = 0; bj < 2; ++bj) { const f32x4 x0 = *(const f32x4*)(base + off + bj * HALF), x1 = *(const f32x4*)(base + off + bj * HALF + 4);
                    const f32x4 v0 = acc[ai][bj][m][0] + x0, v1 = acc[ai][bj][m][1] + x1;
                    u32x4 w; w.x = cvt_pk_bf16(v0[0], v0[1]); w.y = cvt_pk_bf16(v0[2], v0[3]); w.z = cvt_pk_bf16(v1[0], v1[1]); w.w = cvt_pk_bf16(v1[2], v1[3]);
                    *(u32x4*)(out + off + bj * HALF) = w; }
                if (m == 3) asm volatile("" ::: "memory"); }
    }
};
template <bool STORE = true> struct EpiSwigluT {
    static constexpr bool PERM = true, AFTER_DRAIN = false;
    unsigned char* O;
    __device__ __forceinline__ void operator()(const f32x4 (&acc)[2][2][4][2], const Unit& u, int wr, int wc, int fr, int fq) const {
        const int row0 = u.pm * BM + wr * 64 + fr, col0 = u.pn * HALF + wc * 32 + 8 * fq;
#pragma unroll
        for (int ai = 0; ai < 2; ++ai)
#pragma unroll
            for (int m = 0; m < 4; ++m) { unsigned char* op = O + (size_t)(row0 + ai * HALF + m * 16) * 1024 + col0;
                typedef float f32x2 __attribute__((ext_vector_type(2)));
                f32x4 h0, h1;
#pragma unroll
                for (int n = 0; n < 2; ++n)
#pragma unroll
                    for (int q = 0; q < 4; q += 2) { const f32x2 gv = {acc[ai][0][m][n][q], acc[ai][0][m][n][q + 1]}, uv = {acc[ai][1][m][n][q], acc[ai][1][m][n][q + 1]};
                        const f32x2 ea = gv * (-1.4426950408889634f * F8_DEQ); f32x2 ex; ex.x = __builtin_amdgcn_exp2f(ea.x); ex.y = __builtin_amdgcn_exp2f(ea.y);
                        const f32x2 dn = ex + 1.0f; f32x2 rc; rc.x = __builtin_amdgcn_rcpf(dn.x); rc.y = __builtin_amdgcn_rcpf(dn.y);
                        const f32x2 hv = (gv * uv) * (rc * (F8_DEQ * F8_DEQ * F8_ACT_SCALE));
                        if (n == 0) { h0[q] = hv.x; h0[q + 1] = hv.y; } else { h1[q] = hv.x; h1[q + 1] = hv.y; } }
                typedef unsigned u32x2 __attribute__((ext_vector_type(2)));
                u32x2 w; w.x = pk4_fp8(h0[0], h0[1], h0[2], h0[3]); w.y = pk4_fp8(h1[0], h1[1], h1[2], h1[3]);
                if (STORE) *(u32x2*)op = w; else asm volatile("" :: "v"(w)); }
    }
};
typedef EpiSwigluT<true> EpiSwiglu;
struct EpiDown {
    static constexpr bool PERM = true, AFTER_DRAIN = false;
    unsigned char* O; const float* gv;
    __device__ __forceinline__ void operator()(const f32x4 (&acc)[2][2][4][2], const Unit& u, int wr, int wc, int fr, int fq) const {
        const int row0 = u.pm * BM + wr * 64 + fr, col0 = u.pn * BM + wc * 32 + 8 * fq;
        typedef unsigned u32x2 __attribute__((ext_vector_type(2)));
#pragma unroll
        for (int ai = 0; ai < 2; ++ai)
#pragma unroll
            for (int m = 0; m < 4; ++m) { const int row = row0 + ai * HALF + m * 16; const float gsc = gv[row] * (F8_DEQ * Y_SCALE); unsigned char* op = O + (size_t)row * 1024 + col0;
#pragma unroll
                for (int bj = 0; bj < 2; ++bj) { const f32x4 v0 = acc[ai][bj][m][0] * gsc, v1 = acc[ai][bj][m][1] * gsc;
                    u32x2 w; w.x = pk4_fp8(v0[0], v0[1], v0[2], v0[3]); w.y = pk4_fp8(v1[0], v1[1], v1[2], v1[3]);
                    *(u32x2*)(op + bj * HALF) = w; } }
    }
};

template <class Epi, class Sched, bool ALIGN_EPI = false, bool SP2 = false, bool FP8 = false, bool GATHER = false>
__device__ __forceinline__ void gemm_phase(PG8_LAS unsigned char* lds, const Gemm g, const Sched& S, const Epi& E) {
    const int tid = threadIdx.x, wid = __builtin_amdgcn_readfirstlane(tid >> 6), lane = tid & 63, wr = wid >> 2, wc = wid & 3, fr = lane & 15, fq = lane >> 4;
    const int K = g.K, nt = K / BK;
    unsigned voffA[2], voffB[2]; int rowA[2], colA2[2];
    static_assert(!GATHER || SP2, "the gathered-A path is written for the SP2 loop only");
#pragma unroll
    for (int i = 0; i < 2; ++i) { int R, C; stage_rc(tid * 16 + i * 8192, R, C); const int Rb = Epi::PERM ? ((R & ~31) + perm32(R & 31)) : R;
        voffA[i] = (unsigned)(R * g.lda + C) * 2u; voffB[i] = (unsigned)(Rb * g.ldb + C) * 2u; rowA[i] = R; colA2[i] = C * 2; }
    const size_t kstep = (size_t)(BK * 2);
    const size_t hstepA = (size_t)HALF * g.lda * 2, hstepB = (size_t)HALF * g.ldb * 2;
    const size_t tstepA = 2 * hstepA, tstepB = 2 * hstepB;
    const unsigned ldsw = (unsigned)wid * 1024u;
    const int aoff = lds_byte(wr * 64 + fr, fq * 8), boff = lds_byte(wc * 32 + fr, fq * 8);
#define PG8_SA(b, h) (((b) * 2 + (h)) * HTB)
#define PG8_SB(b, h) ((4 + (b) * 2 + (h)) * HTB)
#define PG8_STAGE(bufoff, gbase, voff) do { _Pragma("unroll") for (int _i = 0; _i < 2; ++_i) { unsigned vo_ = (voff)[_i]; asm volatile("" : "+v"(vo_));     \
        __builtin_amdgcn_global_load_lds((const unsigned*)((const char*)(gbase) + vo_), (PG8_LAS unsigned*)(lds + (bufoff) + ldsw + _i * 8192), 16, 0, 0); } } while (0)
#define PG8_LDA(dst, b, h) do { if constexpr (FP8) { _Pragma("unroll") for (int m = 0; m < 4; ++m) { const i32x4 lo_ = *(const PG8_LAS i32x4*)(lds + PG8_SA(b, h) + aoff + m * 2048), hi_ = *(const PG8_LAS i32x4*)(lds + PG8_SA(b, h) + aoff + m * 2048 + 1024); dst##8[m] = __builtin_shufflevector(lo_, hi_, 0, 1, 2, 3, 4, 5, 6, 7); } } \
        else { _Pragma("unroll") for (int m = 0; m < 4; ++m) _Pragma("unroll") for (int k = 0; k < 2; ++k) dst[m][k] = *(const PG8_LAS bf16x8*)(lds + PG8_SA(b, h) + aoff + m * 2048 + k * 1024); } } while (0)
#define PG8_LDB(dst, b, h) do { if constexpr (FP8) { _Pragma("unroll") for (int n = 0; n < 2; ++n) { const i32x4 lo_ = *(const PG8_LAS i32x4*)(lds + PG8_SB(b, h) + boff + n * 2048), hi_ = *(const PG8_LAS i32x4*)(lds + PG8_SB(b, h) + boff + n * 2048 + 1024); dst##8[n] = __builtin_shufflevector(lo_, hi_, 0, 1, 2, 3, 4, 5, 6, 7); } } \
        else { _Pragma("unroll") for (int n = 0; n < 2; ++n) _Pragma("unroll") for (int k = 0; k < 2; ++k) dst[n][k] = *(const PG8_LAS bf16x8*)(lds + PG8_SB(b, h) + boff + n * 2048 + k * 1024); } } while (0)
#define PG8_MMA(ai, bj, At, Bt) do { __builtin_amdgcn_s_setprio(1); _Pragma("unroll") for (int m = 0; m < 4; ++m) _Pragma("unroll") for (int n = 0; n < 2; ++n) { \
        if constexpr (FP8) { asm volatile("v_mfma_f32_16x16x128_f8f6f4 %0, %1, %2, %0" : "+v"(acc[ai][bj][m][n]) : "v"(Bt##8[n]), "v"(At##8[m])); }     \
        else { _Pragma("unroll") for (int k = 0; k < 2; ++k) acc[ai][bj][m][n] = __builtin_amdgcn_mfma_f32_16x16x32_bf16(Bt[n][k], At[m][k], acc[ai][bj][m][n], 0, 0, 0); } } \
        __builtin_amdgcn_s_setprio(0); } while (0)
#define PG8_WAIT_V(n) asm volatile("s_waitcnt vmcnt(" #n ")" ::: "memory")
#define PG8_WAIT_L(n) asm volatile("s_waitcnt lgkmcnt(" #n ")" ::: "memory")
#define PG8_BAR __builtin_amdgcn_s_barrier()
#define PG8_SCHED __builtin_amdgcn_sched_barrier(0)
    unsigned gcur[2][2] = {{0u, 0u}, {0u, 0u}}, gnxt[2][2] = {{0u, 0u}, {0u, 0u}}; int graw[2][2] = {{0, 0}, {0, 0}};
#define PG8_GIDX_ISSUE(U) do { _Pragma("unroll") for (int h_ = 0; h_ < 2; ++h_) _Pragma("unroll") for (int i_ = 0; i_ < 2; ++i_) { const unsigned bo_ = (unsigned)((U).pm * BM + h_ * HALF + rowA[i_]) * 4u; \
        asm volatile("global_load_dword %0, %1, %2" : "=v"(graw[h_][i_]) : "v"(bo_), "s"(g.gidx) : "memory"); } } while (0)
#define PG8_GIDX_CONV(dst, U) do { _Pragma("unroll") for (int h_ = 0; h_ < 2; ++h_) _Pragma("unroll") for (int i_ = 0; i_ < 2; ++i_) { asm volatile("" : "+v"(graw[h_][i_])); \
        dst[h_][i_] = (unsigned)(((U).pm >> 6) * 8192 + graw[h_][i_]) * (unsigned)(g.lda * 2) + (unsigned)colA2[i_]; } } while (0)
#define PG8_STAGE_A(bufoff, ptr, h, nx) do { if constexpr (GATHER) { PG8_STAGE(bufoff, ptr, ((nx) ? gsel[h] : gcur[h])); } else { PG8_STAGE(bufoff, (ptr) + ((h) ? hstepA : 0), voffA); } } while (0)
    Unit cur, nxt; int ui = 0;
    if (!S.next(0, cur)) return;
    if constexpr (GATHER) { PG8_GIDX_ISSUE(cur); asm volatile("s_waitcnt vmcnt(0)" ::: "memory"); PG8_GIDX_CONV(gcur, cur); }
    unsigned gsel[2][2] = {{0u, 0u}, {0u, 0u}};
    f32x4 acc[2][2][4][2];
#pragma unroll
    for (int a = 0; a < 2; ++a)
#pragma unroll
        for (int b = 0; b < 2; ++b)
#pragma unroll
            for (int m = 0; m < 4; ++m)
#pragma unroll
                for (int n = 0; n < 2; ++n) acc[a][b][m][n] = (f32x4){0.f, 0.f, 0.f, 0.f};
    bf16x8 At[4][2], B0[2][2], B1[2][2];
    i32x8 At8[4], B08[2], B18[2];
    const char* cA = (const char*)g.A + (GATHER ? (size_t)0 : (size_t)cur.pm * tstepA); const char* cB = (const char*)g.Bt + (size_t)cur.pb * tstepB;
    S.a_ready(cur);
    if constexpr (SP2) {
        PG8_STAGE(PG8_SB(0, 0), cB, voffB); PG8_STAGE(PG8_SB(0, 1), cB + hstepB, voffB); PG8_STAGE_A(PG8_SA(0, 0), cA, 0, false); PG8_STAGE_A(PG8_SA(0, 1), cA, 1, false);
        if (wr == 1) PG8_BAR;
        PG8_WAIT_V(2); PG8_BAR;
        PG8_STAGE(PG8_SB(1, 0), cB + kstep, voffB); PG8_STAGE_A(PG8_SA(1, 0), cA + kstep, 0, false); PG8_STAGE(PG8_SB(1, 1), cB + hstepB + kstep, voffB);
        PG8_WAIT_V(6); PG8_BAR;
    } else {
        PG8_STAGE(PG8_SB(0, 0), cB, voffB); PG8_STAGE(PG8_SA(0, 0), cA, voffA); PG8_STAGE(PG8_SB(0, 1), cB + hstepB, voffB); PG8_STAGE(PG8_SA(0, 1), cA + hstepA, voffA);
        if (wr == 1) PG8_BAR;
        PG8_WAIT_V(4); PG8_BAR;
        PG8_STAGE(PG8_SB(1, 0), cB + kstep, voffB); PG8_STAGE(PG8_SA(1, 0), cA + kstep, voffA); PG8_STAGE(PG8_SB(1, 1), cB + hstepB + kstep, voffB);
        PG8_WAIT_V(6); PG8_BAR;
    }
    for (;;) {
        const bool has_next = S.next(ui + 1, nxt);
        if constexpr (GATHER) { if (has_next) PG8_GIDX_ISSUE(nxt); }
        const char* nA = has_next ? (const char*)g.A + (GATHER ? (size_t)0 : (size_t)nxt.pm * tstepA) : cA; const char* nB = has_next ? (const char*)g.Bt + (size_t)nxt.pb * tstepB : cB;
#pragma unroll 1
        for (int t = 0; t < nt; t += 2) {
            const bool last = (t == nt - 2);
            const char* a1 = cA + (size_t)(t + 1) * kstep;
            const char* a2 = last ? nA : cA + (size_t)(t + 2) * kstep; const char* b2 = last ? nB : cB + (size_t)(t + 2) * kstep;
            const char* a3 = a2 + kstep; const char* b3 = b2 + kstep;
            if (last && has_next) S.a_ready(nxt);
            if constexpr (GATHER) { if (last) { if (has_next) { PG8_GIDX_CONV(gnxt, nxt); } else { _Pragma("unroll") for (int h_ = 0; h_ < 2; ++h_) _Pragma("unroll") for (int i_ = 0; i_ < 2; ++i_) gnxt[h_][i_] = gcur[h_][i_]; } }
                _Pragma("unroll") for (int h_ = 0; h_ < 2; ++h_) _Pragma("unroll") for (int i_ = 0; i_ < 2; ++i_) gsel[h_][i_] = last ? gnxt[h_][i_] : gcur[h_][i_]; }
            if constexpr (SP2) {
            PG8_LDB(B0, 0, 0); PG8_LDB(B1, 0, 1); PG8_SCHED; PG8_LDA(At, 0, 0); PG8_STAGE_A(PG8_SA(1, 1), a1, 1, false);
            PG8_WAIT_V(8); PG8_WAIT_L(0); PG8_BAR; PG8_MMA(0, 0, At, B0); PG8_MMA(0, 1, At, B1); PG8_BAR; PG8_SCHED;
            PG8_LDA(At, 0, 1); PG8_STAGE(PG8_SB(0, 0), b2, voffB); PG8_STAGE(PG8_SB(0, 1), b2 + hstepB, voffB); PG8_STAGE_A(PG8_SA(0, 0), a2, 0, true);
            PG8_WAIT_V(8); PG8_WAIT_L(0); PG8_BAR; PG8_MMA(1, 0, At, B0); PG8_MMA(1, 1, At, B1); PG8_BAR; PG8_SCHED;
            PG8_LDB(B0, 1, 0); PG8_LDB(B1, 1, 1); PG8_SCHED; PG8_LDA(At, 1, 0); PG8_STAGE_A(PG8_SA(0, 1), a2, 1, true);
            PG8_WAIT_V(8); PG8_WAIT_L(0); PG8_BAR; PG8_MMA(0, 0, At, B0); PG8_MMA(0, 1, At, B1); PG8_BAR; PG8_SCHED;
            PG8_LDA(At, 1, 1); PG8_STAGE(PG8_SB(1, 0), b3, voffB); PG8_STAGE(PG8_SB(1, 1), b3 + hstepB, voffB); PG8_STAGE_A(PG8_SA(1, 0), a3, 0, true);
            PG8_WAIT_V(8); PG8_WAIT_L(0); PG8_BAR; PG8_MMA(1, 0, At, B0); PG8_MMA(1, 1, At, B1); PG8_BAR; PG8_SCHED;
            if constexpr (epi_has_mid<Epi>::value) { if (t + 2 == Epi::MID_KT) E.mid(acc, cur, wr, wc, fr, fq); }
            } else {
            PG8_LDB(B0, 0, 0); PG8_SCHED; PG8_LDA(At, 0, 0); PG8_STAGE(PG8_SA(1, 1), a1 + hstepA, voffA);
            PG8_WAIT_L(8); PG8_BAR; PG8_WAIT_L(0); PG8_MMA(0, 0, At, B0); PG8_BAR; PG8_SCHED;
            PG8_LDB(B1, 0, 1); PG8_STAGE(PG8_SB(0, 0), b2, voffB);
            PG8_BAR; PG8_WAIT_L(0); PG8_MMA(0, 1, At, B1); PG8_BAR;
            PG8_LDA(At, 0, 1); PG8_STAGE(PG8_SA(0, 0), a2, voffA);
            PG8_BAR; PG8_WAIT_L(0); PG8_MMA(1, 0, At, B0); PG8_BAR; PG8_SCHED;
            PG8_STAGE(PG8_SB(0, 1), b2 + hstepB, voffB);
            PG8_WAIT_V(6); PG8_BAR; PG8_MMA(1, 1, At, B1); PG8_BAR;
            PG8_LDB(B0, 1, 0); PG8_SCHED; PG8_LDA(At, 1, 0); PG8_STAGE(PG8_SA(0, 1), a2 + hstepA, voffA);
            PG8_WAIT_L(8); PG8_BAR; PG8_WAIT_L(0); PG8_MMA(0, 0, At, B0); PG8_BAR; PG8_SCHED;
            PG8_LDB(B1, 1, 1); PG8_STAGE(PG8_SB(1, 0), b3, voffB);
            PG8_BAR; PG8_WAIT_L(0); PG8_MMA(0, 1, At, B1); PG8_BAR;
            PG8_LDA(At, 1, 1); PG8_STAGE(PG8_SA(1, 0), a3, voffA);
            PG8_BAR; PG8_WAIT_L(0); PG8_MMA(1, 0, At, B0); PG8_BAR; PG8_SCHED;
            PG8_STAGE(PG8_SB(1, 1), b3 + hstepB, voffB);
            PG8_WAIT_V(6); PG8_BAR; PG8_MMA(1, 1, At, B1); PG8_BAR;
            }
        }
        if constexpr (ALIGN_EPI) { if (wr == 0) PG8_BAR; }
        if constexpr (FP8) {
            asm volatile("s_nop 15\n\ts_nop 15" ::: "memory");
#pragma unroll
            for (int a = 0; a < 2; ++a)
#pragma unroll
                for (int b = 0; b < 2; ++b)
#pragma unroll
                    for (int m = 0; m < 4; ++m)
#pragma unroll
                        for (int n = 0; n < 2; ++n) asm volatile("" : "+v"(acc[a][b][m][n]));
        }
        if constexpr (!Epi::AFTER_DRAIN) { E(acc, cur, wr, wc, fr, fq); S.done(cur); }
        if (!has_next) break;
#pragma unroll
        for (int a = 0; a < 2; ++a)
#pragma unroll
            for (int b = 0; b < 2; ++b)
#pragma unroll
                for (int m = 0; m < 4; ++m)
#pragma unroll
                    for (int n = 0; n < 2; ++n) acc[a][b][m][n] = (f32x4){0.f, 0.f, 0.f, 0.f};
        cur = nxt; cA = nA; cB = nB; ++ui;
        if constexpr (GATHER) { _Pragma("unroll") for (int h_ = 0; h_ < 2; ++h_) _Pragma("unroll") for (int i_ = 0; i_ < 2; ++i_) gcur[h_][i_] = gnxt[h_][i_]; }
        if constexpr (ALIGN_EPI) { if (wr == 1) PG8_BAR; }
    }
    PG8_WAIT_V(0);
    if constexpr (!ALIGN_EPI) { if (wr == 0) PG8_BAR; }
    PG8_BAR;
    if constexpr (Epi::AFTER_DRAIN) { E.fused(acc, cur, wr, wc, fr, fq, lds, wid, lane); S.done(cur); }
#undef PG8_SA
#undef PG8_SB
#undef PG8_STAGE
#undef PG8_LDA
#undef PG8_LDB
#undef PG8_MMA
#undef PG8_WAIT_V
#undef PG8_WAIT_L
#undef PG8_BAR
#undef PG8_SCHED
#undef PG8_GIDX_ISSUE
#undef PG8_GIDX_CONV
#undef PG8_STAGE_A
}
}
#include <hip/hip_bf16.h>
#include <cmath>
namespace attn_body {
using bf16=__hip_bfloat16;
using bf16x8=__attribute__((ext_vector_type(8)))short;
using s16x4=__attribute__((ext_vector_type(4)))short;
using f32x16=__attribute__((ext_vector_type(16)))float;
using u32x4=__attribute__((ext_vector_type(4)))unsigned;
constexpr int BATCH=8,NHEAD=8,NKVH=2,SEQ=8192,D=64,QP=512,KVP=256,OP=768;
constexpr int NW=8,QBLK=32,QB=QBLK*NW,KVBLK=64,NQB=SEQ/QB;
constexpr int ATTN_UNIT_ROWS=QB;
__device__ __forceinline__ int crow(int r,int hi){return (r&3)+8*(r>>2)+4*hi;}
#define SBAR() __builtin_amdgcn_sched_barrier(0)
__device__ __forceinline__ void cmask(f32x16&p0,f32x16&p1,int jb,int qrel,int hi){
  const float NEG=-INFINITY; int kb=64*jb+4*hi;
  #pragma unroll
  for(int r=0;r<16;++r){int kv=kb+(r&3)+8*(r>>2); if(kv>qrel)p0[r]=NEG; if(kv+32>qrel)p1[r]=NEG;}
}

constexpr int NSLOT=3, SLOTB=8192;
constexpr int LDS_K=0, LDS_V=NSLOT*SLOTB, LDS_WS=2*NSLOT*SLOTB, LDS_OST=LDS_WS+NW*64*4, LDS_BYTES=LDS_OST+NW*4096;
constexpr float C2=0.125f*1.4426950408889634f;
__device__ __forceinline__ void glds16(const void*gsrc,unsigned lds_dst){unsigned keep;
  asm volatile("s_mov_b32 %0, m0\n\ts_mov_b32 m0, %2\n\ts_nop 0\n\tglobal_load_lds_dwordx4 %1, off\n\ts_mov_b32 m0, %0":"=&s"(keep):"v"(gsrc),"s"(lds_dst):"memory");}
__device__ __forceinline__ float max3f(float a,float b,float c){float r;asm("v_max3_f32 %0, %1, %2, %3":"=v"(r):"v"(a),"v"(b),"v"(c));return r;}
__device__ __forceinline__ float max2f(float a,float b){float r;asm("v_max_f32_e32 %0, %1, %2":"=v"(r):"v"(a),"v"(b));return r;}
__device__ __forceinline__ float fadd_s(float a,float b){float r;asm("v_add_f32_e32 %0, %1, %2":"=v"(r):"v"(a),"v"(b));return r;}
__device__ __forceinline__ float fsub_s(float a,float b){float r;asm("v_sub_f32_e32 %0, %1, %2":"=v"(r):"v"(a),"v"(b));return r;}
typedef float f32x2_t __attribute__((ext_vector_type(2))); typedef __bf16 bf16x2_t __attribute__((ext_vector_type(2)));
__device__ __forceinline__ unsigned cvtpk_s(float lo,float hi){f32x2_t v={lo,hi};bf16x2_t b=__builtin_convertvector(v,bf16x2_t);return __builtin_bit_cast(unsigned,b);}
#define WAIT_BAR(N) asm volatile("s_waitcnt vmcnt(" #N ") lgkmcnt(0)\n\ts_barrier":::"memory")

__device__ __forceinline__ void qkt(f32x16&p0,f32x16&p1,const char*Kslot,const bf16x8*qr,const f32x16&negm,int r32,int hi){
  const char*kb=Kslot+hi*1024+r32*16;
  #pragma unroll
  for(int d0=0;d0<4;++d0){
    const bf16x8 b0=*reinterpret_cast<const bf16x8*>(kb+d0*2048);
    const bf16x8 b1=*reinterpret_cast<const bf16x8*>(kb+d0*2048+512);
    if(d0==0){p0=__builtin_amdgcn_mfma_f32_32x32x16_bf16(b0,qr[0],negm,0,0,0);p1=__builtin_amdgcn_mfma_f32_32x32x16_bf16(b1,qr[0],negm,0,0,0);}
    else{p0=__builtin_amdgcn_mfma_f32_32x32x16_bf16(b0,qr[d0],p0,0,0,0);p1=__builtin_amdgcn_mfma_f32_32x32x16_bf16(b1,qr[d0],p1,0,0,0);}}
}
typedef __attribute__((address_space(3))) const char* lds_cptr;
typedef short v4i16_t __attribute__((ext_vector_type(4)));
__device__ __forceinline__ void kload8(bf16x8*kf,lds_cptr kp){
  kf[0]=*(const __attribute__((address_space(3))) bf16x8*)(kp);      kf[1]=*(const __attribute__((address_space(3))) bf16x8*)(kp+512);
  kf[2]=*(const __attribute__((address_space(3))) bf16x8*)(kp+2048); kf[3]=*(const __attribute__((address_space(3))) bf16x8*)(kp+2560);
  kf[4]=*(const __attribute__((address_space(3))) bf16x8*)(kp+4096); kf[5]=*(const __attribute__((address_space(3))) bf16x8*)(kp+4608);
  kf[6]=*(const __attribute__((address_space(3))) bf16x8*)(kp+6144); kf[7]=*(const __attribute__((address_space(3))) bf16x8*)(kp+6656);
}
__device__ __forceinline__ void kload2(bf16x8*kf,lds_cptr kp,int j){ kf[2*j]=*(const __attribute__((address_space(3))) bf16x8*)(kp+j*2048); kf[2*j+1]=*(const __attribute__((address_space(3))) bf16x8*)(kp+j*2048+512); }
__device__ __forceinline__ s16x4 vtr(lds_cptr p){ return __builtin_bit_cast(s16x4,__builtin_amdgcn_ds_read_tr16_b64_v4i16((__attribute__((address_space(3))) v4i16_t*)p)); }
__device__ __forceinline__ float rowmax(const f32x16&p0,const f32x16&p1){
  float a=max3f(p0[0],p0[1],p1[0]),b=max3f(p0[2],p0[3],p1[1]);a=max3f(a,p1[2],p1[3]);
  #pragma unroll
  for(int r=4;r<16;r+=4){a=max3f(a,p0[r],p0[r+1]);b=max3f(b,p0[r+2],p0[r+3]);a=max3f(a,p1[r],p1[r+1]);b=max3f(b,p1[r+2],p1[r+3]);}
  const float m=max2f(a,b);
  auto rr=__builtin_amdgcn_permlane32_swap(__float_as_uint(m),__float_as_uint(m),false,false);
  return max2f(__uint_as_float(rr[0]),__uint_as_float(rr[1]));
}
__device__ __forceinline__ void pv(f32x16*o,int vb,bf16x8 pa0,bf16x8 pa1,bf16x8 pa2,bf16x8 pa3){
  #pragma unroll
  for(int d0=0;d0<2;++d0){s16x4 lo[4],hi[4];
    #pragma unroll
    for(int ks=0;ks<4;++ks){
      asm volatile("ds_read_b64_tr_b16 %0,%1 offset:%c2":"=&v"(lo[ks]):"v"(vb),"i"(d0*4096+ks*1024):"memory");
      asm volatile("ds_read_b64_tr_b16 %0,%1 offset:%c2":"=&v"(hi[ks]):"v"(vb),"i"(d0*4096+ks*1024+512):"memory");}
    asm volatile("s_waitcnt lgkmcnt(0)":::"memory");SBAR();
    #define PK(k) (bf16x8){lo[k][0],lo[k][1],lo[k][2],lo[k][3],hi[k][0],hi[k][1],hi[k][2],hi[k][3]}
    o[d0]=__builtin_amdgcn_mfma_f32_32x32x16_bf16(pa0,PK(0),o[d0],0,0,0);
    o[d0]=__builtin_amdgcn_mfma_f32_32x32x16_bf16(pa1,PK(1),o[d0],0,0,0);
    o[d0]=__builtin_amdgcn_mfma_f32_32x32x16_bf16(pa2,PK(2),o[d0],0,0,0);
    o[d0]=__builtin_amdgcn_mfma_f32_32x32x16_bf16(pa3,PK(3),o[d0],0,0,0);
    #undef PK
  }
}

#ifndef ATTN_STORE16
#define ATTN_STORE16(p,v) (*(u32x4*)(p)=(v))
#endif
template<int THRL,bool FIXREF> __device__ __forceinline__ void attn_unit(int b,int h,int qb,const bf16*Q,const bf16*__restrict__ K,const bf16*__restrict__ V,bf16*O,char*shm,float cref){
  const int tid=threadIdx.x,lane=tid&63,r32=lane&31,hi=lane>>5; const int wid=__builtin_amdgcn_readfirstlane(tid>>6);
  const long rowbase=(long)b*SEQ; const int q0=qb*QB;
  const bf16*Qw=Q+(rowbase+q0+wid*QBLK)*QP+h*D;
  const bf16*Kh=K+rowbase*KVP+(h>>2)*D,*Vh=V+rowbase*KVP+(h>>2)*D;
  const unsigned lds0=(unsigned)(uintptr_t)shm;
  float*wsf=(float*)(shm+LDS_WS)+wid*64;
  const bf16*ksrc=Kh+(long)lane*KVP+wid*8;
  const bf16*vsrc=Vh+(long)(16*(wid&3)+(lane>>2))*KVP+(wid>>2)*32+(lane&3)*8;
  const unsigned kdst=lds0+LDS_K+wid*1024, vdst=lds0+LDS_V+wid*1024;
  #define DMA_K(t,slot) glds16(ksrc+(long)(t)*KVBLK*KVP,(unsigned)__builtin_amdgcn_readfirstlane(kdst+(slot)))
  #define DMA_V(t,slot) glds16(vsrc+(long)(t)*KVBLK*KVP,(unsigned)__builtin_amdgcn_readfirstlane(vdst+(slot)))
  const int vb0=(int)(lds0+LDS_V)+((lane>>4)&1)*32+(lane&3)*8+(4*hi+((lane&15)>>2))*64;
  const char*Kbase=shm+LDS_K; bf16x8 kf[8];
  const lds_cptr shm3=(lds_cptr)shm; const lds_cptr kp0=shm3+LDS_K+hi*1024+r32*16; const lds_cptr vp0=shm3+LDS_V+((lane>>4)&1)*32+(lane&3)*8+(4*hi+((lane&15)>>2))*64;
  const int NT=SEQ/KVBLK;
  DMA_K(0,0);DMA_V(0,0);DMA_K(1,SLOTB);
  bf16x8 qr[4];
  #pragma unroll
  for(int d0=0;d0<4;++d0)qr[d0]=*reinterpret_cast<const bf16x8*>(&Qw[(long)r32*QP+d0*16+hi*8]);
  float mhat=0.f,l_reg=0.f;f32x16 o[2];o[0]=f32x16{};o[1]=f32x16{};f32x16 negm=f32x16{};
  if constexpr(FIXREF){ _Pragma("unroll") for(int r=0;r<16;++r)negm[r]=-cref; }
  asm volatile("":"+v"(negm));
    #define CMASK(P0,P1,t) do{}while(0)
  bool resc=false;
  #define START(P0,P1) do{ resc=false; if constexpr(!FIXREF) \
    { const float rm=rowmax(P0,P1); const float dl=rm; mhat=fadd_s(mhat,dl); \
      _Pragma("unroll") for(int r=0;r<16;++r){P0[r]=fsub_s(P0[r],dl);P1[r]=fsub_s(P1[r],dl);} \
      _Pragma("unroll") for(int r=0;r<16;++r)negm[r]=-mhat; asm volatile("":"+v"(negm)); } \
    _Pragma("unroll") for(int r=0;r<16;++r)P0[r]=__builtin_amdgcn_exp2f(P0[r]); }while(0)
  #define RESC() do{ if(resc){ asm volatile("s_waitcnt lgkmcnt(0)":::"memory"); \
      _Pragma("unroll") for(int d_=0;d_<2;++d_) _Pragma("unroll") for(int r=0;r<16;++r)o[d_][r]*=wsf[crow(r,hi)]; } }while(0)
  f32x16 pA0,pA1,pB0,pB1;
  int sl_prev=0,sl_cur=0,sl_next=SLOTB;
  #define ROT() do{sl_prev=sl_cur;sl_cur=sl_next;sl_next=(sl_next==(NSLOT-1)*SLOTB)?0:sl_next+SLOTB;}while(0)
  DMA_K(2,2*SLOTB);
  WAIT_BAR(3);
  qkt(pA0,pA1,Kbase,qr,negm,r32,hi);asm volatile("s_nop 15\n\ts_nop 7":"+v"(pA0),"+v"(pA1));CMASK(pA0,pA1,0);
  START(pA0,pA1);
  _Pragma("unroll") for(int r=0;r<16;++r)pA1[r]=__builtin_amdgcn_exp2f(pA1[r]);
  WAIT_BAR(0);
  DMA_K(3,0);DMA_V(1,SLOTB);
  ROT();
  kload8(kf,kp0+sl_cur);
  WAIT_BAR(2);
  s16x4 vlo[8],vhi[8]; u32x4 pw0,pw1,pw2,pw3;
  #define PKW(P,B) cvtpk_s(P[B],P[B+1])
  #define PAF(k) __builtin_bit_cast(bf16x8,pw##k)
  #define VFR(i) (bf16x8){vlo[i][0],vlo[i][1],vlo[i][2],vlo[i][3],vhi[i][0],vhi[i][1],vhi[i][2],vhi[i][3]}
  #define PIN(x) asm volatile("":"+v"(x))
  #define MX3(a,b,c) __builtin_fmaxf(__builtin_fmaxf((a),(b)),(c))
  #define GAPA(MF,A0,A1,A2,A3,W0,W1,PW) do{ MF; sacc+=A0; sacc+=A1; sacc+=A2; sacc+=A3; PIN(sacc); W0; W1; PIN(PW); SBAR(); }while(0)
  #define EX(v) __builtin_amdgcn_exp2f(v)
  #define GAPB(MF,X,B) do{ MF; X[B]=EX(X[B]); X[B+1]=EX(X[B+1]); X[B+2]=EX(X[B+2]); X[B+3]=EX(X[B+3]); PIN(X); SBAR(); }while(0)
  #define VRD(i) do{ vlo[i]=vtr(vp_+(((i)>>2)*4096+((i)&3)*1024)); vhi[i]=vtr(vp_+(((i)>>2)*4096+((i)&3)*1024+512)); }while(0)
  #define KRD(G,j) do{ if(G){ kload2(kf,kp0+sl_next,j); SBAR(); } }while(0)
  #define STEP(C0,C1,P0,P1,t,GK,GV,GL) do{ SBAR(); \
    const lds_cptr vp_=vp0+sl_prev; \
    VRD(0); SBAR(); float sacc=(P0[0]+P0[1]); \
    GAPA(C0=__builtin_amdgcn_mfma_f32_32x32x16_bf16(kf[0],qr[0],negm,0,0,0), P0[2],P0[3],P0[4],P0[5],     pw0[0]=PKW(P0,0), pw0[1]=PKW(P0,2), pw0); \
    VRD(4); SBAR(); GAPA(C1=__builtin_amdgcn_mfma_f32_32x32x16_bf16(kf[1],qr[0],negm,0,0,0), P0[6],P0[7],P0[8],P0[9],     pw0[2]=PKW(P0,4), pw0[3]=PKW(P0,6), pw0); \
    VRD(1); SBAR(); GAPA(C0=__builtin_amdgcn_mfma_f32_32x32x16_bf16(kf[2],qr[1],C0,0,0,0),   P0[10],P0[11],P0[12],P0[13], pw1[0]=PKW(P0,8), pw1[1]=PKW(P0,10), pw1); \
    VRD(5); SBAR(); GAPA(C1=__builtin_amdgcn_mfma_f32_32x32x16_bf16(kf[3],qr[1],C1,0,0,0),   P0[14],P0[15],P1[0],P1[1],   pw1[2]=PKW(P0,12),pw1[3]=PKW(P0,14), pw1); \
    VRD(2); SBAR(); GAPA(C0=__builtin_amdgcn_mfma_f32_32x32x16_bf16(kf[4],qr[2],C0,0,0,0),   P1[2],P1[3],P1[4],P1[5],     pw2[0]=PKW(P1,0), pw2[1]=PKW(P1,2), pw2); \
    VRD(6); SBAR(); GAPA(C1=__builtin_amdgcn_mfma_f32_32x32x16_bf16(kf[5],qr[2],C1,0,0,0),   P1[6],P1[7],P1[8],P1[9],     pw2[2]=PKW(P1,4), pw2[3]=PKW(P1,6), pw2); \
    VRD(3); SBAR(); GAPA(C0=__builtin_amdgcn_mfma_f32_32x32x16_bf16(kf[6],qr[3],C0,0,0,0),   P1[10],P1[11],P1[12],P1[13], pw3[0]=PKW(P1,8), pw3[1]=PKW(P1,10), pw3); \
    VRD(7); SBAR(); GAPA(C1=__builtin_amdgcn_mfma_f32_32x32x16_bf16(kf[7],qr[3],C1,0,0,0),   P1[14],P1[15],0.f,0.f,       pw3[2]=PKW(P1,12),pw3[3]=PKW(P1,14), pw3); \
    l_reg+=sacc; \
    if(GK){DMA_K((t)+3,sl_cur);} if(GV){DMA_V((t)+1,sl_next);} \
    CMASK(C0,C1,t); \
    if constexpr(!FIXREF){ float a=MX3(C0[0],C0[1],C1[0]),b=MX3(C0[2],C0[3],C1[1]); a=MX3(a,C1[2],C1[3]); \
      _Pragma("unroll") for(int r=4;r<16;r+=4){a=MX3(a,C0[r],C0[r+1]);b=MX3(b,C0[r+2],C0[r+3]);a=MX3(a,C1[r],C1[r+1]);b=MX3(b,C1[r+2],C1[r+3]);} \
      float rm=__builtin_fmaxf(a,b); { auto rr=__builtin_amdgcn_permlane32_swap(__float_as_uint(rm),__float_as_uint(rm),false,false); rm=__builtin_fmaxf(__uint_as_float(rr[0]),__uint_as_float(rr[1])); } \
      resc=false; \
      if(__builtin_expect(__any(rm>(float)THRL),0)){ const float dl=__builtin_fmaxf(rm,0.f); mhat+=dl; \
        _Pragma("unroll") for(int r=0;r<16;++r){C0[r]-=dl;C1[r]-=dl;} \
        _Pragma("unroll") for(int r=0;r<16;++r)negm[r]=-mhat; asm volatile("":"+v"(negm)); \
        const float f=__builtin_amdgcn_exp2f(-dl); l_reg*=f; if(hi==0)wsf[r32]=f; resc=true; } } \
    SBAR(); \
    GAPB(o[0]=__builtin_amdgcn_mfma_f32_32x32x16_bf16(PAF(0),VFR(0),o[0],0,0,0), C0,0); \
    GAPB(o[1]=__builtin_amdgcn_mfma_f32_32x32x16_bf16(PAF(0),VFR(4),o[1],0,0,0), C0,4); \
    KRD(GL,0); GAPB(o[0]=__builtin_amdgcn_mfma_f32_32x32x16_bf16(PAF(1),VFR(1),o[0],0,0,0), C0,8); \
    KRD(GL,1); GAPB(o[1]=__builtin_amdgcn_mfma_f32_32x32x16_bf16(PAF(1),VFR(5),o[1],0,0,0), C0,12); \
    KRD(GL,2); GAPB(o[0]=__builtin_amdgcn_mfma_f32_32x32x16_bf16(PAF(2),VFR(2),o[0],0,0,0), C1,0); \
    KRD(GL,3); GAPB(o[1]=__builtin_amdgcn_mfma_f32_32x32x16_bf16(PAF(2),VFR(6),o[1],0,0,0), C1,4); \
    GAPB(o[0]=__builtin_amdgcn_mfma_f32_32x32x16_bf16(PAF(3),VFR(3),o[0],0,0,0), C1,8); \
    GAPB(o[1]=__builtin_amdgcn_mfma_f32_32x32x16_bf16(PAF(3),VFR(7),o[1],0,0,0), C1,12); \
    }while(0)
  int t=1;
  #undef CMASK
  #define CMASK(P0,P1,t) do{}while(0)
  for(;t+5<NT;t+=2){
    STEP(pB0,pB1,pA0,pA1,t,true,true,true);     WAIT_BAR(2); RESC(); ROT();
    STEP(pA0,pA1,pB0,pB1,t+1,true,true,true);   WAIT_BAR(2); RESC(); ROT();
  }
  #undef CMASK
  #define CMASK(P0,P1,t) do{}while(0)
  #define ENDW(tt) do{ if((tt)+3<NT){WAIT_BAR(2);} else if((tt)+2<NT){WAIT_BAR(1);} else {WAIT_BAR(0);} }while(0)
  for(;t+1<NT;t+=2){
    STEP(pB0,pB1,pA0,pA1,t,(t+3<NT),(t+1<NT),(t+1<NT));       ENDW(t);   RESC(); ROT();
    STEP(pA0,pA1,pB0,pB1,t+1,(t+4<NT),(t+2<NT),(t+2<NT));     ENDW(t+1); RESC(); ROT();
  }
  STEP(pB0,pB1,pA0,pA1,NT-1,false,false,false); RESC();
  { float sacc=pB0[0]+pB0[1]; _Pragma("unroll") for(int r=2;r<16;++r)sacc+=pB0[r]; _Pragma("unroll") for(int r=0;r<16;++r)sacc+=pB1[r]; l_reg+=sacc;
    pw0=(u32x4){PKW(pB0,0),PKW(pB0,2),PKW(pB0,4),PKW(pB0,6)};pw1=(u32x4){PKW(pB0,8),PKW(pB0,10),PKW(pB0,12),PKW(pB0,14)};pw2=(u32x4){PKW(pB1,0),PKW(pB1,2),PKW(pB1,4),PKW(pB1,6)};pw3=(u32x4){PKW(pB1,8),PKW(pB1,10),PKW(pB1,12),PKW(pB1,14)};
    SBAR(); pv(o,vb0+sl_cur,PAF(0),PAF(1),PAF(2),PAF(3)); }
  #undef PKW
  #undef PAF
  #undef VFR
  #undef PIN
  #undef MX3
  #undef GAPA
  #undef GAPB
  #undef EX
  #undef VRD
  #undef KRD
  #undef STEP
  #undef ENDW
  {auto rr=__builtin_amdgcn_permlane32_swap(__float_as_uint(l_reg),__float_as_uint(l_reg),false,false);l_reg=__uint_as_float(rr[0])+__uint_as_float(rr[1]);}
  if(hi==0)wsf[32+r32]=l_reg;asm volatile("s_waitcnt lgkmcnt(0)":::"memory");
  float rli[16];
  #pragma unroll
  for(int r=0;r<16;++r)rli[r]=__builtin_amdgcn_rcpf(wsf[32+crow(r,hi)]);
  bf16*Ow=O+(rowbase+q0+wid*QBLK)*OP+h*D;
  { bf16*stg=(bf16*)(shm+LDS_OST)+wid*2048;
    #pragma unroll
    for(int r=0;r<16;++r){const int orow=crow(r,hi);
      #pragma unroll
      for(int d0=0;d0<2;++d0)stg[orow*64+d0*32+r32]=__float2bfloat16(o[d0][r]*rli[r]);}
    asm volatile("s_waitcnt lgkmcnt(0)":::"memory");
    #pragma unroll
    for(int i=0;i<4;++i){const int row=i*8+(lane>>3),ch=lane&7; const u32x4 v=*(const u32x4*)(stg+row*64+ch*8); ATTN_STORE16(Ow+(long)row*OP+ch*8,v);} }
  asm volatile("s_waitcnt lgkmcnt(0)\n\ts_barrier":::"memory");
  #undef DMA_K
  #undef DMA_V
  #undef CMASK
  #undef START
  #undef RESC
  #undef ROT
}
constexpr int ATTN_LDS_BYTES=LDS_BYTES;
struct AttnTensors { const bf16* Q; const bf16* K; const bf16* V; bf16* O; };
struct AttnUnit { int b; int h; int qb; };
struct StaticOrder {
  int vcu, G;
  __device__ __forceinline__ StaticOrder(int grid,int vcu_):vcu(vcu_),G(grid){}
  __device__ __forceinline__ bool next(int i,AttnUnit&u)const{ const int L=i*G+vcu; if(L>=BATCH*NHEAD*NQB)return false;
    const int rnd=L>>8, x=(L>>5)&7, w=L&31; const int pair=x*2+(rnd>>2); const int uu=(rnd&3)*32+w;
    u.b=pair>>1; u.h=(pair&1)*4+(uu>>5); u.qb=uu&31; return true; }
};
template<class Sched,int THRL=8> __device__ __forceinline__ void attn_phase(char*lds,const AttnTensors&T,const Sched&S,float cref){
  AttnUnit u;
  for(int i=0;S.next(i,u);++i){ attn_unit<THRL,true>(u.b,u.h,u.qb,T.Q,T.K,T.V,T.O,lds,cref); }
}
#undef SBAR
#undef WAIT_BAR
}
namespace attnb {
using attn_body::bf16; using attn_body::bf16x8; using attn_body::s16x4; using attn_body::f32x16; using attn_body::u32x4; using attn_body::lds_cptr;
using attn_body::crow; using attn_body::glds16; using attn_body::cvtpk_s; using attn_body::kload8;
constexpr int SEQ = 8192, PB = 768, OP = 768, OCOL = 512;
#define ATB_MX3(a,b,c) __builtin_fmaxf(__builtin_fmaxf((a),(b)),(c))
__device__ __forceinline__ void pvb(f32x16*o,int vb,bf16x8 pa0,bf16x8 pa1,bf16x8 pa2,bf16x8 pa3){
  #pragma unroll
  for(int d0=0;d0<2;++d0){s16x4 lo[4],hi[4];
    #pragma unroll
    for(int ks=0;ks<4;++ks){
      asm volatile("ds_read_b64_tr_b16 %0,%1 offset:%c2":"=&v"(lo[ks]):"v"(vb),"i"(d0*4096+ks*1024):"memory");
      asm volatile("ds_read_b64_tr_b16 %0,%1 offset:%c2":"=&v"(hi[ks]):"v"(vb),"i"(d0*4096+ks*1024+512):"memory");}
    asm volatile("s_waitcnt lgkmcnt(0)":::"memory");__builtin_amdgcn_sched_barrier(0);
    #define ATB_PK(k) (bf16x8){lo[k][0],lo[k][1],lo[k][2],lo[k][3],hi[k][0],hi[k][1],hi[k][2],hi[k][3]}
    o[d0]=__builtin_amdgcn_mfma_f32_32x32x16_bf16(pa0,ATB_PK(0),o[d0],0,0,0);
    o[d0]=__builtin_amdgcn_mfma_f32_32x32x16_bf16(pa1,ATB_PK(1),o[d0],0,0,0);
    o[d0]=__builtin_amdgcn_mfma_f32_32x32x16_bf16(pa2,ATB_PK(2),o[d0],0,0,0);
    o[d0]=__builtin_amdgcn_mfma_f32_32x32x16_bf16(pa3,ATB_PK(3),o[d0],0,0,0);
    #undef ATB_PK
  }
}
__device__ __forceinline__ void attnb_job(int b,int j,int tt,const bf16*Qb,const bf16*__restrict__ Kb,const bf16*__restrict__ Vb,bf16*O,char*wl,float*wsf){
  const int lane=threadIdx.x&63,r32=lane&31,hi=lane>>5;
  const long rowbase=(long)b*SEQ; const int T0=(tt>>4)*512+(tt&15);
  const unsigned lds0=(unsigned)__builtin_amdgcn_readfirstlane((int)(unsigned)(uintptr_t)wl);
  const lds_cptr kp0=(lds_cptr)wl+hi*1024+r32*16;
  const int vb0=(int)(lds0+8192u)+((lane>>4)&1)*32+(lane&3)*8+(4*hi+((lane&15)>>2))*64;
  float m_run=-INFINITY,l_run=0.f; f32x16 o[2]; o[0]=f32x16{}; o[1]=f32x16{};
  #pragma unroll 1
  for(int g=0;g<3;++g){
    const int sh=2*g,d=1<<sh,stride=16>>sh,ntile=(g==0)?10:((g==1)?4:3),hq=g*4+j;
    const float slope2=exp2f(-8.0f*(float)(hq+1)/12.0f)*(float)d*1.4426950408889634f;
    const int rc=T0&(d-1),s0=T0>>sh,sk0=s0-64,smax=(SEQ>>sh)-1,sq=s0+stride*r32;
    const bf16*Qw=Qb+(rowbase+T0+16*r32)*PB+hq*64;
    bf16x8 qr[4];
    #pragma unroll
    for(int d0=0;d0<4;++d0)qr[d0]=*reinterpret_cast<const bf16x8*>(Qw+d0*16+hi*8);
    const float lo_f=(float)max(-64,-sq),hi_f=(float)min(64,smax-sq);
    const bf16*Kg=Kb+(rowbase+rc)*PB+hq*64; const bf16*Vg=Vb+(rowbase+rc)*PB+hq*64+(lane&3)*8;
    #define ATB_DMAK(tau) do{ int s_=sk0+64*(tau)+lane; s_=min(max(s_,0),smax); const bf16*src_=Kg+(long)(d*s_)*PB; \
        _Pragma("unroll") for(int c_=0;c_<8;++c_)glds16(src_+c_*8,lds0+c_*1024u); }while(0)
    #define ATB_DMAV(tau) do{ _Pragma("unroll") for(int kg_=0;kg_<4;++kg_){ int s_=sk0+64*(tau)+16*kg_+(lane>>2); s_=min(max(s_,0),smax); const bf16*src_=Vg+(long)(d*s_)*PB; \
        glds16(src_,lds0+8192u+kg_*1024u); glds16(src_+32,lds0+8192u+(4+kg_)*1024u);} }while(0)
    ATB_DMAK(0); ATB_DMAV(0);
    #pragma unroll 1
    for(int tau=0;tau<ntile;++tau){
      asm volatile("s_waitcnt vmcnt(8)":::"memory");
      bf16x8 kf[8]; kload8(kf,kp0);
      asm volatile("s_waitcnt lgkmcnt(0)":::"memory");
      const bool more=(tau+1<ntile);
      if(more){ATB_DMAK(tau+1);}
      f32x16 p0=f32x16{},p1=f32x16{};
      #pragma unroll
      for(int d0=0;d0<4;++d0){ p0=__builtin_amdgcn_mfma_f32_32x32x16_bf16(kf[2*d0],qr[d0],p0,0,0,0); p1=__builtin_amdgcn_mfma_f32_32x32x16_bf16(kf[2*d0+1],qr[d0],p1,0,0,0); }
      const float basef=(float)(64*tau-64-stride*r32+4*hi);
      #pragma unroll
      for(int r=0;r<16;++r){ const float c0=basef+(float)((r&3)+8*(r>>2)),c1=c0+32.0f;
        p0[r]=(c0>=lo_f&&c0<=hi_f)?__builtin_fmaf(-slope2,__builtin_fabsf(c0),p0[r]):-INFINITY;
        p1[r]=(c1>=lo_f&&c1<=hi_f)?__builtin_fmaf(-slope2,__builtin_fabsf(c1),p1[r]):-INFINITY; }
      float rm;
      { float a=ATB_MX3(p0[0],p0[1],p1[0]),bb=ATB_MX3(p0[2],p0[3],p1[1]); a=ATB_MX3(a,p1[2],p1[3]);
        #pragma unroll
        for(int r=4;r<16;r+=4){a=ATB_MX3(a,p0[r],p0[r+1]);bb=ATB_MX3(bb,p0[r+2],p0[r+3]);a=ATB_MX3(a,p1[r],p1[r+1]);bb=ATB_MX3(bb,p1[r+2],p1[r+3]);}
        rm=__builtin_fmaxf(a,bb); auto rr=__builtin_amdgcn_permlane32_swap(__float_as_uint(rm),__float_as_uint(rm),false,false); rm=__builtin_fmaxf(__uint_as_float(rr[0]),__uint_as_float(rr[1])); }
      const float m_new=__builtin_fmaxf(m_run,rm); const float m_safe=(m_new==-INFINITY)?0.0f:m_new;
      const float alpha=__builtin_amdgcn_exp2f(m_run-m_safe);
      float sum=0.f;
      #pragma unroll
      for(int r=0;r<16;++r){ p0[r]=__builtin_amdgcn_exp2f(p0[r]-m_safe); p1[r]=__builtin_amdgcn_exp2f(p1[r]-m_safe); sum+=p0[r]+p1[r]; }
      l_run=l_run*alpha+sum; m_run=m_new;
      if(hi==0)wsf[r32]=alpha;
      asm volatile("s_waitcnt lgkmcnt(0)":::"memory");
      #pragma unroll
      for(int r=0;r<16;++r){ const float f=wsf[crow(r,hi)]; o[0][r]*=f; o[1][r]*=f; }
      u32x4 pw0,pw1,pw2,pw3;
      pw0=(u32x4){cvtpk_s(p0[0],p0[1]),cvtpk_s(p0[2],p0[3]),cvtpk_s(p0[4],p0[5]),cvtpk_s(p0[6],p0[7])};
      pw1=(u32x4){cvtpk_s(p0[8],p0[9]),cvtpk_s(p0[10],p0[11]),cvtpk_s(p0[12],p0[13]),cvtpk_s(p0[14],p0[15])};
      pw2=(u32x4){cvtpk_s(p1[0],p1[1]),cvtpk_s(p1[2],p1[3]),cvtpk_s(p1[4],p1[5]),cvtpk_s(p1[6],p1[7])};
      pw3=(u32x4){cvtpk_s(p1[8],p1[9]),cvtpk_s(p1[10],p1[11]),cvtpk_s(p1[12],p1[13]),cvtpk_s(p1[14],p1[15])};
      if(more){asm volatile("s_waitcnt vmcnt(8)":::"memory");}else{asm volatile("s_waitcnt vmcnt(0)":::"memory");}
      pvb(o,vb0,__builtin_bit_cast(bf16x8,pw0),__builtin_bit_cast(bf16x8,pw1),__builtin_bit_cast(bf16x8,pw2),__builtin_bit_cast(bf16x8,pw3));
      if(more){ATB_DMAV(tau+1);}
    }
    #undef ATB_DMAK
    #undef ATB_DMAV
  }
  {auto rr=__builtin_amdgcn_permlane32_swap(__float_as_uint(l_run),__float_as_uint(l_run),false,false);l_run=__uint_as_float(rr[0])+__uint_as_float(rr[1]);}
  if(hi==0)wsf[32+r32]=l_run;
  asm volatile("s_waitcnt lgkmcnt(0)":::"memory");
  float rli[16];
  #pragma unroll
  for(int r=0;r<16;++r)rli[r]=__builtin_amdgcn_rcpf(wsf[32+crow(r,hi)]);
  { bf16*stg=(bf16*)wl;
    #pragma unroll
    for(int r=0;r<16;++r){const int orow=crow(r,hi);
      #pragma unroll
      for(int d0=0;d0<2;++d0)stg[orow*64+d0*32+r32]=__float2bfloat16(o[d0][r]*rli[r]);}
    asm volatile("s_waitcnt lgkmcnt(0)":::"memory");
    bf16*Ow=O+(rowbase+T0)*OP+OCOL+j*64;
    #pragma unroll
    for(int i=0;i<4;++i){const int row=i*8+(lane>>3),ch=lane&7; const u32x4 v=*(const u32x4*)(stg+row*64+ch*8); *(u32x4*)(Ow+(long)(16*row)*OP+ch*8)=v;} }
  asm volatile("s_waitcnt lgkmcnt(0)":::"memory");
}
#undef ATB_MX3
}
namespace attn8 {
using attn_body::bf16; using attn_body::f32x16; using attn_body::u32x4; using attn_body::crow; using attn_body::glds16;
typedef int i32x4 __attribute__((ext_vector_type(4)));
typedef int i32x8 __attribute__((ext_vector_type(8)));
constexpr int SEQ=8192,QP=512,KP=128,OP=768,NW=8,QBLK=32,QB=256,KVBLK=64,NT=SEQ/KVBLK;
constexpr int SLOT=4096,NSLOT=8,LDS_K=0,LDS_V=NSLOT*SLOT,LDS_WS=2*NSLOT*SLOT,LDS_OST=LDS_WS+NW*256,LDS_BYTES=LDS_OST+NW*4096;
typedef __attribute__((address_space(3))) const char* lds_cptr;
__device__ __forceinline__ i32x8 frag2(lds_cptr a,lds_cptr b){ const i32x4 lo=*(const __attribute__((address_space(3))) i32x4*)a, hi=*(const __attribute__((address_space(3))) i32x4*)b; return __builtin_shufflevector(lo,hi,0,1,2,3,4,5,6,7); }
__device__ __forceinline__ int pk4_bf8(float a,float b,float c,float d){ int w=__builtin_amdgcn_cvt_pk_bf8_f32(a,b,0,false); return __builtin_amdgcn_cvt_pk_bf8_f32(c,d,w,true); }
__device__ __forceinline__ int pk4_e5m2(float a,float b,float c,float d){
  const unsigned h0=__builtin_bit_cast(unsigned,__builtin_amdgcn_cvt_pkrtz(a,b)), h1=__builtin_bit_cast(unsigned,__builtin_amdgcn_cvt_pkrtz(c,d));
  return (int)__builtin_amdgcn_perm(h1,h0,0x07050301u); }
template<int MODE=0,bool ZC=false> __device__ __forceinline__ void unit(int b,int h,int qb,const unsigned char*Q8,const unsigned char*K8,const unsigned char*VT8,bf16*O,char*shm,float cref){
  const int tid=threadIdx.x,lane=tid&63,r32=lane&31,hi=lane>>5; const int wid=__builtin_amdgcn_readfirstlane(tid>>6);
  const long rowbase=(long)b*SEQ; const int q0=qb*QB,kvh=h>>2;
  const unsigned lds0=(unsigned)(uintptr_t)shm;
  const unsigned char*src0; long sstep; unsigned dst0;
  if(wid<4){ const int rho=lane,key=32*(rho>>5)+16*((rho>>2)&1)+(rho&3)+4*((rho&31)>>3); src0=K8+(rowbase+key)*KP+kvh*64+wid*16; sstep=(long)KVBLK*KP; dst0=lds0+LDS_K+wid*1024; }
  else { src0=VT8+((long)(b*2+kvh)*64+lane)*SEQ+(wid-4)*16; sstep=KVBLK; dst0=lds0+LDS_V+(wid-4)*1024; }
  #define A8_DMA(t,slot) glds16(src0+(long)(t)*sstep,(unsigned)__builtin_amdgcn_readfirstlane(dst0+(slot)*SLOT))
  A8_DMA(0,0); A8_DMA(1,1); A8_DMA(2,2); A8_DMA(3,3);
  const unsigned char*qp=Q8+(rowbase+q0+wid*QBLK+r32)*QP+h*64+hi*32;
  i32x8 qr=__builtin_shufflevector(*(const i32x4*)qp,*(const i32x4*)(qp+16),0,1,2,3,4,5,6,7);
  asm volatile("":"+v"(qr));
  f32x16 negm=f32x16{}; if(!ZC){ _Pragma("unroll") for(int r=0;r<16;++r)negm[r]=-cref; }
  f32x16 o0=f32x16{},o1=f32x16{},ol=f32x16{};
  i32x8 ones; _Pragma("unroll") for(int r=0;r<8;++r)ones[r]=0x38383838; asm volatile("":"+v"(ones));
  const lds_cptr kp=(lds_cptr)shm+LDS_K+(2*hi)*1024+r32*16, vp=(lds_cptr)shm+LDS_V+hi*1024+r32*16;
  #define A8_MF(a,bq,c,fa) __builtin_amdgcn_mfma_scale_f32_32x32x64_f8f6f4(a,bq,c,fa,0,0,0,0,0)
  f32x16 pA0,pA1,pB0,pB1; i32x8 paA,paB; _Pragma("unroll") for(int r=0;r<8;++r){paA[r]=0;paB[r]=0;}
  asm volatile("s_waitcnt vmcnt(3) lgkmcnt(0)\n\ts_barrier":::"memory");
  { const i32x8 kf0=frag2(kp,kp+1024),kf1=frag2(kp+512,kp+1024+512); pA0=A8_MF(kf0,qr,negm,0); pA1=A8_MF(kf1,qr,negm,0); }
  int s_k=1,s_v=NSLOT-1,s_d=4;
  #define A8_ROT(x) x=((x)==NSLOT-1)?0:(x)+1
  #define A8_STEP(PC0,PC1,PN0,PN1,PAO,PAN,HAVE_NEXT,DO_PV) do{ \
    const lds_cptr ks_=kp+s_k*SLOT, vs_=vp+s_v*SLOT; \
    if(HAVE_NEXT){ const i32x8 kf0_=frag2(ks_,ks_+1024),kf1_=frag2(ks_+512,ks_+1024+512); if(!(MODE&4)){ PN0=A8_MF(kf0_,qr,negm,0); PN1=A8_MF(kf1_,qr,negm,0); } else { PN0=negm; PN1=negm; asm volatile(""::"v"(kf0_),"v"(kf1_)); } } \
    if(DO_PV){ const i32x8 vf0_=frag2(vs_,vs_+2048),vf1_=frag2(vs_+512,vs_+2048+512); if(!(MODE&8)){ o0=A8_MF(PAO,vf0_,o0,1); o1=A8_MF(PAO,vf1_,o1,1); ol=A8_MF(PAO,ones,ol,1); } else { asm volatile(""::"v"(vf0_),"v"(vf1_),"v"(PAO)); } } \
    if(!(MODE&1)){ _Pragma("unroll") for(int r_=0;r_<16;++r_){ PC0[r_]=__builtin_amdgcn_exp2f(PC0[r_]); PC1[r_]=__builtin_amdgcn_exp2f(PC1[r_]); } } \
    if(!(MODE&2)){ PAN[0]=pk4_e5m2(PC0[0],PC0[1],PC0[2],PC0[3]); PAN[1]=pk4_e5m2(PC0[4],PC0[5],PC0[6],PC0[7]); PAN[2]=pk4_e5m2(PC0[8],PC0[9],PC0[10],PC0[11]); PAN[3]=pk4_e5m2(PC0[12],PC0[13],PC0[14],PC0[15]); \
      PAN[4]=pk4_e5m2(PC1[0],PC1[1],PC1[2],PC1[3]); PAN[5]=pk4_e5m2(PC1[4],PC1[5],PC1[6],PC1[7]); PAN[6]=pk4_e5m2(PC1[8],PC1[9],PC1[10],PC1[11]); PAN[7]=pk4_e5m2(PC1[12],PC1[13],PC1[14],PC1[15]); } else { asm volatile(""::"v"(PC0),"v"(PC1)); } \
    _Pragma("unroll") for(int g_=0;g_<5;++g_){ __builtin_amdgcn_sched_group_barrier(0x008,1,0); __builtin_amdgcn_sched_group_barrier(0x002,12,0); } \
    A8_ROT(s_k); A8_ROT(s_v); }while(0)
  #define A8_TOP(t) do{ if((t)+3<NT){ asm volatile("s_waitcnt vmcnt(1) lgkmcnt(0)\n\ts_barrier":::"memory"); } else { asm volatile("s_waitcnt vmcnt(0) lgkmcnt(0)\n\ts_barrier":::"memory"); } \
    if((t)+5<NT){ A8_DMA((t)+4,s_d); A8_DMA((t)+5,s_d+1); } s_d=(s_d==NSLOT-2)?0:s_d+2; }while(0)
  A8_TOP(0); A8_STEP(pA0,pA1,pB0,pB1,paB,paA,true,false);
             A8_STEP(pB0,pB1,pA0,pA1,paA,paB,true,true);
  #pragma unroll 1
  for(int t=2;t<NT;t+=2){
    A8_TOP(t); A8_STEP(pA0,pA1,pB0,pB1,paB,paA,true,true);
               A8_STEP(pB0,pB1,pA0,pA1,paA,paB,(t+2<NT),true);
  }
  { const lds_cptr vs_=vp+s_v*SLOT; const i32x8 vf0_=frag2(vs_,vs_+2048),vf1_=frag2(vs_+512,vs_+2048+512); if(!(MODE&8)){ o0=A8_MF(paB,vf0_,o0,1); o1=A8_MF(paB,vf1_,o1,1); ol=A8_MF(paB,ones,ol,1); } }
  #undef A8_DMA
  #undef A8_MF
  #undef A8_ROT
  #undef A8_STEP
  #undef A8_TOP
  float rli[16];
  #pragma unroll
  for(int r=0;r<16;++r)rli[r]=__builtin_amdgcn_rcpf(ol[r]);
  bf16*Ow=O+(rowbase+q0+wid*QBLK)*OP+h*64;
  { bf16*stg=(bf16*)(shm+LDS_OST)+wid*2048;
    #pragma unroll
    for(int r=0;r<16;++r){const int orow=crow(r,hi); stg[orow*64+r32]=__float2bfloat16(o0[r]*rli[r]); stg[orow*64+32+r32]=__float2bfloat16(o1[r]*rli[r]);}
    asm volatile("s_waitcnt lgkmcnt(0)":::"memory");
    #pragma unroll
    for(int i=0;i<4;++i){const int row=i*8+(lane>>3),ch=lane&7; const u32x4 v=*(const u32x4*)(stg+row*64+ch*8); *(u32x4*)(Ow+(long)row*OP+ch*8)=v;} }
  asm volatile("s_waitcnt lgkmcnt(0)\n\ts_barrier":::"memory");
}
constexpr int ATTN8_LDS_BYTES=LDS_BYTES;
}
namespace attnb2 {
using attn_body::bf16; using attn_body::bf16x8; using attn_body::s16x4; using attn_body::f32x16; using attn_body::u32x4;
using attn_body::crow; using attn_body::glds16; using attn_body::cvtpk_s; using attnb::pvb;
constexpr int SEQ = 8192, PB = 768, OP = 768, OCOL = 512;
#define AB2_MX3(a,b,c) __builtin_fmaxf(__builtin_fmaxf((a),(b)),(c))
__device__ __forceinline__ void pvb2(f32x16*o,int vb,bf16x8 pa0,bf16x8 pa1,bf16x8 pa2,bf16x8 pa3){
  #pragma unroll
  for(int d0=0;d0<2;++d0){s16x4 lo[4],hi[4];
    #pragma unroll
    for(int ks=0;ks<4;++ks){
      asm volatile("ds_read_b64_tr_b16 %0,%1 offset:%c2":"=&v"(lo[ks]):"v"(vb),"i"(d0*64+ks*2048):"memory");
      asm volatile("ds_read_b64_tr_b16 %0,%1 offset:%c2":"=&v"(hi[ks]):"v"(vb),"i"(d0*64+ks*2048+1024):"memory");}
    asm volatile("s_waitcnt lgkmcnt(0)":::"memory");__builtin_amdgcn_sched_barrier(0);
    #define AB2_PK(k) (bf16x8){lo[k][0],lo[k][1],lo[k][2],lo[k][3],hi[k][0],hi[k][1],hi[k][2],hi[k][3]}
    o[d0]=__builtin_amdgcn_mfma_f32_32x32x16_bf16(pa0,AB2_PK(0),o[d0],0,0,0);
    o[d0]=__builtin_amdgcn_mfma_f32_32x32x16_bf16(pa1,AB2_PK(1),o[d0],0,0,0);
    o[d0]=__builtin_amdgcn_mfma_f32_32x32x16_bf16(pa2,AB2_PK(2),o[d0],0,0,0);
    o[d0]=__builtin_amdgcn_mfma_f32_32x32x16_bf16(pa3,AB2_PK(3),o[d0],0,0,0);
    #undef AB2_PK
  }
}
__device__ __forceinline__ void gload16(bf16x8&dst,const void*p){asm volatile("global_load_dwordx4 %0, %1, off":"=v"(dst):"v"(p):"memory");}
#define AB2_PIN8(N,kf) asm volatile("s_waitcnt vmcnt(" #N ")":"+v"(kf[0]),"+v"(kf[1]),"+v"(kf[2]),"+v"(kf[3]),"+v"(kf[4]),"+v"(kf[5]),"+v"(kf[6]),"+v"(kf[7])::"memory")
#define AB2_WAITV(N) asm volatile("s_waitcnt vmcnt(" #N ")":::"memory")
template<int BM=0> __device__ __forceinline__ void b2_tile(int lane_in,int b,int j,int g,int k,int c,const bf16*Qb,const bf16*__restrict__ Kb,const bf16*__restrict__ Vb,bf16*O,float*LSE,char*wl,float*wsf){
  int lane=lane_in; asm volatile("":"+v"(lane));
  const int r32=lane&31,hi=lane>>5;
  const int sh=2*g,d=1<<sh,Lg=SEQ>>sh,hq=g*4+j;
  int rc,sfirst; if(g==2){rc=k;sfirst=32*c;} else if(g==1){rc=k&3;sfirst=128*c+32*(k>>2);} else {rc=0;sfirst=512*c+32*k;}
  const float slope2=exp2f(-8.0f*(float)(hq+1)/12.0f)*(float)d*1.4426950408889634f;
  const long rowbase=(long)b*SEQ+rc;
  const int sq=sfirst+r32; const float lo_f=(float)max(-64,-sq),hi_f=(float)min(64,Lg-1-sq);
  const unsigned slot0=(unsigned)__builtin_amdgcn_readfirstlane((int)(unsigned)(uintptr_t)wl),slot1=slot0+8192u;
  const int vb0=(int)slot0+((lane>>4)&1)*32+(lane&3)*8+(4*hi+((lane&15)>>2))*128,vb1=vb0+8192;
  const bool mrg=(g!=2);
  bf16x8 qr[4],kfA[8];
  { const bf16*Qp=Qb+(rowbase+(long)d*sq)*PB+hq*64+hi*8;
    #pragma unroll
    for(int d0=0;d0<4;++d0)gload16(qr[d0],Qp+d0*16); }
  #define AB2_KLOAD(kf,tau) do{ const bf16*k0_=Kb+(rowbase+(long)d*min(max(sfirst-64+64*(tau)+r32,0),Lg-1))*PB+hq*64+hi*8; const bf16*k1_=Kb+(rowbase+(long)d*min(max(sfirst-32+64*(tau)+r32,0),Lg-1))*PB+hq*64+hi*8; \
      if(!(BM&2)){ _Pragma("unroll") for(int d0=0;d0<4;++d0){ gload16(kf[2*d0],k0_+16*d0); gload16(kf[2*d0+1],k1_+16*d0);} } else { _Pragma("unroll") for(int i_=0;i_<8;++i_){ asm volatile("s_nop 0":"=v"(kf[i_])); } } }while(0)
  #define AB2_VDMA(tau,slot) do{ _Pragma("unroll") for(int i_=0;i_<8;++i_){ const int s_=min(max(sfirst-64+64*(tau)+8*i_+(lane>>3),0),Lg-1); const bf16*src_=Vb+(rowbase+(long)d*s_)*PB+hq*64+(lane&7)*8; \
      if(!(BM&4)) glds16(src_,(slot)+i_*1024u);} }while(0)
  AB2_KLOAD(kfA,1); AB2_VDMA(1,slot0); AB2_VDMA(0,slot1);
  float m_run=0.f,l_run=0.f; f32x16 o[2]; o[0]=f32x16{}; o[1]=f32x16{};
  u32x4 pw0,pw1,pw2,pw3; f32x16 p0,p1;
  #define AB2_QK(kf) do{ p0=f32x16{}; p1=f32x16{}; _Pragma("unroll") for(int d0=0;d0<4;++d0){ p0=__builtin_amdgcn_mfma_f32_32x32x16_bf16(kf[2*d0],qr[d0],p0,0,0,0); p1=__builtin_amdgcn_mfma_f32_32x32x16_bf16(kf[2*d0+1],qr[d0],p1,0,0,0); } }while(0)
  #define AB2_SOFTMAX(tau,FIRST) do{ if(BM&1){ m_run=0.f; l_run=1.f; } else { float basef=(float)(64*(tau)-64-r32+4*hi); asm volatile("":"+v"(basef));     \
      _Pragma("unroll") for(int r=0;r<16;++r){ const float c0=basef+(float)((r&3)+8*(r>>2)),c1=c0+32.0f; \
        p0[r]=(c0>=lo_f&&c0<=hi_f)?__builtin_fmaf(-slope2,__builtin_fabsf(c0),p0[r]):-INFINITY; p1[r]=(c1>=lo_f&&c1<=hi_f)?__builtin_fmaf(-slope2,__builtin_fabsf(c1),p1[r]):-INFINITY; } \
      float rm; { float a=AB2_MX3(p0[0],p0[1],p1[0]),bb=AB2_MX3(p0[2],p0[3],p1[1]); a=AB2_MX3(a,p1[2],p1[3]); \
        _Pragma("unroll") for(int r=4;r<16;r+=4){a=AB2_MX3(a,p0[r],p0[r+1]);bb=AB2_MX3(bb,p0[r+2],p0[r+3]);a=AB2_MX3(a,p1[r],p1[r+1]);bb=AB2_MX3(bb,p1[r+2],p1[r+3]);} \
        rm=__builtin_fmaxf(a,bb); auto rr=__builtin_amdgcn_permlane32_swap(__float_as_uint(rm),__float_as_uint(rm),false,false); rm=__builtin_fmaxf(__uint_as_float(rr[0]),__uint_as_float(rr[1])); } \
      const float m_new=(FIRST)?rm:__builtin_fmaxf(m_run,rm); float sum=0.f; \
      _Pragma("unroll") for(int r=0;r<16;++r){ p0[r]=__builtin_amdgcn_exp2f(p0[r]-m_new); p1[r]=__builtin_amdgcn_exp2f(p1[r]-m_new); sum+=p0[r]+p1[r]; } \
      if(FIRST){ l_run=sum; } else { const float alpha=__builtin_amdgcn_exp2f(m_run-m_new); l_run=l_run*alpha+sum; \
        if(!__all(m_new==m_run)){ if(hi==0)wsf[r32]=alpha; asm volatile("s_waitcnt lgkmcnt(0)":::"memory");     \
        _Pragma("unroll") for(int r=0;r<16;++r){ const float f=wsf[crow(r,hi)]; o[0][r]*=f; o[1][r]*=f; } } } \
      m_run=m_new; \
      } \
      pw0=(u32x4){cvtpk_s(p0[0],p0[1]),cvtpk_s(p0[2],p0[3]),cvtpk_s(p0[4],p0[5]),cvtpk_s(p0[6],p0[7])}; pw1=(u32x4){cvtpk_s(p0[8],p0[9]),cvtpk_s(p0[10],p0[11]),cvtpk_s(p0[12],p0[13]),cvtpk_s(p0[14],p0[15])}; \
      pw2=(u32x4){cvtpk_s(p1[0],p1[1]),cvtpk_s(p1[2],p1[3]),cvtpk_s(p1[4],p1[5]),cvtpk_s(p1[6],p1[7])}; pw3=(u32x4){cvtpk_s(p1[8],p1[9]),cvtpk_s(p1[10],p1[11]),cvtpk_s(p1[12],p1[13]),cvtpk_s(p1[14],p1[15])}; }while(0)
  #define AB2_PV(vb) if(!(BM&4)) pvb2(o,vb,__builtin_bit_cast(bf16x8,pw0),__builtin_bit_cast(bf16x8,pw1),__builtin_bit_cast(bf16x8,pw2),__builtin_bit_cast(bf16x8,pw3))
  asm volatile("s_waitcnt vmcnt(16)":"+v"(qr[0]),"+v"(qr[1]),"+v"(qr[2]),"+v"(qr[3])::"memory");
  AB2_PIN8(16,kfA);
  AB2_QK(kfA);
  asm volatile("s_nop 7":"+v"(p0),"+v"(p1));
  AB2_KLOAD(kfA,0);
  AB2_SOFTMAX(1,true);
  AB2_WAITV(16); AB2_PV(vb0);
  AB2_VDMA(2,slot0);
  AB2_PIN8(8,kfA);
  AB2_QK(kfA);
  asm volatile("s_nop 7":"+v"(p0),"+v"(p1));
  AB2_KLOAD(kfA,2);
  AB2_SOFTMAX(0,false);
  AB2_PV(vb1);
  const long rowO=(long)b*SEQ+rc+(long)d*sfirst;
  int lse_old_bits=0;
  {
    #pragma unroll
    for(int i=0;i<4;++i){ const bf16*src_=O+(rowO+(long)d*(i*8+(lane>>3)))*OP+OCOL+j*64+(lane&7)*8; glds16(src_,slot1+i*1024u); }
    const float*lp=LSE+(rowO+(long)d*r32)*4+j; asm volatile("global_load_dword %0, %1, off":"=v"(lse_old_bits):"v"(lp):"memory"); }
  AB2_PIN8(5,kfA);
  AB2_QK(kfA); AB2_SOFTMAX(2,false);
  AB2_PV(vb0);
  {auto rr=__builtin_amdgcn_permlane32_swap(__float_as_uint(l_run),__float_as_uint(l_run),false,false);l_run=__uint_as_float(rr[0])+__uint_as_float(rr[1]);}
  const float lse_g=m_run+__builtin_amdgcn_logf(l_run);
  float w_old=0.f,w_new=__builtin_amdgcn_rcpf(l_run),lse_new=lse_g;
  asm volatile("s_waitcnt vmcnt(0)":"+v"(lse_old_bits)::"memory");
  if(mrg){ const float lse_old=__int_as_float(lse_old_bits);
    const float mx=__builtin_fmaxf(lse_old,lse_g); const float eo=__builtin_amdgcn_exp2f(lse_old-mx),eg=__builtin_amdgcn_exp2f(lse_g-mx); const float inv=__builtin_amdgcn_rcpf(eo+eg);
    lse_new=mx+__builtin_amdgcn_logf(eo+eg); w_old=eo*inv; w_new=eg*inv*__builtin_amdgcn_rcpf(l_run); }
  if(hi==0){wsf[r32]=w_old;wsf[32+r32]=w_new;}
  asm volatile("s_waitcnt lgkmcnt(0)":::"memory");
  { const unsigned short*oldp=(const unsigned short*)(wl+8192); bf16*stg=(bf16*)wl;
    #pragma unroll
    for(int r=0;r<16;++r){ const int orow=crow(r,hi); const float fo=wsf[orow],fn=wsf[32+orow];
      #pragma unroll
      for(int d0=0;d0<2;++d0){ float v=o[d0][r]*fn; if(mrg)v=__builtin_fmaf(__uint_as_float((unsigned)oldp[orow*64+d0*32+r32]<<16),fo,v); stg[orow*64+d0*32+r32]=__float2bfloat16(v); } }
    asm volatile("s_waitcnt lgkmcnt(0)":::"memory");
    #pragma unroll
    for(int i=0;i<4;++i){const int row=i*8+(lane>>3),ch=lane&7; const u32x4 v=*(const u32x4*)(stg+row*64+ch*8); *(u32x4*)(O+(rowO+(long)d*row)*OP+OCOL+j*64+ch*8)=v;}
    if(g!=0&&hi==0)LSE[(rowO+(long)d*r32)*4+j]=lse_new; }
  asm volatile("s_waitcnt lgkmcnt(0)":::"memory");
  #undef AB2_KLOAD
  #undef AB2_VDMA
  #undef AB2_QK
  #undef AB2_SOFTMAX
  #undef AB2_PV
}
template<int BM=0> __device__ __forceinline__ void b2_unit(int lane,int b,int j,int c,int wave,const bf16*Qb,const bf16*Kb,const bf16*Vb,bf16*O,float*LSE,char*wl,float*wsf){
  #pragma unroll 1
  for(int g=2;g>=0;--g){
    #pragma unroll 1
    for(int kk=0;kk<2;++kk)b2_tile<BM>(lane,b,j,g,2*wave+kk,c,Qb,Kb,Vb,O,LSE,wl,wsf);
    asm volatile("s_waitcnt vmcnt(0)":::"memory");
    __syncthreads();
  }
}
#undef AB2_MX3
#undef AB2_PIN8
#undef AB2_WAITV
}
#ifndef ATTN_FP8
#define ATTN_FP8 1
#endif
#ifndef GEMM1_WGM
#define GEMM1_WGM 8
#endif
#ifndef GEMM1_FP8
#define GEMM1_FP8 1
#endif
constexpr int NWAVES = 8;
#ifndef MK_N_LAUNCHES
#define MK_N_LAUNCHES 1
#endif
constexpr int N_PHASES = 12;
constexpr int N_LAUNCHES = MK_N_LAUNCHES;

constexpr int BATCH = 8, SEQ = 8192, DM = 1024, M = BATCH * SEQ;
constexpr int N_IN = 5120, NE = 16, FF = 1024, CAP = 1024, MR = BATCH * NE * CAP;
constexpr float NORM_EPS = 1e-6f;

constexpr size_t MiB = 1u << 20;
constexpr size_t WS_CTL = 0, CTL_ZERO_BYTES = 1 * MiB;
constexpr size_t WS_AFF = 1 * MiB;
constexpr size_t WS_TOPI = 5 * MiB, WS_TOPG = WS_TOPI + 512 * 1024;
constexpr size_t WS_TSLOT = 6 * MiB;
constexpr size_t WS_WIN = 10 * MiB;
constexpr size_t WS_WO = 20 * MiB;
constexpr size_t WS_WOUT = 22 * MiB;
constexpr size_t WS_WGU = 24 * MiB;
constexpr size_t WS_WD = 88 * MiB;
constexpr size_t WS_XN = 120 * MiB;
constexpr size_t WS_QA = 248 * MiB, WS_KVA = 312 * MiB, WS_QB = 344 * MiB, WS_KB = 440 * MiB, WS_VB = 536 * MiB, WS_G = 632 * MiB;
constexpr size_t WS_Q8 = WS_XN, WS_K8 = WS_XN + 32 * MiB, WS_VT8 = WS_XN + 40 * MiB;
constexpr size_t WS_OAB = 888 * MiB;
constexpr size_t WS_XB = 440 * MiB;
constexpr size_t WS_XG = 248 * MiB, WS_ACT = 632 * MiB, WS_Y = 760 * MiB;
constexpr size_t WS_END = 1016 * MiB;
static_assert(WS_WD + 32 * MiB <= WS_XN && WS_XN + 128 * MiB <= WS_QA && WS_G + 256 * MiB <= WS_OAB && WS_OAB + 96 * MiB <= WS_END && WS_Y + 256 * MiB <= WS_END, "d_ws map");
constexpr int CW_BAR = 4096;

constexpr int RING_OFF = 0, RING_BYTES = 131072;
constexpr int WSF_OFF = RING_BYTES;
constexpr int LDSCTL_OFF = RING_BYTES + 2048, MISC_OFF = LDSCTL_OFF + 320;
constexpr int LDS_BYTES = 147456;
static_assert(MISC_OFF + 128 <= LDS_BYTES, "LDS map");

#define GAS __attribute__((address_space(1)))
#define LAS __attribute__((address_space(3)))
typedef unsigned short bf16;
typedef unsigned v4u __attribute__((ext_vector_type(4)));
typedef float f32x4 __attribute__((ext_vector_type(4)));
typedef short bf16x8 __attribute__((ext_vector_type(8)));
typedef GAS unsigned gu32;
typedef GAS unsigned long long gu64;
#define RLX_AGENT __ATOMIC_RELAXED, __HIP_MEMORY_SCOPE_AGENT
#define LDS_WAIT() asm volatile("s_waitcnt lgkmcnt(0)" ::: "memory")
#define VM_WAIT() asm volatile("s_waitcnt vmcnt(0)" ::: "memory")
__device__ __forceinline__ unsigned long long rt() { return __builtin_amdgcn_s_memrealtime(); }
__device__ __forceinline__ unsigned f2bf(float f) { unsigned u = __builtin_bit_cast(unsigned, f); return (u + 0x7fffu + ((u >> 16) & 1u)) >> 16; }
__device__ __forceinline__ unsigned pk2(float lo, float hi) { return f2bf(lo) | (f2bf(hi) << 16); }

#define XB_TMO      128
#define XB_XCNT(j)  (256  + 64 * (j))
#define XB_XSUB(j)  (1280 + 64 * (j))
#define XB_XGEN(j)  (2304 + 64 * (j))
#define XB_TOP      3328
#define XB_TOPGEN   3392
#define XCD_BAR_WORDS 3456
#define XB_SPIN_CAP (1u << 18)

__device__ __forceinline__ unsigned xb_ld(unsigned* p)              { return __hip_atomic_load(p, __ATOMIC_RELAXED, __HIP_MEMORY_SCOPE_AGENT); }
__device__ __forceinline__ unsigned xb_add(unsigned* p, unsigned v) { return __hip_atomic_fetch_add(p, v, __ATOMIC_RELAXED, __HIP_MEMORY_SCOPE_AGENT); }
__device__ __forceinline__ unsigned xb_xcc_id() { return (unsigned)__builtin_amdgcn_s_getreg((3 << 11) | 20) & 0xFu; }
#define XB_SPIN(cond, bar) do { unsigned _sp = 0; while (cond) { __builtin_amdgcn_s_sleep(1); \
    if ((++_sp & 255u) == 0u) { if (xb_ld(&(bar)[XB_TMO])) break; if (_sp > XB_SPIN_CAP) { atomicAdd(&(bar)[XB_TMO], 1u); break; } } } } while (0)

struct XcdBarrier {
    unsigned* bar; unsigned x;
    volatile LAS unsigned* st;
};

__device__ __forceinline__ XcdBarrier xcd_barrier_post(unsigned* bar, volatile LAS unsigned* st) {
    XcdBarrier b; b.bar = bar; b.x = xb_xcc_id(); b.st = st;
    if (threadIdx.x == 0) (void)xb_add(&bar[XB_XCNT(b.x)], 1u);
    return b;
}
__device__ __forceinline__ void xcd_barrier_complete(unsigned* bar, unsigned x, unsigned& nloc, unsigned& nx) {
    const unsigned G = gridDim.x * gridDim.y * gridDim.z;
    unsigned sum, cnt, mine, sp = 0u;
    for (;;) {
        sum = 0u; cnt = 0u; mine = 0u;
#pragma unroll
        for (unsigned j = 0; j < 16; ++j) { const unsigned c = xb_ld(&bar[XB_XCNT(j)]); sum += c; cnt += (c > 0u) ? 1u : 0u; mine = (j == x) ? c : mine; }
        if (sum == G) break;
        __builtin_amdgcn_s_sleep(1);
        if ((++sp & 255u) == 0u) { if (xb_ld(&bar[XB_TMO])) break; if (sp > XB_SPIN_CAP) { atomicAdd(&bar[XB_TMO], 1u); break; } }
    }
    nloc = mine > 0u ? mine : 1u; nx = cnt > 0u ? cnt : 1u;
}

__device__ __forceinline__ void xcd_barrier(const XcdBarrier& b) {
    asm volatile("s_waitcnt vmcnt(0)" ::: "memory");
    __syncthreads();
    if (threadIdx.x == 0) {
        unsigned* bar = b.bar;
        __builtin_amdgcn_s_waitcnt(0);
        unsigned nloc = b.st[0], nx = b.st[1];
        if (nloc == 0u) { xcd_barrier_complete(bar, b.x, nloc, nx); b.st[0] = nloc; b.st[1] = nx; }
        const unsigned old = xb_add(&bar[XB_XSUB(b.x)], 1u);
        const unsigned gen = old / nloc;
        if (old + 1u == (gen + 1u) * nloc) {
            __builtin_amdgcn_fence(__ATOMIC_RELEASE, "agent");
            asm volatile("s_waitcnt vmcnt(0)" ::: "memory");
            const unsigned og = xb_add(&bar[XB_TOP], 1u);
            const unsigned tg = og / nx;
            if (og + 1u == (tg + 1u) * nx) xb_add(&bar[XB_TOPGEN], 1u);
            else XB_SPIN(xb_ld(&bar[XB_TOPGEN]) == tg, bar);
            __builtin_amdgcn_fence(__ATOMIC_ACQUIRE, "agent");
            xb_add(&bar[XB_XGEN(b.x)], 1u);
            asm volatile("s_waitcnt vmcnt(0)" ::: "memory");
        } else {
            XB_SPIN(xb_ld(&bar[XB_XGEN(b.x)]) == gen, bar);
            __builtin_amdgcn_fence(__ATOMIC_ACQUIRE, "agent");
            asm volatile("s_waitcnt vmcnt(0)" ::: "memory");
        }
    }
    __syncthreads();
}

struct Frame {
    LAS unsigned char* lds;
    volatile LAS unsigned* MISC;
    gu32* ctl;
    int tid, lane, wave;
    int vcu, G;
    float* out; unsigned char* ws;
};
enum InIdx { IN_X = 0, IN_NORM1_G, IN_W_IN, IN_B_GATES, IN_Q_NORM_G, IN_K_NORM_G, IN_W_O_A, IN_W_O_B, IN_W_OUT, IN_NORM2_G, IN_W_ROUTER, IN_W_GATE, IN_W_UP, IN_W_DOWN, IN_NORMF_G };
__device__ __forceinline__ const float* inptr(const Frame& F, int k) {
    volatile LAS unsigned* pt = (volatile LAS unsigned*)(F.lds + LDSCTL_OFF + 64);
    const unsigned lo = pt[2 * k], hi = pt[2 * k + 1];
    const GAS float* gp = (const GAS float*)(((unsigned long long)(unsigned)__builtin_amdgcn_readfirstlane((int)hi) << 32) | (unsigned)__builtin_amdgcn_readfirstlane((int)lo));
    return (const float*)gp;
}

__device__ __forceinline__ float wave_sum(float v) {
#pragma unroll
    for (int o = 1; o < 64; o <<= 1) v += __shfl_xor(v, o);
    return v;
}
__device__ __forceinline__ void p0_transpose_item(const float* W, int N, bf16* WT, int ldk, int drow0, int dcol0, LAS float* scr, int kb, int nb, int lane) {
    const int k0 = 64 * kb, n0 = 32 * nb;
#pragma unroll 8
    for (int i = 0; i < 32; ++i) { const int kk = 2 * i + (lane >> 5); scr[kk * 33 + (lane & 31)] = W[(size_t)(k0 + kk) * N + n0 + (lane & 31)]; }
    LDS_WAIT(); asm volatile("" ::: "memory");
    const int c = lane & 7;
#pragma unroll
    for (int j = 0; j < 4; ++j) { const int n = (lane >> 3) + 8 * j; const LAS float* s = scr + (8 * c) * 33 + n;
        v4u o; o.x = pk2(s[0 * 33], s[1 * 33]); o.y = pk2(s[2 * 33], s[3 * 33]); o.z = pk2(s[4 * 33], s[5 * 33]); o.w = pk2(s[6 * 33], s[7 * 33]);
        *(GAS v4u*)(WT + (size_t)(drow0 + n) * ldk + dcol0 + k0 + 8 * c) = o; }
    LDS_WAIT(); asm volatile("" ::: "memory");
}
__device__ __forceinline__ void p0_transpose_item_f8(const float* W, int N, unsigned char* WT, int ldk, int drow0, float wscale, LAS float* scr, int kb, int nb, int lane) {
    const int k0 = 64 * kb, n0 = 32 * nb;
#pragma unroll 8
    for (int i = 0; i < 32; ++i) { const int kk = 2 * i + (lane >> 5); scr[kk * 33 + (lane & 31)] = W[(size_t)(k0 + kk) * N + n0 + (lane & 31)]; }
    LDS_WAIT(); asm volatile("" ::: "memory");
    const int c = lane & 7;
#pragma unroll
    for (int j = 0; j < 4; ++j) { const int n = (lane >> 3) + 8 * j; const LAS float* s = scr + (8 * c) * 33 + n;
        const unsigned lo = pg8::pk4_fp8(s[0 * 33] * wscale, s[1 * 33] * wscale, s[2 * 33] * wscale, s[3 * 33] * wscale), hi = pg8::pk4_fp8(s[4 * 33] * wscale, s[5 * 33] * wscale, s[6 * 33] * wscale, s[7 * 33] * wscale);
        *(GAS unsigned long long*)(WT + (size_t)(drow0 + n) * ldk + k0 + 8 * c) = (unsigned long long)lo | ((unsigned long long)hi << 32); }
    LDS_WAIT(); asm volatile("" ::: "memory");
}
__device__ __forceinline__ void p0_prologue(Frame& F) {
    LAS float* scr = (LAS float*)(F.lds + RING_OFF + F.wave * 16384);
    const int gw = F.vcu * NWAVES + F.wave, NGW = F.G * NWAVES;
    bf16* WIN = (bf16*)(F.ws + WS_WIN); bf16* WO = (bf16*)(F.ws + WS_WO); bf16* WOUT = (bf16*)(F.ws + WS_WOUT); unsigned char* WGU = F.ws + WS_WGU; unsigned char* WD = F.ws + WS_WD;
    const float* w_in = inptr(F, IN_W_IN); const float* w_o_a = inptr(F, IN_W_O_A); const float* w_o_b = inptr(F, IN_W_O_B); const float* w_out = inptr(F, IN_W_OUT);
    const float* w_gate = inptr(F, IN_W_GATE); const float* w_up = inptr(F, IN_W_UP); const float* w_down = inptr(F, IN_W_DOWN);
    constexpr int I_IN = 16 * 160, I_OA = 8 * 32, I_OB = 4 * 32, I_OUT = 16 * 32, I_E = 16 * 32, NITEMS = I_IN + I_OA + I_OB + I_OUT + 3 * 16 * I_E;
    for (int it = gw; it < NITEMS; it += NGW) {
        int r = it;
#if GEMM1_FP8
        if (r < I_IN) { const int n0 = 32 * (r % 160);
            const int dr = n0 < 3072 ? n0 : (n0 < 4096 ? 3072 + ((n0 - 3072) >> 7) * 256 + ((n0 - 3072) & 127) : 3072 + ((n0 - 4096) >> 7) * 256 + 128 + ((n0 - 4096) & 127));
            p0_transpose_item_f8(w_in, N_IN, (unsigned char*)WIN, 1024, dr, pg8::F8_W_SCALE, scr, r / 160, r % 160, F.lane); continue; } r -= I_IN;
#else
        if (r < I_IN) { p0_transpose_item(w_in, N_IN, WIN, 1024, 32 * (r % 160), 0, scr, r / 160, r % 160, F.lane); continue; } r -= I_IN;
#endif
        if (r < I_OA) { p0_transpose_item(w_o_a, DM, WO, 768, 32 * (r % 32), 0, scr, r / 32, r % 32, F.lane); continue; } r -= I_OA;
        if (r < I_OB) { p0_transpose_item(w_o_b, DM, WO, 768, 32 * (r % 32), 512, scr, r / 32, r % 32, F.lane); continue; } r -= I_OB;
        if (r < I_OUT) { p0_transpose_item(w_out, DM, WOUT, 1024, 32 * (r % 32), 0, scr, r / 32, r % 32, F.lane); continue; } r -= I_OUT;
        const int which = r / (16 * I_E); r -= which * 16 * I_E; const int e = r / I_E, rr = r % I_E, kb = rr / 32, nb = rr % 32, n0 = 32 * nb;
        if (which == 0) p0_transpose_item_f8(w_gate + (size_t)e * DM * FF, FF, WGU + (size_t)e * 2048 * 1024, 1024, (n0 >> 7) * 256 + (n0 & 127), pg8::F8_W_SCALE, scr, kb, nb, F.lane);
        else if (which == 1) p0_transpose_item_f8(w_up + (size_t)e * DM * FF, FF, WGU + (size_t)e * 2048 * 1024, 1024, (n0 >> 7) * 256 + 128 + (n0 & 127), pg8::F8_W_SCALE, scr, kb, nb, F.lane);
        else p0_transpose_item_f8(w_down + (size_t)e * FF * DM, DM, WD + (size_t)e * 1024 * 1024, 1024, n0, pg8::F8_W_SCALE, scr, kb, nb, F.lane);
    }
    bf16* XN = (bf16*)(F.ws + WS_XN); const float* xin = inptr(F, IN_X); const float* norm1_g = inptr(F, IN_NORM1_G);
    f32x4 gg[4];
#pragma unroll
    for (int j = 0; j < 4; ++j) gg[j] = ((const GAS f32x4*)norm1_g)[F.lane + 64 * j];
    for (int m = gw; m < M; m += NGW) {
        const GAS f32x4* xr = (const GAS f32x4*)(xin + (size_t)m * DM) + F.lane;
        f32x4 v[4]; float s2 = 0.f;
#pragma unroll
        for (int j = 0; j < 4; ++j) { v[j] = xr[64 * j]; s2 += (v[j].x * v[j].x + v[j].y * v[j].y) + (v[j].z * v[j].z + v[j].w * v[j].w); }
        const float rs = 1.0f / sqrtf(wave_sum(s2) * (1.f / DM) + NORM_EPS);
        GAS unsigned long long* o8 = (GAS unsigned long long*)(XN + (size_t)m * DM) + F.lane;
#pragma unroll
#if GEMM1_FP8
        for (int j = 0; j < 4; ++j) { const f32x4 y = v[j] * (rs * pg8::F8_ACT_SCALE) * gg[j]; ((GAS unsigned*)((unsigned char*)XN + (size_t)m * DM) + F.lane)[64 * j] = pg8::pk4_fp8(y.x, y.y, y.z, y.w); }
#else
        for (int j = 0; j < 4; ++j) { const f32x4 y = v[j] * rs * gg[j]; o8[64 * j] = (unsigned long long)pk2(y.x, y.y) | ((unsigned long long)pk2(y.z, y.w) << 32); }
#endif
    }
}
__device__ __forceinline__ void p2_qknorm_rope(Frame& F) {
    const int gw = F.vcu * NWAVES + F.wave, NGW = F.G * NWAVES, lane = F.lane, s = lane & 7;
    bf16* QA = (bf16*)(F.ws + WS_QA); bf16* KVA = (bf16*)(F.ws + WS_KVA); unsigned char* Q8 = F.ws + WS_Q8; unsigned char* K8 = F.ws + WS_K8; unsigned char* VT8 = F.ws + WS_VT8;
    const float* q_norm_g = inptr(F, IN_Q_NORM_G); const float* k_norm_g = inptr(F, IN_K_NORM_G);
    float qg[8], kg[8], invf[8];
#pragma unroll
    for (int i = 0; i < 8; ++i) { qg[i] = q_norm_g[s * 8 + i]; kg[i] = k_norm_g[s * 8 + i]; invf[i] = exp2f(-(float)((s & 1) * 8 + i) * 0.8304820237218406f) * 0.15915494309189535f; }
    const bool first = (s & 2) == 0;
    for (int m = gw; m < M; m += NGW) {
        const int t = m & (SEQ - 1); const float pos = (float)((s < 4) ? (t >> 6) : (t & 63));
        float cs[8], sn[8];
#pragma unroll
        for (int i = 0; i < 8; ++i) { float rev = pos * invf[i]; rev -= rintf(rev); cs[i] = __builtin_amdgcn_cosf(rev); sn[i] = __builtin_amdgcn_sinf(rev); if (first) sn[i] = -sn[i]; }
#pragma unroll
        for (int pass = 0; pass < 2; ++pass) {
            const bool act = (pass == 0) || (lane < 16);
            GAS v4u* p = pass == 0 ? (GAS v4u*)(QA + (size_t)m * 512) + lane : (GAS v4u*)(KVA + (size_t)m * 256) + (lane & 15);
            v4u w = (v4u){0u, 0u, 0u, 0u}; if (act) w = *p;
            float v[8] = {__uint_as_float(w.x << 16), __uint_as_float(w.x & 0xffff0000u), __uint_as_float(w.y << 16), __uint_as_float(w.y & 0xffff0000u),
                          __uint_as_float(w.z << 16), __uint_as_float(w.z & 0xffff0000u), __uint_as_float(w.w << 16), __uint_as_float(w.w & 0xffff0000u)};
            float ss = 0.f;
#pragma unroll
            for (int i = 0; i < 8; ++i) ss += v[i] * v[i];
            ss += __shfl_xor(ss, 1); ss += __shfl_xor(ss, 2); ss += __shfl_xor(ss, 4);
            const float rs = (1.0f / sqrtf(ss * (1.f / 64.f) + NORM_EPS)) * (pass == 0 ? pg8::QSCALE : 1.0f);
            float o[8];
#pragma unroll
            for (int i = 0; i < 8; ++i) { const float y = v[i] * rs * (pass == 0 ? qg[i] : kg[i]); const float pr = __shfl_xor(y, 2); o[i] = y * cs[i] + pr * sn[i]; }
            const unsigned long long w8 = (unsigned long long)pg8::pk4_fp8(o[0], o[1], o[2], o[3]) | ((unsigned long long)pg8::pk4_fp8(o[4], o[5], o[6], o[7]) << 32);
            if (act) { if (pass == 0) *((GAS unsigned long long*)(Q8 + (size_t)m * 512) + lane) = w8; else *((GAS unsigned long long*)(K8 + (size_t)m * 128) + (lane & 15)) = w8; }
        }
    }
    LAS unsigned char* tb = F.lds + RING_OFF + F.wave * 16384;
    for (int T = gw; T < BATCH * 2 * (SEQ / 64); T += NGW) {
        const int b = T >> 8, kvh = (T >> 7) & 1, t0 = (T & 127) * 64;
        const GAS v4u* src = (const GAS v4u*)(KVA + ((size_t)b * SEQ + t0 + lane) * 256 + 128 + kvh * 64);
        v4u rv[8];
#pragma unroll
        for (int i = 0; i < 8; ++i) rv[i] = src[i];
#pragma unroll
        for (int i = 0; i < 8; ++i) {
            const unsigned lo = pg8::pk4_fp8(__uint_as_float(rv[i].x << 16), __uint_as_float(rv[i].x & 0xffff0000u), __uint_as_float(rv[i].y << 16), __uint_as_float(rv[i].y & 0xffff0000u));
            const unsigned hi = pg8::pk4_fp8(__uint_as_float(rv[i].z << 16), __uint_as_float(rv[i].z & 0xffff0000u), __uint_as_float(rv[i].w << 16), __uint_as_float(rv[i].w & 0xffff0000u));
            *(LAS unsigned*)(tb + lane * 68 + i * 8) = lo; *(LAS unsigned*)(tb + lane * 68 + i * 8 + 4) = hi; }
        LDS_WAIT(); asm volatile("" ::: "memory");
        v4u ov[4];
#pragma unroll
        for (int i = 0; i < 4; ++i) { unsigned wv[4];
#pragma unroll
            for (int q = 0; q < 4; ++q) { const int tt = i * 16 + q * 4;
                wv[q] = (unsigned)tb[(tt + 0) * 68 + lane] | ((unsigned)tb[(tt + 1) * 68 + lane] << 8) | ((unsigned)tb[(tt + 2) * 68 + lane] << 16) | ((unsigned)tb[(tt + 3) * 68 + lane] << 24); }
            ov[i] = (v4u){wv[0], wv[1], wv[2], wv[3]}; }
        GAS v4u* dst = (GAS v4u*)(VT8 + ((size_t)(b * 2 + kvh) * 64 + lane) * SEQ + t0);
#pragma unroll
        for (int i = 0; i < 4; ++i) dst[i] = ov[i];
        LDS_WAIT(); asm volatile("" ::: "memory");
    }
}
__device__ __forceinline__ void p6_norm2_router(Frame& F) {
    constexpr int WP = 1028;
    LAS float* Wt = (LAS float*)(F.lds + RING_OFF);
    LAS float* g2s = (LAS float*)(F.lds + RING_OFF + 16 * WP * 4);
    const float* w_router = inptr(F, IN_W_ROUTER); const float* norm2_g = inptr(F, IN_NORM2_G);
    for (int i = F.tid; i < DM * NE; i += NWAVES * 64) Wt[(i & 15) * WP + (i >> 4)] = w_router[i] * norm2_g[i >> 4];
    for (int i = F.tid; i < DM; i += NWAVES * 64) g2s[i] = norm2_g[i];
    __syncthreads();
    const int gw = F.vcu * NWAVES + F.wave, NGW = F.G * NWAVES, lane = F.lane, t = lane & 15, kq = lane >> 4;
    const bf16* XB = (const bf16*)(F.ws + WS_XB); unsigned char* XF8 = F.ws + WS_XN; float* AFF = (float*)(F.ws + WS_AFF);
    const LAS float* wl = Wt + t * WP + 256 * kq; const LAS float* gl = g2s + 256 * kq;
#pragma unroll 1
    for (int T = gw; T < M / 16; T += NGW) {
        const size_t row = (size_t)T * 16 + t;
        const GAS v4u* xp = (const GAS v4u*)(XB + row * DM + 256 * kq);
        f32x4 acc = {0.f, 0.f, 0.f, 0.f}; float ss = 0.f;
        v4u xn[8];
#pragma unroll
        for (int c = 0; c < 8; ++c) xn[c] = xp[c];
#pragma unroll 1
        for (int cb = 0; cb < 4; ++cb) {
            v4u xr[8];
#pragma unroll
            for (int c = 0; c < 8; ++c) xr[c] = xn[c];
            if (cb < 3) {
#pragma unroll
                for (int c = 0; c < 8; ++c) xn[c] = xp[8 * (cb + 1) + c]; }
#pragma unroll
            for (int c = 0; c < 8; ++c) {
                const f32x4 w0 = *(const LAS f32x4*)(wl + 64 * cb + 8 * c), w1 = *(const LAS f32x4*)(wl + 64 * cb + 8 * c + 4);
                const float x0 = __uint_as_float(xr[c].x << 16), x1 = __uint_as_float(xr[c].x & 0xffff0000u), x2 = __uint_as_float(xr[c].y << 16), x3 = __uint_as_float(xr[c].y & 0xffff0000u);
                const float x4 = __uint_as_float(xr[c].z << 16), x5 = __uint_as_float(xr[c].z & 0xffff0000u), x6 = __uint_as_float(xr[c].w << 16), x7 = __uint_as_float(xr[c].w & 0xffff0000u);
                ss += (x0 * x0 + x1 * x1) + (x2 * x2 + x3 * x3) + (x4 * x4 + x5 * x5) + (x6 * x6 + x7 * x7);
                acc = __builtin_amdgcn_mfma_f32_16x16x4f32(x0, w0.x, acc, 0, 0, 0); acc = __builtin_amdgcn_mfma_f32_16x16x4f32(x1, w0.y, acc, 0, 0, 0);
                acc = __builtin_amdgcn_mfma_f32_16x16x4f32(x2, w0.z, acc, 0, 0, 0); acc = __builtin_amdgcn_mfma_f32_16x16x4f32(x3, w0.w, acc, 0, 0, 0);
                acc = __builtin_amdgcn_mfma_f32_16x16x4f32(x4, w1.x, acc, 0, 0, 0); acc = __builtin_amdgcn_mfma_f32_16x16x4f32(x5, w1.y, acc, 0, 0, 0);
                acc = __builtin_amdgcn_mfma_f32_16x16x4f32(x6, w1.z, acc, 0, 0, 0); acc = __builtin_amdgcn_mfma_f32_16x16x4f32(x7, w1.w, acc, 0, 0, 0);
                if (c & 1) asm volatile("" ::: "memory");
            }
        }
        ss += __shfl_xor(ss, 16); ss += __shfl_xor(ss, 32);
        const float rs = 1.0f / sqrtf(ss * (1.f / DM) + NORM_EPS);
#pragma unroll
        for (int r = 0; r < 4; ++r) {
            const float lg = acc[r] * __shfl(rs, 4 * kq + r);
            float mx = lg;
#pragma unroll
            for (int o = 1; o < 16; o <<= 1) mx = fmaxf(mx, __shfl_xor(mx, o));
            const float ex = __expf(lg - mx); float sm = ex;
#pragma unroll
            for (int o = 1; o < 16; o <<= 1) sm += __shfl_xor(sm, o);
            AFF[((size_t)T * 16 + 4 * kq + r) * NE + t] = ex / sm;
        }
        GAS v4u* op = (GAS v4u*)(XF8 + row * DM + 256 * kq); const float sc = rs * pg8::F8_ACT_SCALE;
#pragma unroll
        for (int c = 0; c < 8; ++c) xn[c] = xp[c];
#pragma unroll 1
        for (int cb = 0; cb < 4; ++cb) {
            v4u xr[8];
#pragma unroll
            for (int c = 0; c < 8; ++c) xr[c] = xn[c];
            if (cb < 3) {
#pragma unroll
                for (int c = 0; c < 8; ++c) xn[c] = xp[8 * (cb + 1) + c]; }
#pragma unroll
            for (int c2 = 0; c2 < 4; ++c2) { v4u o;
#pragma unroll
                for (int hh = 0; hh < 2; ++hh) { const int c = 2 * c2 + hh; const f32x4 g0 = *(const LAS f32x4*)(gl + 64 * cb + 8 * c), g1 = *(const LAS f32x4*)(gl + 64 * cb + 8 * c + 4);
                    const unsigned a = pg8::pk4_fp8(__uint_as_float(xr[c].x << 16) * sc * g0.x, __uint_as_float(xr[c].x & 0xffff0000u) * sc * g0.y, __uint_as_float(xr[c].y << 16) * sc * g0.z, __uint_as_float(xr[c].y & 0xffff0000u) * sc * g0.w);
                    const unsigned bq = pg8::pk4_fp8(__uint_as_float(xr[c].z << 16) * sc * g1.x, __uint_as_float(xr[c].z & 0xffff0000u) * sc * g1.y, __uint_as_float(xr[c].w << 16) * sc * g1.z, __uint_as_float(xr[c].w & 0xffff0000u) * sc * g1.w);
                    if (hh == 0) { o.x = a; o.y = bq; } else { o.z = a; o.w = bq; } }
                op[4 * cb + c2] = o; asm volatile("" ::: "memory"); }
        }
    }
    __syncthreads();
}
__device__ __forceinline__ int block_excl_scan(int v, LAS int* sc, int tid, int lane, int wave, int& total) {
    int inc = v;
#pragma unroll
    for (int o = 1; o < 64; o <<= 1) { const int t = __shfl_up(inc, o); if (lane >= o) inc += t; }
    __syncthreads();
    if (lane == 63) sc[wave] = inc;
    __syncthreads();
    int base = 0, tot = 0;
#pragma unroll
    for (int w = 0; w < NWAVES; ++w) { const int t = sc[w]; if (w < wave) base += t; tot += t; }
    total = tot; return base + inc - v;
}
__device__ __forceinline__ void p7_topk(Frame& F) {
    LAS unsigned* hist = (LAS unsigned*)(F.lds + RING_OFF);
    LAS int* sc = (LAS int*)(F.lds + RING_OFF + 1024);
    LAS unsigned* sel = (LAS unsigned*)(F.lds + RING_OFF + 1024 + 64);
    const float* AFF = (const float*)(F.ws + WS_AFF); int* TOPI = (int*)(F.ws + WS_TOPI); float* TOPG = (float*)(F.ws + WS_TOPG); int* TSLOT = (int*)(F.ws + WS_TSLOT);
    const int tid = F.tid, lane = F.lane, wave = F.wave;
    for (int g = blockIdx.x; g < BATCH * NE; g += F.G) {
        const int b = g >> 4, e = g & 15;
        unsigned k[16];
#pragma unroll
        for (int i = 0; i < 16; ++i) k[i] = __float_as_uint(AFF[((size_t)b * SEQ + tid * 16 + i) * NE + e]);
        unsigned prefix = 0u, mask = 0u, remaining = CAP;
#pragma unroll 1
        for (int pass = 3; pass >= 0; --pass) {
            const int shift = pass * 8;
            __syncthreads();
            if (tid < 256) hist[tid] = 0u;
            __syncthreads();
#pragma unroll
            for (int i = 0; i < 16; ++i) if ((k[i] & mask) == prefix) atomicAdd((unsigned*)&hist[(k[i] >> shift) & 255u], 1u);
            __syncthreads();
            if (wave == 0) {
                unsigned c[4]; unsigned tot = 0u;
#pragma unroll
                for (int q = 0; q < 4; ++q) { c[q] = hist[255 - 4 * lane - q]; tot += c[q]; }
                unsigned inc = tot;
#pragma unroll
                for (int o = 1; o < 64; o <<= 1) { const unsigned t = __shfl_up(inc, o); if (lane >= o) inc += t; }
                const unsigned exc = inc - tot;
                if (exc < remaining && remaining <= inc) { unsigned cum = exc, rem = 0u; int bin = 0; bool found = false;
#pragma unroll
                    for (int q = 0; q < 4; ++q) { if (!found && cum + c[q] >= remaining) { bin = 255 - 4 * lane - q; rem = remaining - cum; found = true; } cum += c[q]; }
                    sel[0] = (unsigned)bin; sel[1] = rem; }
            }
            __syncthreads();
            prefix |= sel[0] << shift; mask |= 255u << shift; remaining = sel[1];
        }
        int cgt = 0, ceq = 0;
#pragma unroll
        for (int i = 0; i < 16; ++i) { cgt += (k[i] > prefix) ? 1 : 0; ceq += (k[i] == prefix) ? 1 : 0; }
        int toteq; const int eq0 = block_excl_scan(ceq, sc, tid, lane, wave, toteq);
        int nsel = cgt; { int rk = eq0;
#pragma unroll
            for (int i = 0; i < 16; ++i) if (k[i] == prefix) { if ((unsigned)rk < remaining) ++nsel; ++rk; } }
        int totsel; int pos = block_excl_scan(nsel, sc, tid, lane, wave, totsel);
        int rk = eq0;
#pragma unroll
        for (int i = 0; i < 16; ++i) {
            const int stok = tid * 16 + i; bool take = k[i] > prefix;
            if (k[i] == prefix) { take = (unsigned)rk < remaining; ++rk; }
            int slot = -1;
            if (take) { slot = pos; TOPI[g * CAP + pos] = stok; TOPG[g * CAP + pos] = __uint_as_float(k[i]); ++pos; }
            TSLOT[((size_t)b * SEQ + stok) * NE + e] = slot;
        }
    }
    __syncthreads();
}
__device__ __forceinline__ void p8_gather(Frame& F) {
    const int gw = F.vcu * NWAVES + F.wave, NGW = F.G * NWAVES, lane = F.lane;
    const unsigned char* XF8 = F.ws + WS_XN; unsigned char* XG = F.ws + WS_XG; const int* TOPI = (const int*)(F.ws + WS_TOPI);
    for (int r = gw; r < MR; r += NGW) {
        const int b = r >> 14; const int tok = TOPI[r];
        const GAS v4u* src = (const GAS v4u*)(XF8 + ((size_t)b * SEQ + tok) * DM) + lane; GAS v4u* dst = (GAS v4u*)(XG + (size_t)r * DM) + lane;
        dst[0] = src[0];
    }
}
__device__ __forceinline__ void p11_final(Frame& F, bool poison) {
    const int gw = F.vcu * NWAVES + F.wave, NGW = F.G * NWAVES, lane = F.lane;
    const unsigned char* Y = F.ws + WS_Y; const int* TSLOT = (const int*)(F.ws + WS_TSLOT);
    f32x4 gg[4];
#pragma unroll
    for (int j = 0; j < 4; ++j) gg[j] = ((const GAS f32x4*)inptr(F, IN_NORMF_G))[lane + 64 * j];
    const float qnan = __builtin_nanf("");
    unsigned long long xw[4] = {0ull, 0ull, 0ull, 0ull}; int slotw = -1;
    if (gw < M) { const GAS unsigned long long* xb = (const GAS unsigned long long*)((const bf16*)(F.ws + WS_XB) + (size_t)gw * DM) + lane;
#pragma unroll
        for (int j = 0; j < 4; ++j) xw[j] = xb[64 * j];
        slotw = TSLOT[(size_t)gw * NE + (lane & 15)]; }
    for (int m = gw; m < M; m += NGW) {
        GAS f32x4* xr = (GAS f32x4*)(F.out + (size_t)m * DM) + lane;
        f32x4 v[4];
#pragma unroll
        for (int j = 0; j < 4; ++j) { const unsigned lo = (unsigned)xw[j], hi = (unsigned)(xw[j] >> 32);
            v[j] = (f32x4){__uint_as_float(lo << 16), __uint_as_float(lo & 0xffff0000u), __uint_as_float(hi << 16), __uint_as_float(hi & 0xffff0000u)}; }
        const int b = m >> 13; const int myslot = slotw;
        if (m + NGW < M) { const GAS unsigned long long* xb = (const GAS unsigned long long*)((const bf16*)(F.ws + WS_XB) + (size_t)(m + NGW) * DM) + lane;
#pragma unroll
            for (int j = 0; j < 4; ++j) xw[j] = xb[64 * j];
            slotw = TSLOT[(size_t)(m + NGW) * NE + (lane & 15)]; }
        unsigned msk = (unsigned)(__builtin_amdgcn_ballot_w64(myslot >= 0 && lane < 16) & 0xffffull);
#pragma unroll 1
        while (msk) {
            const int e0 = __builtin_ctz(msk); msk &= msk - 1u; const bool two = msk != 0u; const int e1 = two ? __builtin_ctz(msk) : e0; if (two) msk &= msk - 1u;
            const int s0 = __builtin_amdgcn_readlane(myslot, e0), s1 = __builtin_amdgcn_readlane(myslot, e1);
            const GAS int* y0 = (const GAS int*)(Y + ((size_t)(b * NE + e0) * CAP + s0) * DM) + lane; const GAS int* y1 = (const GAS int*)(Y + ((size_t)(b * NE + e1) * CAP + s1) * DM) + lane;
            int w0[4], w1[4];
#pragma unroll
            for (int j = 0; j < 4; ++j) { w0[j] = y0[64 * j]; w1[j] = y1[64 * j]; }
            typedef float f32x2v __attribute__((ext_vector_type(2)));
#pragma unroll
            for (int j = 0; j < 4; ++j) { const f32x2v lo = __builtin_amdgcn_cvt_pk_f32_fp8(w0[j], false), hi = __builtin_amdgcn_cvt_pk_f32_fp8(w0[j], true);
                v[j].x += lo.x * (1.0f / pg8::Y_SCALE); v[j].y += lo.y * (1.0f / pg8::Y_SCALE); v[j].z += hi.x * (1.0f / pg8::Y_SCALE); v[j].w += hi.y * (1.0f / pg8::Y_SCALE); }
            if (two) {
#pragma unroll
                for (int j = 0; j < 4; ++j) { const f32x2v lo = __builtin_amdgcn_cvt_pk_f32_fp8(w1[j], false), hi = __builtin_amdgcn_cvt_pk_f32_fp8(w1[j], true);
                    v[j].x += lo.x * (1.0f / pg8::Y_SCALE); v[j].y += lo.y * (1.0f / pg8::Y_SCALE); v[j].z += hi.x * (1.0f / pg8::Y_SCALE); v[j].w += hi.y * (1.0f / pg8::Y_SCALE); } }
        }
        float s2 = 0.f;
#pragma unroll
        for (int j = 0; j < 4; ++j) s2 += (v[j].x * v[j].x + v[j].y * v[j].y) + (v[j].z * v[j].z + v[j].w * v[j].w);
        const float rs = 1.0f / sqrtf(wave_sum(s2) * (1.f / DM) + NORM_EPS);
#pragma unroll
        for (int j = 0; j < 4; ++j) { f32x4 o = v[j] * rs * gg[j]; if (poison) o = (f32x4){qnan, qnan, qnan, qnan}; xr[64 * j] = o; }
    }
}

struct Args { const float* in[15]; float* out; unsigned char* ws; int ph_lo, ph_hi; };
__global__ void __launch_bounds__(NWAVES * 64, 2) hyb_fwd(Args args) {
    extern __shared__ __attribute__((aligned(16))) unsigned char lds[];
    Frame F;
    F.lds = (LAS unsigned char*)lds;
    F.MISC = (volatile LAS unsigned*)(F.lds + MISC_OFF);
    F.tid = threadIdx.x; F.lane = F.tid & 63; F.wave = __builtin_amdgcn_readfirstlane(F.tid >> 6);
    F.G = gridDim.x; { const int bx = blockIdx.x; F.vcu = (F.G % 8 == 0) ? (bx % 8) * (F.G / 8) + bx / 8 : bx; }
    F.ws = args.ws; F.ctl = (gu32*)(args.ws + WS_CTL); F.out = args.out;
    for (int u = F.tid; u < (LDS_BYTES - LDSCTL_OFF) / 4; u += NWAVES * 64) ((LAS unsigned*)(F.lds + LDSCTL_OFF))[u] = 0u;
    __syncthreads();
    if (F.tid == 0) { LAS unsigned long long* pt = (LAS unsigned long long*)(F.lds + LDSCTL_OFF + 64);
#pragma unroll
        for (int k = 0; k < 15; ++k) pt[k] = (unsigned long long)args.in[k]; }
    __syncthreads();
    XcdBarrier bar; bar.bar = (unsigned*)(F.ctl + CW_BAR); bar.x = 0; bar.st = nullptr;
    if (N_LAUNCHES == 1) bar = xcd_barrier_post((unsigned*)(F.ctl + CW_BAR), F.MISC + 8);
#define GRID_BAR() do { if (N_LAUNCHES == 1) { xcd_barrier(bar); } } while (0)
    const int lo = args.ph_lo, hi = args.ph_hi;
#ifndef PH_MASK
#define PH_MASK 0xFFF
#endif
#define IN(k) (((PH_MASK >> (k)) & 1) && lo <= (k) && (k) < hi)
#define BOTH(k) (IN(k) && IN((k) + 1))
#ifndef DUP_MASK
#define DUP_MASK 0
#endif
#define REP(k) _Pragma("unroll 1") for (int rep_ = 0; rep_ < (((DUP_MASK >> (k)) & 1) ? 2 : 1); ++rep_)
    unsigned char* ws = args.ws;
    pg8::bf16_t* XN = (pg8::bf16_t*)(ws + WS_XN);

    if (IN(0)) { REP(0) { p0_prologue(F); } if (BOTH(0)) GRID_BAR(); }

    if (IN(1)) {
        pg8::Gemm g{XN, (const pg8::bf16_t*)(ws + WS_WIN), GEMM1_FP8 ? DM / 2 : DM, GEMM1_FP8 ? DM / 2 : DM, GEMM1_FP8 ? DM / 2 : DM, nullptr}; pg8::StaticOrder S; S.init(M, N_IN, F.G, (int)blockIdx.x, GEMM1_WGM);
        pg8::EpiZ E{(pg8::bf16_t*)(ws + WS_QA), (pg8::bf16_t*)(ws + WS_KVA), (pg8::bf16_t*)(ws + WS_QB), (pg8::bf16_t*)(ws + WS_KB), (pg8::bf16_t*)(ws + WS_VB), (pg8::bf16_t*)(ws + WS_G), inptr(F, IN_B_GATES), GEMM1_FP8 ? pg8::F8_DEQ : 1.0f};
        REP(1) { pg8::gemm_phase<pg8::EpiZ, pg8::StaticOrder, true, true, GEMM1_FP8 != 0>(F.lds + RING_OFF, g, S, E); }
        if ((DUP_MASK >> 14) & 1) { pg8::EpiNull EN; pg8::gemm_phase<pg8::EpiNull, pg8::StaticOrder, true, true, GEMM1_FP8 != 0>(F.lds + RING_OFF, g, S, EN); }
        if (BOTH(1)) GRID_BAR();
    }
    if (IN(2)) { p2_qknorm_rope(F); if (BOTH(2)) GRID_BAR(); }

    if (IN(3)) {
        static_assert(attn_body::ATTN_LDS_BYTES <= RING_BYTES, "attention body geometry vs frame");
        const attn_body::AttnTensors AT{(const attn_body::bf16*)(ws + WS_QA), (const attn_body::bf16*)(ws + WS_KVA), (const attn_body::bf16*)(ws + WS_KVA) + 128, (attn_body::bf16*)(ws + WS_OAB)};
        const attn_body::StaticOrder S((int)F.G, F.vcu);
        float cref; { const float* qg = inptr(F, IN_Q_NORM_G); const float* kg = inptr(F, IN_K_NORM_G); float mq = 0.f, mk = 0.f;
            for (int i = 0; i < 64; ++i) { mq = fmaxf(mq, fabsf(qg[i])); mk = fmaxf(mk, fabsf(kg[i])); }
            cref = 8.0f * mq * mk * 1.4426950408889634f * 1.02f + 0.05f; cref = __builtin_bit_cast(float, __builtin_amdgcn_readfirstlane(__builtin_bit_cast(int, cref))); }
#if ATTN_FP8
        { const float cref8 = fmaxf(0.f, cref - 15.5f); attn_body::AttnUnit u;
          REP(12) { if (cref8 == 0.f) { for (int i = 0; S.next(i, u); ++i) attn8::unit<0, true>(u.b, u.h, u.qb, ws + WS_Q8, ws + WS_K8, ws + WS_VT8, (attn_body::bf16*)(ws + WS_OAB), (char*)lds + RING_OFF, 0.f); }
                    else { for (int i = 0; S.next(i, u); ++i) attn8::unit<0, false>(u.b, u.h, u.qb, ws + WS_Q8, ws + WS_K8, ws + WS_VT8, (attn_body::bf16*)(ws + WS_OAB), (char*)lds + RING_OFF, cref8); } } }
#ifdef A8_PROBE_MODE
        { const float cref8 = fmaxf(0.f, cref - 15.5f); attn_body::AttnUnit u; attn_body::bf16* dummyO = (attn_body::bf16*)(ws + WS_QA);
          for (int i = 0; S.next(i, u); ++i) attn8::unit<A8_PROBE_MODE, true>(u.b, u.h, u.qb, ws + WS_Q8, ws + WS_K8, ws + WS_VT8, dummyO, (char*)lds + RING_OFF, cref8); }
#endif
#else
        REP(12) { attn_body::attn_phase<attn_body::StaticOrder>((char*)lds + RING_OFF, AT, S, cref); }
#endif
        __syncthreads();
        REP(13) {
            char* wl = (char*)lds + RING_OFF + F.wave * 16384; float* wsf = (float*)((char*)lds + WSF_OFF) + F.wave * 64;
            int lane2 = F.lane; asm volatile("" : "+v"(lane2));
#pragma unroll 1
            for (int L = F.vcu; L < BATCH * 4 * 16; L += F.G)
                attnb2::b2_unit(lane2, L >> 6, (L >> 4) & 3, L & 15, F.wave, (const attn_body::bf16*)(ws + WS_QB), (const attn_body::bf16*)(ws + WS_KB), (const attn_body::bf16*)(ws + WS_VB), (attn_body::bf16*)(ws + WS_OAB), (float*)(ws + WS_AFF), wl, wsf);
        }
#ifdef B2_PROBE_MODE
        { char* wl = (char*)lds + RING_OFF + F.wave * 16384; float* wsf = (float*)((char*)lds + WSF_OFF) + F.wave * 64; int lane2 = F.lane; asm volatile("" : "+v"(lane2));
          for (int L = F.vcu; L < BATCH * 4 * 16; L += F.G) attnb2::b2_unit<B2_PROBE_MODE>(lane2, L >> 6, (L >> 4) & 3, L & 15, F.wave, (const attn_body::bf16*)(ws + WS_QB), (const attn_body::bf16*)(ws + WS_KB), (const attn_body::bf16*)(ws + WS_VB), (attn_body::bf16*)(ws + WS_QA), (float*)(ws + WS_AFF + 2 * MiB), wl, wsf); }
#endif
        asm volatile("s_waitcnt vmcnt(0) lgkmcnt(0)" ::: "memory");
        __syncthreads();
        if (BOTH(3)) GRID_BAR();
    }
    if (IN(4)) {
        const pg8::bf16_t* OAB = (const pg8::bf16_t*)(ws + WS_OAB); const pg8::bf16_t* WO = (const pg8::bf16_t*)(ws + WS_WO); const pg8::bf16_t* Gt = (const pg8::bf16_t*)(ws + WS_G);
        pg8::StaticOrder S; S.init(M, DM, F.G, (int)blockIdx.x);
        REP(4) { pg8::Gemm g{OAB, WO, 768, 768, 768, nullptr}; pg8::EpiGateHook E{Gt, XN}; pg8::gemm_phase<pg8::EpiGateHook, pg8::StaticOrder, true, true>(F.lds + RING_OFF, g, S, E); }
        if (BOTH(4)) GRID_BAR();
    }
    if (IN(5)) {
        pg8::Gemm g{XN, (const pg8::bf16_t*)(ws + WS_WOUT), DM, DM, DM, nullptr}; pg8::StaticOrder S; S.init(M, DM, F.G, (int)blockIdx.x);
        pg8::EpiResBf16 E{inptr(F, IN_X), (pg8::bf16_t*)(ws + WS_XB)};
        REP(5) { pg8::gemm_phase<pg8::EpiResBf16, pg8::StaticOrder, true, true>(F.lds + RING_OFF, g, S, E); }
        if (BOTH(5)) GRID_BAR();
    }
    if (IN(6)) { REP(6) { p6_norm2_router(F); } if (BOTH(6)) GRID_BAR(); }
    if (IN(7)) { REP(7) { p7_topk(F); } if (BOTH(7)) GRID_BAR(); }
    if (IN(9)) {
        pg8::Gemm g{(const pg8::bf16_t*)(ws + WS_XN), (const pg8::bf16_t*)(ws + WS_WGU), DM / 2, DM / 2, DM / 2, (const int*)(ws + WS_TOPI)}; pg8::MoeOrderGU S{F.G, F.vcu};
        pg8::EpiSwiglu E{ws + WS_ACT};
        pg8::gemm_phase<pg8::EpiSwiglu, pg8::MoeOrderGU, true, true, true, true>(F.lds + RING_OFF, g, S, E);
        if ((DUP_MASK >> 9) & 1) { asm volatile("" ::: "memory"); pg8::gemm_phase<pg8::EpiSwiglu, pg8::MoeOrderGU, true, true, true, true>(F.lds + RING_OFF, g, S, E); }
        if ((DUP_MASK >> 18) & 1) { pg8::EpiSwigluT<false> E2{E.O}; pg8::gemm_phase<pg8::EpiSwigluT<false>, pg8::MoeOrderGU, true, true, true, true>(F.lds + RING_OFF, g, S, E2); }
        if ((DUP_MASK >> 15) & 1) { pg8::EpiNull EN; pg8::gemm_phase<pg8::EpiNull, pg8::MoeOrderGU, true, true, true, true>(F.lds + RING_OFF, g, S, EN); }
        if ((DUP_MASK >> 16) & 1) { pg8::EpiNull EN; pg8::gemm_phase<pg8::EpiNull, pg8::MoeOrderGU, true, true, false, true>(F.lds + RING_OFF, g, S, EN); }
        if (BOTH(9)) GRID_BAR();
    }
    if (IN(10)) {
        pg8::Gemm g{(const pg8::bf16_t*)(ws + WS_ACT), (const pg8::bf16_t*)(ws + WS_WD), FF / 2, FF / 2, FF / 2, nullptr}; pg8::MoeOrderDown S{F.G, F.vcu};
        pg8::EpiDown E{ws + WS_Y, (const float*)(ws + WS_TOPG)};
        pg8::gemm_phase<pg8::EpiDown, pg8::MoeOrderDown, true, true, true>(F.lds + RING_OFF, g, S, E);
        if ((DUP_MASK >> 10) & 1) { asm volatile("" ::: "memory"); pg8::gemm_phase<pg8::EpiDown, pg8::MoeOrderDown, true, true, true>(F.lds + RING_OFF, g, S, E); }
        if (BOTH(10)) GRID_BAR();
    }
    if (IN(11)) {
        bool poison = false;
        if (N_LAUNCHES == 1) poison = __hip_atomic_load((gu32*)((const unsigned*)(F.ctl + CW_BAR) + XB_TMO), RLX_AGENT) != 0u;
        p11_final(F, poison);
    }
#undef IN
#undef BOTH
#undef GRID_BAR
}

extern "C" void kernel_launch(void* const* d_in, const int* in_sizes, int n_in, void* d_out, int out_size, void* d_ws, size_t ws_size, hipStream_t stream) {
    static int grid = 0;
    if (grid == 0) {
        if (n_in != 15 || in_sizes[0] != M * DM || out_size != M * DM || ws_size < WS_END) { fprintf(stderr, "kernel_launch: unexpected shapes / workspace (n_in %d, in0 %d, out %d, ws %zu < %zu); nothing launched\n", n_in, n_in > 0 ? in_sizes[0] : -1, out_size, ws_size, (size_t)WS_END); grid = -1; return; }
        int dev = 0, cus = 0, per_cu = 0;
        if (hipGetDevice(&dev) != hipSuccess || hipDeviceGetAttribute(&cus, hipDeviceAttributeMultiprocessorCount, dev) != hipSuccess) { grid = -1; return; }
        if (hipFuncSetAttribute((const void*)hyb_fwd, hipFuncAttributeMaxDynamicSharedMemorySize, LDS_BYTES) != hipSuccess) { fprintf(stderr, "kernel_launch: hipFuncSetAttribute failed\n"); grid = -1; return; }
        if (hipOccupancyMaxActiveBlocksPerMultiprocessor(&per_cu, (const void*)hyb_fwd, NWAVES * 64, LDS_BYTES) != hipSuccess || per_cu < 1) { fprintf(stderr, "kernel_launch: occupancy query reports %d workgroups per CU\n", per_cu); }
        (void)hipGetLastError();
        grid = cus;
    }
    if (grid < 0) return;
    if (hipMemsetAsync((char*)d_ws + WS_CTL, 0, CTL_ZERO_BYTES, stream) != hipSuccess) return;
    Args a{};
    for (int i = 0; i < 15; ++i) a.in[i] = (const float*)d_in[i];
    a.out = (float*)d_out; a.ws = (unsigned char*)d_ws;
    for (int li = 0; li < N_LAUNCHES; ++li) {
        a.ph_lo = (N_LAUNCHES == 1) ? 0 : li; a.ph_hi = (N_LAUNCHES == 1) ? N_PHASES : li + 1;
        hipLaunchKernelGGL(hyb_fwd, dim3(grid), dim3(NWAVES * 64), LDS_BYTES, stream, a);
        if (hipPeekAtLastError() != hipSuccess) { fprintf(stderr, "kernel_launch: launch %d failed\n", li); break; }
    }
}
```
